# Optimizing an MI355X kernel written in HIP

```python
import math
import jax, jax.numpy as jnp
from jax import lax
import numpy as np

D_MODEL = 1024
BATCH = 1
SEQ = 16384
DEPTH = 4

D_MIX = D_MODEL
S5_WIDTH = D_MIX // 4
S5_GROUP = 16
S5_GROUPS = S5_WIDTH // S5_GROUP
S5_STATE = 64
CONV_WIDTH = D_MIX // 4
CONV_K = 3
HG_WIDTH = D_MIX // 2
HG_HEAD_DIM = 128
HG_HEADS = HG_WIDTH // HG_HEAD_DIM
HG_CHUNK = 64
IN_SPLITS = (S5_WIDTH, CONV_WIDTH, CONV_WIDTH, CONV_WIDTH, HG_WIDTH, HG_WIDTH, HG_WIDTH, HG_WIDTH)
D_IN = S5_WIDTH + 3 * CONV_WIDTH + 4 * HG_WIDTH
D_FF = (7 * D_MODEL) // 2
N_EXPERTS = 8
TOP_K = 2
MOE_BLOCK = 128
N_DENSE = (DEPTH + 1) // 2
N_MOE = DEPTH // 2
NORM_EPS = 1e-6
DT_MIN = 1e-3
DT_MAX = 1e-1
LB_FLOOR = 1e-30

kernel_name = "hybrid_s5_conv_hgrn2_moe"

F32 = jnp.float32


def rmsnorm(x, g):
    x32 = x.astype(F32)
    y = x32 * lax.rsqrt(jnp.mean(x32 * x32, axis=-1, keepdims=True) + NORM_EPS)
    return (y * g.astype(F32)).astype(x.dtype)


def split_cols(h):
    parts, off = [], 0
    for w in IN_SPLITS:
        parts.append(h[..., off:off + w])
        off += w
    return parts


def _diag_scan_op(e1, e2):
    a1, b1 = e1
    a2, b2 = e2
    return a1 * a2, a2 * b1 + b2


def s5_mixer(u, lam_re, lam_im, log_dt, b_re, b_im, c_re, c_im, d, w_glu):
    bsz, L, _ = u.shape
    ug = u.astype(F32).reshape(bsz, L, S5_GROUPS, S5_GROUP)
    lam = lax.complex(lam_re.astype(F32), lam_im.astype(F32))
    dt = jnp.exp(log_dt.astype(F32))[:, None]
    lam_bar = jnp.exp(lam * dt)
    b = lax.complex(b_re.astype(F32), b_im.astype(F32))
    b_bar = ((lam_bar - 1.0) / lam)[..., None] * b
    bu = jnp.einsum('gpc,blgc->blgp', b_bar, ug.astype(jnp.complex64))
    a = jnp.broadcast_to(lam_bar, bu.shape)
    _, states = lax.associative_scan(_diag_scan_op, (a, bu), axis=1)
    c = lax.complex(c_re.astype(F32), c_im.astype(F32))
    y = jnp.real(jnp.einsum('gcp,blgp->blgc', c, states)) + d.astype(F32).reshape(S5_GROUPS, S5_GROUP) * ug
    y = jax.nn.gelu(y.reshape(bsz, L, S5_WIDTH))
    return y * jax.nn.sigmoid(y @ w_glu.astype(F32))


def conv_mixer(gate_b, gate_c, v, conv_w):
    z = gate_c * v
    L = z.shape[1]
    zp = jnp.pad(z, ((0, 0), (CONV_K - 1, 0), (0, 0)))
    y = zp[:, 0:L] * conv_w[0]
    for k in range(1, CONV_K):
        y = y + zp[:, k:k + L] * conv_w[k]
    return gate_b * y


def hgrn2_mixer(q, f_pre, i_val, gate, lb, norm_g):
    bsz, L, _ = q.shape
    n_chunks = L // HG_CHUNK

    def heads(t):
        return t.astype(F32).reshape(bsz, n_chunks, HG_CHUNK, HG_HEADS, HG_HEAD_DIM).transpose(1, 0, 3, 2, 4)

    lbh = jnp.clip(lb.astype(F32), 0.0, 1.0 - 1e-6).reshape(HG_HEADS, 1, HG_HEAD_DIM)
    fp = heads(f_pre)
    log_f = jnp.logaddexp(jnp.log(jnp.maximum(lbh, LB_FLOOR)), jnp.log1p(-lbh) + jax.nn.log_sigmoid(fp))
    k = (1.0 - lbh) * jax.nn.sigmoid(-fp)
    qh = jax.nn.silu(heads(q))
    vh = heads(i_val)
    mask = jnp.tril(jnp.ones((HG_CHUNK, HG_CHUNK), dtype=bool))[:, :, None]

    def step(state, inp):
        qc, kc, vc, lfc = inp
        b = jnp.cumsum(lfc, axis=2)
        o_inter = jnp.einsum('bhtk,bhkv->bhtv', qc * jnp.exp(b), state)
        diff = b[:, :, :, None, :] - b[:, :, None, :, :]
        decay = jnp.where(mask, jnp.exp(jnp.where(mask, diff, 0.0)), 0.0)
        scores = jnp.einsum('bhtk,bhtsk,bhsk->bhts', qc, decay, kc)
        o = o_inter + jnp.einsum('bhts,bhsv->bhtv', scores, vc)
        b_last = b[:, :, -1:, :]
        state = jnp.exp(b_last[:, :, 0, :])[..., None] * state + jnp.einsum('bhsk,bhsv->bhkv', kc * jnp.exp(b_last - b), vc)
        return state, o

    s0 = jnp.zeros((bsz, HG_HEADS, HG_HEAD_DIM, HG_HEAD_DIM), F32)
    _, o = lax.scan(step, s0, (qh, k, vh, log_f))
    o = o.transpose(1, 0, 3, 2, 4).reshape(bsz, L, HG_HEADS, HG_HEAD_DIM)
    o = rmsnorm(o, norm_g.reshape(HG_HEADS, HG_HEAD_DIM)).reshape(bsz, L, HG_WIDTH)
    return o * jax.nn.silu(gate.astype(F32))


def swiglu(h, w1, w3, w2):
    return (jax.nn.silu(h @ w1) * (h @ w3)) @ w2


def moe_swiglu(h, router, w1, w3, w2):
    T = h.shape[0]
    logits = h.astype(F32) @ router.astype(F32)
    top_val, top_idx = lax.top_k(logits, TOP_K)
    gates = jax.nn.softmax(top_val, axis=-1)
    flat_e = top_idx.reshape(-1)
    flat_tok = jnp.arange(T * TOP_K, dtype=jnp.int32) // TOP_K
    flat_g = gates.reshape(-1)
    order = jnp.argsort(flat_e)
    se, stok, sg = flat_e[order], flat_tok[order], flat_g[order]
    counts = jnp.zeros((N_EXPERTS,), jnp.int32).at[flat_e].add(1)
    padded = (counts + MOE_BLOCK - 1) // MOE_BLOCK * MOE_BLOCK
    start = jnp.cumsum(counts) - counts
    pend = jnp.cumsum(padded)
    pstart = pend - padded
    dest = pstart[se] + jnp.arange(T * TOP_K, dtype=jnp.int32) - start[se]
    n_blk = -(-(T * TOP_K) // MOE_BLOCK) + N_EXPERTS
    slot_tok = jnp.full((n_blk * MOE_BLOCK,), T, jnp.int32).at[dest].set(stok)
    slot_g = jnp.zeros((n_blk * MOE_BLOCK,), F32).at[dest].set(sg)
    blk_e = jnp.clip(jnp.searchsorted(pend, jnp.arange(n_blk, dtype=jnp.int32) * MOE_BLOCK, side='right'), 0, N_EXPERTS - 1)
    xs = jnp.take(h, slot_tok, axis=0, mode='fill', fill_value=0).reshape(n_blk, MOE_BLOCK, -1)

    def run_block(args):
        xb, e = args
        return swiglu(xb, w1[e], w3[e], w2[e])

    yb = lax.map(run_block, (xs, blk_e)).reshape(n_blk * MOE_BLOCK, -1)
    yb = yb * slot_g[:, None].astype(yb.dtype)
    return jnp.zeros_like(h).at[slot_tok].add(yb, mode='drop')


def setup_inputs(seed: int = 0) -> dict:
    key = jax.random.key(seed)
    ks = jax.random.split(key, 32)

    def nrm(k, shape, scale):
        return jax.random.normal(k, shape, F32) * scale

    def gain(k, shape):
        return 1.0 + 0.02 * jax.random.normal(k, shape, F32)

    return {
        "x": nrm(ks[0], (BATCH, SEQ, D_MODEL), 1.0),
        "attn_norm": gain(ks[1], (DEPTH, D_MODEL)),
        "ffn_norm": gain(ks[2], (DEPTH, D_MODEL)),
        "final_norm": gain(ks[3], (D_MODEL,)),
        "w_in": nrm(ks[4], (DEPTH, D_MODEL, D_IN), D_MODEL ** -0.5),
        "w_out": nrm(ks[5], (DEPTH, D_MIX, D_MODEL), D_MIX ** -0.5),
        "s5_lambda_re": -0.5 + 0.01 * jax.random.normal(ks[6], (DEPTH, S5_GROUPS, S5_STATE), F32),
        "s5_lambda_im": jnp.pi * jnp.arange(S5_STATE, dtype=F32) + 0.01 * jax.random.normal(ks[7], (DEPTH, S5_GROUPS, S5_STATE), F32),
        "s5_log_dt": jax.random.uniform(ks[8], (DEPTH, S5_GROUPS), F32, minval=math.log(DT_MIN), maxval=math.log(DT_MAX)),
        "s5_b_re": nrm(ks[9], (DEPTH, S5_GROUPS, S5_STATE, S5_GROUP), (2 * S5_GROUP) ** -0.5),
        "s5_b_im": nrm(ks[10], (DEPTH, S5_GROUPS, S5_STATE, S5_GROUP), (2 * S5_GROUP) ** -0.5),
        "s5_c_re": nrm(ks[11], (DEPTH, S5_GROUPS, S5_GROUP, S5_STATE), S5_STATE ** -0.5),
        "s5_c_im": nrm(ks[12], (DEPTH, S5_GROUPS, S5_GROUP, S5_STATE), S5_STATE ** -0.5),
        "s5_d": nrm(ks[13], (DEPTH, S5_WIDTH), 1.0),
        "s5_glu": nrm(ks[14], (DEPTH, S5_WIDTH, S5_WIDTH), S5_WIDTH ** -0.5),
        "s5_out_norm": gain(ks[15], (DEPTH, S5_WIDTH)),
        "conv_w": nrm(ks[16], (DEPTH, CONV_K, CONV_WIDTH), CONV_K ** -0.5),
        "conv_out_norm": gain(ks[17], (DEPTH, CONV_WIDTH)),
        "hg_lower_bounds": nrm(ks[18], (DEPTH, HG_WIDTH), 0.1),
        "hg_out_norm": gain(ks[19], (DEPTH, HG_WIDTH)),
        "ffn_w1": nrm(ks[20], (N_DENSE, D_MODEL, D_FF), D_MODEL ** -0.5),
        "ffn_w3": nrm(ks[21], (N_DENSE, D_MODEL, D_FF), D_MODEL ** -0.5),
        "ffn_w2": nrm(ks[22], (N_DENSE, D_FF, D_MODEL), D_FF ** -0.5),
        "moe_router": nrm(ks[23], (N_MOE, D_MODEL, N_EXPERTS), D_MODEL ** -0.5),
        "moe_w1": nrm(ks[24], (N_MOE, N_EXPERTS, D_MODEL, D_FF), D_MODEL ** -0.5),
        "moe_w3": nrm(ks[25], (N_MOE, N_EXPERTS, D_MODEL, D_FF), D_MODEL ** -0.5),
        "moe_w2": nrm(ks[26], (N_MOE, N_EXPERTS, D_FF, D_MODEL), D_FF ** -0.5),
    }


def reference(x, attn_norm, ffn_norm, final_norm, w_in, w_out,
              s5_lambda_re, s5_lambda_im, s5_log_dt, s5_b_re, s5_b_im, s5_c_re, s5_c_im,
              s5_d, s5_glu, s5_out_norm, conv_w, conv_out_norm, hg_lower_bounds, hg_out_norm,
              ffn_w1, ffn_w3, ffn_w2, moe_router, moe_w1, moe_w3, moe_w2):
    lb_soft = jax.nn.softmax(hg_lower_bounds.astype(F32), axis=0)
    lb_all = jnp.cumsum(lb_soft, axis=0) - lb_soft[0]
    h = x
    bsz, L, _ = x.shape
    for l in range(DEPTH):
        hn = rmsnorm(h, attn_norm[l])
        u, cb, cc, cv, hq, hf, hi, hgate = split_cols(hn @ w_in[l])
        y_s5 = s5_mixer(u, s5_lambda_re[l], s5_lambda_im[l], s5_log_dt[l], s5_b_re[l], s5_b_im[l],
                        s5_c_re[l], s5_c_im[l], s5_d[l], s5_glu[l])
        y_s5 = rmsnorm(y_s5, s5_out_norm[l])
        y_conv = rmsnorm(conv_mixer(cb, cc, cv, conv_w[l]), conv_out_norm[l])
        y_hg = hgrn2_mixer(hq, hf, hi, hgate, lb_all[l], hg_out_norm[l])
        mix = jnp.concatenate([y_s5.astype(h.dtype), y_conv.astype(h.dtype), y_hg.astype(h.dtype)], axis=-1)
        h = h + mix @ w_out[l]
        hn = rmsnorm(h, ffn_norm[l])
        j = l // 2
        if l % 2 == 0:
            ff = swiglu(hn, ffn_w1[j], ffn_w3[j], ffn_w2[j])
        else:
            ff = moe_swiglu(hn.reshape(bsz * L, D_MODEL), moe_router[j], moe_w1[j], moe_w3[j], moe_w2[j]).reshape(bsz, L, D_MODEL)
        h = h + ff
    return rmsnorm(h, final_norm)
```

```cpp
#include <hip/hip_runtime.h>
#include <cstdio>
#include <cstdint>

#ifndef MK_FUSED
#define MK_FUSED 1
#endif
#ifndef XREP_HGL
#define XREP_HGL 0
#endif
#ifndef XREP_S5A
#define XREP_S5A 0
#endif
#ifndef XREP_CONV
#define XREP_CONV 0
#endif
#ifndef XREP_HGF
#define XREP_HGF 0
#endif
#ifndef XREP_S5C
#define XREP_S5C 0
#endif
#ifndef FAST_HG
#define FAST_HG 1
#endif
#ifndef FAST_S5
#define FAST_S5 1
#endif

#ifndef PH_MASK
#define PH_MASK 0xFFFF
#endif
#define SITE(n) ((PH_MASK >> (n)) & 1)
#define LAS __attribute__((address_space(3)))
#define GAS __attribute__((address_space(1)))
typedef unsigned short bf16_t;
typedef short bf16x8 __attribute__((ext_vector_type(8)));
typedef float f32x4 __attribute__((ext_vector_type(4)));
typedef float f32x2 __attribute__((ext_vector_type(2)));
typedef unsigned u32x4 __attribute__((ext_vector_type(4)));
typedef unsigned u32x2 __attribute__((ext_vector_type(2)));
typedef int i32x4 __attribute__((ext_vector_type(4)));
typedef int i32x8 __attribute__((ext_vector_type(8)));

constexpr int T = 16384, D = 1024, DIN = 3072, DFF = 3584, NE = 8, DEPTH = 4;
constexpr int S5W = 256, S5G = 16, S5P = 64, CW = 256, HGW = 512, HGH = 4, HGD = 128;
constexpr int F8_FFN = 0x4;
constexpr int F8_IN = 0xC;
constexpr int F8_OUT = 0x8;
constexpr int ECAP = 16384;
constexpr int MAXP = 136;
constexpr float NORM_EPS = 1e-6f;
constexpr int PC_U = 0, PC_CB = 256, PC_CC = 512, PC_CV = 768, PC_Q = 1024, PC_F = 1536, PC_I = 2048, PC_G = 2560;

constexpr size_t MiB = 1u << 20;
constexpr size_t WS_CTL = 0, CTL_BYTES = 1 * MiB;
constexpr size_t WS_WIN = 1 * MiB;
constexpr size_t WS_WOUT = 25 * MiB;
constexpr size_t WS_W13 = 33 * MiB;
constexpr size_t WS_W2 = 61 * MiB;
constexpr size_t WS_MW13 = 75 * MiB;
constexpr size_t WS_HB8 = 187 * MiB;
constexpr size_t WS_MIX8 = 203 * MiB;
constexpr size_t WS_MW2 = 299 * MiB;
constexpr size_t WS_GLU = 411 * MiB;
constexpr size_t WS_TAB = 412 * MiB;
constexpr size_t WS_HB = 413 * MiB;
constexpr size_t WS_SSQ = 445 * MiB;
constexpr size_t WS_MOE = 446 * MiB;
constexpr size_t WS_Y = 448 * MiB;
constexpr size_t WS_X = 516 * MiB;
constexpr size_t WS_PROJ = WS_X, WS_MIX = WS_X + 96 * MiB, WS_ACT = WS_X;
constexpr size_t WS_RL = WS_X;
constexpr size_t WS_SCR = 754 * MiB;
constexpr size_t WS_YT = WS_SCR;
constexpr size_t WS_VT = WS_SCR + 32 * MiB;
constexpr size_t WS_END = 896 * MiB;
constexpr int TB_LBC = 0;
constexpr int TB_LAMB = 2048;
constexpr int TB_BBAR = TB_LAMB + 4 * 16 * 64 * 2;
constexpr int TB_RG = TB_BBAR + 4 * 16 * 64 * 16 * 2;
constexpr int TB_END = TB_RG + 2 * 8 * 1024;
static_assert((size_t)TB_END * 4 <= MiB, "tables");
constexpr size_t MO_TOKE = 0;
constexpr size_t MO_TOKP = 128 * 1024;
constexpr size_t MO_RSTD = 256 * 1024;
constexpr size_t MO_TCNT = 384 * 1024;
constexpr size_t MO_TLIST = 512 * 1024;
constexpr size_t MO_TGATE = 1024 * 1024;
constexpr size_t SC_F = WS_SCR, SC_K = WS_SCR + 32 * MiB, SC_Q = WS_SCR + 64 * MiB, SC_O = WS_SCR + 96 * MiB;
constexpr size_t FS = WS_X + 128 * MiB;
constexpr size_t FS_OLOC = FS;
constexpr size_t FS_ASEG = FS + 16 * MiB;
constexpr size_t FS_SEND = FS + 32 * MiB;
constexpr size_t FS_SST = FS + 48 * MiB;
constexpr size_t FS_DSEG = FS + 56 * MiB;
constexpr size_t FS_XE = FS + 57 * MiB;
constexpr size_t FS_XIN = FS + 59 * MiB;
constexpr size_t FS_GATE = FS + 61 * MiB;
constexpr size_t WS_BB = WS_GLU + 512 * 1024;
constexpr size_t WS_CM = WS_GLU + 768 * 1024;
constexpr size_t SC_Y1 = WS_Y;
static_assert(SC_O + (size_t)T * 512 * 4 <= WS_END, "ws map");
constexpr int CW_BAR = 4096;
constexpr int CW_CNT = 16384;

constexpr int RING_BYTES = 131072;
constexpr int LDS_BYTES = 163840;
constexpr int MISC_OFF = LDS_BYTES - 4096;
constexpr int RSB_OFF = RING_BYTES;
constexpr int RSB_UNITS = (MISC_OFF - RSB_OFF) / 1024;
constexpr int BASE_OFF = RING_BYTES + 20480;

__device__ __forceinline__ unsigned f2bf(float f) { unsigned u = __builtin_bit_cast(unsigned, f); return (u + 0x7fffu + ((u >> 16) & 1u)) >> 16; }
__device__ __forceinline__ unsigned pk2(float lo, float hi) { unsigned r; asm("v_cvt_pk_bf16_f32 %0, %1, %2" : "=v"(r) : "v"(lo), "v"(hi)); return r; }
__device__ __forceinline__ unsigned pk4_f8(float a, float b, float c, float d) {
    a = __builtin_amdgcn_fmed3f(a, -448.f, 448.f); b = __builtin_amdgcn_fmed3f(b, -448.f, 448.f); c = __builtin_amdgcn_fmed3f(c, -448.f, 448.f); d = __builtin_amdgcn_fmed3f(d, -448.f, 448.f);
    int w = 0; w = __builtin_amdgcn_cvt_pk_fp8_f32(a, b, w, false); w = __builtin_amdgcn_cvt_pk_fp8_f32(c, d, w, true); return (unsigned)w; }
__device__ __forceinline__ u32x2 bf8_to_f8(u32x4 w) {
    u32x2 o; o.x = pk4_f8(__builtin_bit_cast(float, w.x << 16), __builtin_bit_cast(float, w.x & 0xffff0000u), __builtin_bit_cast(float, w.y << 16), __builtin_bit_cast(float, w.y & 0xffff0000u));
    o.y = pk4_f8(__builtin_bit_cast(float, w.z << 16), __builtin_bit_cast(float, w.z & 0xffff0000u), __builtin_bit_cast(float, w.w << 16), __builtin_bit_cast(float, w.w & 0xffff0000u)); return o; }
__device__ __forceinline__ float bf2f(unsigned short b) { return __builtin_bit_cast(float, (unsigned)b << 16); }
__device__ __forceinline__ float bflo(unsigned w) { return __builtin_bit_cast(float, w << 16); }
__device__ __forceinline__ float bfhi(unsigned w) { return __builtin_bit_cast(float, w & 0xffff0000u); }
__device__ __forceinline__ float shx(float v, int m, int lane) { return __builtin_bit_cast(float, __builtin_amdgcn_ds_bpermute((lane ^ m) << 2, __builtin_bit_cast(int, v))); }
__device__ __forceinline__ float wave_sum(float v, int lane) {
#pragma unroll
    for (int o = 1; o < 64; o <<= 1) v += shx(v, o, lane);
    return v;
}
__device__ __forceinline__ float sigmoidf_(float x) { return __builtin_amdgcn_rcpf(1.f + __expf(-x)); }
__device__ __forceinline__ float siluf_(float x) { return x * __builtin_amdgcn_rcpf(1.f + __expf(-x)); }
__device__ __forceinline__ float gelu_tanh(float x) { const float u2 = 1.5957691216057308f * (x + 0.044715f * x * x * x); return x * __builtin_amdgcn_rcpf(1.f + __expf(-u2)); }
__device__ __forceinline__ float rstd_from_ssq(const float* ssq, int row) {
    const f32x4* p = (const f32x4*)(ssq + (size_t)row * 16);
    const f32x4 a = p[0], b = p[1], c = p[2], d = p[3];
    const float s = ((a.x + a.y) + (a.z + a.w)) + ((b.x + b.y) + (b.z + b.w)) + ((c.x + c.y) + (c.z + c.w)) + ((d.x + d.y) + (d.z + d.w));
    return __builtin_amdgcn_rsqf(s * (1.f / D) + NORM_EPS);
}

__device__ __forceinline__ int slot_src(const LAS int* baseL, int e, int pos);
namespace pg8 {
constexpr int BM = 256, BK = 64, HALF = 128, HTB = HALF * BK * 2, STAGE_BYTES = 8 * HTB, NXCD = 8, WGM = 4;
__host__ __device__ __forceinline__ int lds_byte(int r, int c) { const int st = (r >> 4) * 2 + (c >> 5), rr = r & 15, cc = c & 31, ob = rr * 64 + cc * 2; return st * 1024 + (ob ^ (((ob >> 9) & 1) << 5)); }
__host__ __device__ __forceinline__ void stage_rc(int b, int& R, int& C) { const int st = b / 1024, sb = b % 1024, swz = sb ^ (((sb >> 9) & 1) << 5); R = (st >> 1) * 16 + swz / 64; C = (st & 1) * 32 + (swz % 64) / 2; }
__host__ __device__ __forceinline__ int perm32(int rho) { const int n = rho >> 4, i = rho & 15; return 8 * (i >> 2) + 4 * n + (i & 3); }

struct Unit { int pm, pn, e, lp, ord, ks; };

struct TileOrder {
    int nM, nN, nwg, G, c, lim;
    __device__ __forceinline__ void init(int nM_, int nN_, int G_, int c_) { nM = nM_; nN = nN_; nwg = nM * nN; G = G_; c = c_; lim = nwg; }
    __device__ __forceinline__ bool map(int i, int& pm, int& pn) const { const long L = (long)i * G + c; if (L >= lim) return false; return mapL(L, pm, pn); }
    __device__ __forceinline__ bool mapL(long L, int& pm, int& pn) const {
        if (L >= nwg) return false;
        int wgid = (int)L; { const int q = nwg / NXCD, r = nwg % NXCD, xcd = wgid % NXCD, off = wgid / NXCD; wgid = (xcd < r ? xcd * (q + 1) : r * (q + 1) + (xcd - r) * q) + off; }
        const int nig = WGM * nN, gid = wgid / nig, fm = gid * WGM, gsz = (nM - fm) < WGM ? (nM - fm) : WGM;
        pm = fm + ((wgid % nig) % gsz); pn = (wgid % nig) / gsz; return true;
    }
};

__device__ __forceinline__ unsigned cvt_pk_bf16(float lo, float hi) { unsigned r; asm("v_cvt_pk_bf16_f32 %0, %1, %2" : "=v"(r) : "v"(lo), "v"(hi)); return r; }

template <bool F8, class Epi, class Sched>
__device__ __forceinline__ void gemm_phase(LAS unsigned char* lds, const int tid, const char* Abase, const int Kb, const int ldb, const Sched& S, const Epi& E) {
    const int wid = __builtin_amdgcn_readfirstlane(tid >> 6), lane = tid & 63, wr = wid >> 2, wc = wid & 3, fr = lane & 15, fq = lane >> 4;
    const int nt = Kb / (BK * 2);
    unsigned voffB[2];
#pragma unroll
    for (int i = 0; i < 2; ++i) { int R, C; stage_rc(tid * 16 + i * 8192, R, C); const int Rb = Epi::PERM ? ((R & ~31) + perm32(R & 31)) : R; voffB[i] = (unsigned)(Rb * ldb + C * 2); }
    const size_t kstep = (size_t)(BK * 2);
    const size_t hstep = (size_t)HALF * ldb;
    int one8 = 0x7f7f7f7f; asm volatile("" : "+v"(one8));
    const unsigned ldsw = (unsigned)wid * 1024u;
    const int aoff = lds_byte(wr * 64 + fr, fq * 8), boff = lds_byte(wc * 32 + fr, fq * 8);
#define PG8_SA(b, h) (((b) * 2 + (h)) * HTB)
#define PG8_SB(b, h) ((4 + (b) * 2 + (h)) * HTB)
#define PG8_STAGE(bufoff, gbase, voff) do { _Pragma("unroll") for (int _i = 0; _i < 2; ++_i) \
        __builtin_amdgcn_global_load_lds((const unsigned*)((const char*)(gbase) + (voff)[_i]), (LAS unsigned*)(lds + (bufoff) + ldsw + _i * 8192), 16, 0, 0); } while (0)
#define PG8_STAGEA(bufoff, kb, o0, o1) do { \
        __builtin_amdgcn_global_load_lds((const unsigned*)(Abase + (kb) + (o0)), (LAS unsigned*)(lds + (bufoff) + ldsw), 16, 0, 0); \
        __builtin_amdgcn_global_load_lds((const unsigned*)(Abase + (kb) + (o1)), (LAS unsigned*)(lds + (bufoff) + ldsw + 8192), 16, 0, 0); } while (0)
#define PG8_LDA(dst, b, h) do { _Pragma("unroll") for (int m = 0; m < 4; ++m) _Pragma("unroll") for (int k = 0; k < 2; ++k) dst[m][k] = *(const LAS bf16x8*)(lds + PG8_SA(b, h) + aoff + m * 2048 + k * 1024); } while (0)
#define PG8_LDB(dst, b, h) do { _Pragma("unroll") for (int n = 0; n < 2; ++n) _Pragma("unroll") for (int k = 0; k < 2; ++k) dst[n][k] = *(const LAS bf16x8*)(lds + PG8_SB(b, h) + boff + n * 2048 + k * 1024); } while (0)
#define PG8_CAT8(x) __builtin_shufflevector(__builtin_bit_cast(i32x4, (x)[0]), __builtin_bit_cast(i32x4, (x)[1]), 0, 1, 2, 3, 4, 5, 6, 7)
#define PG8_MMA(ai, bj, At, Bt) do { __builtin_amdgcn_s_setprio(1); \
        if constexpr (F8) { _Pragma("unroll") for (int m = 0; m < 4; ++m) _Pragma("unroll") for (int n = 0; n < 2; ++n) \
            acc[ai][bj][m][n] = __builtin_amdgcn_mfma_scale_f32_16x16x128_f8f6f4(PG8_CAT8(Bt[n]), PG8_CAT8(At[m]), acc[ai][bj][m][n], 0, 0, 0, one8, 0, one8); } \
        else { _Pragma("unroll") for (int m = 0; m < 4; ++m) _Pragma("unroll") for (int n = 0; n < 2; ++n) _Pragma("unroll") for (int k = 0; k < 2; ++k) \
            acc[ai][bj][m][n] = __builtin_amdgcn_mfma_f32_16x16x32_bf16(Bt[n][k], At[m][k], acc[ai][bj][m][n], 0, 0, 0); } \
        __builtin_amdgcn_s_setprio(0); } while (0)
#define PG8_WAIT_V(n) asm volatile("s_waitcnt vmcnt(" #n ")" ::: "memory")
#define PG8_WAIT_L(n) asm volatile("s_waitcnt lgkmcnt(" #n ")" ::: "memory")
#define PG8_BAR __builtin_amdgcn_s_barrier()
#define PG8_SCHED __builtin_amdgcn_sched_barrier(0)
    Unit cur, nxt; int ui = 0;
    const bool any = S.next(0, cur);
    const char* cB = any ? S.b_base(cur) : nullptr;
    unsigned c00 = 0, c01 = 0, c10 = 0, c11 = 0, n00, n01, n10, n11;
    const bool aearly = any && S.a_early();
    if (any) { PG8_STAGE(PG8_SB(0, 0), cB, voffB); PG8_STAGE(PG8_SB(0, 1), cB + hstep, voffB);
        if (aearly) { S.a_off(cur, tid, ldb, c00, c01, c10, c11); PG8_STAGEA(PG8_SA(0, 0), 0, c00, c01); PG8_STAGEA(PG8_SA(0, 1), 0, c10, c11); } }
    S.stage((LAS unsigned*)(lds + RSB_OFF), tid);
    __syncthreads();
    if (!any) return;
    f32x4 acc[2][2][4][2];
    if constexpr (Epi::PRELOAD) E.preload(acc, cur, wr, wc, fr, fq);
    else {
#pragma unroll
    for (int a = 0; a < 2; ++a)
#pragma unroll
        for (int b = 0; b < 2; ++b)
#pragma unroll
            for (int m = 0; m < 4; ++m)
#pragma unroll
                for (int n = 0; n < 2; ++n) acc[a][b][m][n] = (f32x4){0.f, 0.f, 0.f, 0.f};
    }
    bf16x8 At[4][2], B0[2][2], B1[2][2];
    if (!aearly) { S.a_off(cur, tid, ldb, c00, c01, c10, c11); PG8_STAGEA(PG8_SA(0, 0), 0, c00, c01); PG8_STAGEA(PG8_SA(0, 1), 0, c10, c11); }
    if (wr == 1) PG8_BAR;
    PG8_WAIT_V(2); PG8_BAR;
    PG8_STAGE(PG8_SB(1, 0), cB + kstep, voffB); PG8_STAGEA(PG8_SA(1, 0), kstep, c00, c01); PG8_STAGE(PG8_SB(1, 1), cB + hstep + kstep, voffB);
    PG8_WAIT_V(6); PG8_BAR;
    for (;;) {
        const bool has_next = S.next(ui + 1, nxt);
        const char* nB = cB;
        n00 = c00; n01 = c01; n10 = c10; n11 = c11;
        if (has_next) { nB = S.b_base(nxt); S.a_off(nxt, tid, ldb, n00, n01, n10, n11); }
#define PG8_PAIR(FIN) do { \
            if constexpr (F8) asm volatile("" : "+v"(c00), "+v"(c01), "+v"(c10), "+v"(c11), "+v"(voffB[0]), "+v"(voffB[1]));     \
            const bool last = (t == nt - 2); \
            const size_t kb1 = (size_t)(t + 1) * kstep; \
            const size_t kb2 = last ? 0 : (size_t)(t + 2) * kstep; \
            const char* b2 = last ? nB : cB + (size_t)(t + 2) * kstep; \
            const char* b3 = b2 + kstep; \
              \
            PG8_LDB(B0, 0, 0); PG8_LDB(B1, 0, 1); PG8_SCHED; PG8_LDA(At, 0, 0); PG8_STAGEA(PG8_SA(1, 1), kb1, c10, c11); \
            if (last) { c00 = n00; c01 = n01; c10 = n10; c11 = n11; }     \
            if (FIN) PG8_WAIT_V(0); else PG8_WAIT_V(8); PG8_WAIT_L(0); PG8_BAR; PG8_MMA(0, 0, At, B0); PG8_MMA(0, 1, At, B1); PG8_BAR; PG8_SCHED; \
              \
            PG8_LDA(At, 0, 1); if (!(FIN)) { PG8_STAGE(PG8_SB(0, 0), b2, voffB); PG8_STAGE(PG8_SB(0, 1), b2 + hstep, voffB); PG8_STAGEA(PG8_SA(0, 0), kb2, c00, c01); } \
            if (FIN) PG8_WAIT_V(0); else PG8_WAIT_V(8); PG8_WAIT_L(0); PG8_BAR; PG8_MMA(1, 0, At, B0); PG8_MMA(1, 1, At, B1); PG8_BAR; PG8_SCHED; \
              \
            PG8_LDB(B0, 1, 0); PG8_LDB(B1, 1, 1); PG8_SCHED; PG8_LDA(At, 1, 0); if (!(FIN)) { PG8_STAGEA(PG8_SA(0, 1), kb2, c10, c11); } \
            if (FIN) PG8_WAIT_V(0); else PG8_WAIT_V(8); PG8_WAIT_L(0); PG8_BAR; PG8_MMA(0, 0, At, B0); PG8_MMA(0, 1, At, B1); PG8_BAR; PG8_SCHED; \
              \
            PG8_LDA(At, 1, 1); if (!(FIN)) { PG8_STAGE(PG8_SB(1, 0), b3, voffB); PG8_STAGE(PG8_SB(1, 1), b3 + hstep, voffB); PG8_STAGEA(PG8_SA(1, 0), kb2 + kstep, c00, c01); } \
            if (FIN) PG8_WAIT_V(0); else PG8_WAIT_V(8); PG8_WAIT_L(0); PG8_BAR; PG8_MMA(1, 0, At, B0); PG8_MMA(1, 1, At, B1); PG8_BAR; PG8_SCHED; \
        } while (0)
        {
            const int nt_main = (has_next || F8) ? nt : nt - 2;
            int t = 0;
            _Pragma("nounroll") for (; t < nt_main; t += 2) PG8_PAIR(false);
            if constexpr (!F8) { if (!has_next) PG8_PAIR(true); }
        }
#undef PG8_PAIR
        if (wr == 0) PG8_BAR;
        { int l2 = lane; asm volatile("" : "+v"(l2));
          E(acc, cur, wr, wc, l2 & 15, l2 >> 4); }
        if (!has_next) break;
        if constexpr (Epi::PRELOAD) E.preload(acc, nxt, wr, wc, fr, fq);
        else {
#pragma unroll
        for (int a = 0; a < 2; ++a)
#pragma unroll
            for (int b = 0; b < 2; ++b)
#pragma unroll
                for (int m = 0; m < 4; ++m)
#pragma unroll
                    for (int n = 0; n < 2; ++n) acc[a][b][m][n] = (f32x4){0.f, 0.f, 0.f, 0.f};
        }
        cur = nxt; cB = nB; ++ui;
        if (wr == 1) PG8_BAR;
    }
    PG8_WAIT_V(0);
    PG8_BAR;
#undef PG8_SA
#undef PG8_SB
#undef PG8_STAGE
#undef PG8_STAGEA
#undef PG8_LDA
#undef PG8_LDB
#undef PG8_MMA
#undef PG8_CAT8
#undef PG8_WAIT_V
#undef PG8_WAIT_L
#undef PG8_BAR
#undef PG8_SCHED
}

struct DenseSched {
    TileOrder o; const char* Bt; size_t tstepB; const float* ssq; const float* rgsrc;
    __device__ __forceinline__ bool next(int i, Unit& u) const { u.e = 0; u.lp = 0; u.ord = i; return o.map(i, u.pm, u.pn); }
    __device__ __forceinline__ bool a_early() const { return ssq != nullptr; }
    __device__ __forceinline__ void stage(LAS unsigned* rsb, int tid) const {
        if (rgsrc) {
#pragma unroll
            for (int i = 0; i < 3; ++i) { Unit u; if (next(i, u)) { const int idx = tid * 4, e = idx >> 8, c = idx & 255;
                *(LAS f32x4*)((LAS float*)rsb + i * 2048 + idx) = *(const f32x4*)(rgsrc + e * 1024 + u.pn * 256 + c); } }
        }
        if (!ssq) return;
        float v[4]; bool ok[4];
#pragma unroll
        for (int q = 0; q < 4; ++q) { Unit u; const int i = 2 * q + (tid >> 8); ok[q] = next(i, u); v[q] = rstd_from_ssq(ssq, (ok[q] ? u.pm : 0) * 256 + (tid & 255)); }
#pragma unroll
        for (int q = 0; q < 4; ++q) if (ok[q]) rsb[(2 * q + (tid >> 8)) * 256 + (tid & 255)] = __builtin_bit_cast(unsigned, v[q]);
    }
    __device__ __forceinline__ const char* b_base(const Unit& u) const { return Bt + (size_t)u.pn * tstepB; }
    __device__ __forceinline__ void a_off(const Unit& u, int tid, int ldb, unsigned& o00, unsigned& o01, unsigned& o10, unsigned& o11) const {
        int RA[2], CA[2]; stage_rc(tid * 16, RA[0], CA[0]); stage_rc(tid * 16 + 8192, RA[1], CA[1]);
        const int r0 = u.pm * 256;
        o00 = (unsigned)((r0 + RA[0]) * ldb + CA[0] * 2); o01 = (unsigned)((r0 + RA[1]) * ldb + CA[1] * 2);
        o10 = (unsigned)((r0 + 128 + RA[0]) * ldb + CA[0] * 2); o11 = (unsigned)((r0 + 128 + RA[1]) * ldb + CA[1] * 2);
    }
};
struct MoeSched {
    TileOrder o; const char* Bt; size_t estepB, tstepB; const LAS int* tab; const int* tlist; bool gather; const LAS unsigned* rsbp;
    const float* tgate; const LAS int* baseL; const float* rstd_tok;
    __device__ __forceinline__ bool a_early() const { return !gather; }
    __device__ __forceinline__ void stage(LAS unsigned* rsb, int tid) const {
        unsigned v[8]; bool ok[8], in[8];
#pragma unroll
        for (int q = 0; q < 8; ++q) { Unit u; const int i = 2 * q + (tid >> 8); ok[q] = next(i, u);
            const int e = ok[q] ? u.e : 0, cnt = tab[e], sl = (ok[q] ? u.lp : 0) * 256 + (tid & 255); in[q] = ok[q] && sl < cnt;
            const int src = in[q] ? slot_src(baseL, e, sl) : 0;
            v[q] = gather ? (unsigned)tlist[src] : __builtin_bit_cast(unsigned, tgate[src]); }
        if (gather) {
#pragma unroll
            for (int q = 0; q < 8; ++q) v[q] = (v[q] & 0xffffu) | (f2bf(rstd_tok[v[q] & 0x3fffu]) << 16);
        }
#pragma unroll
        for (int q = 0; q < 8; ++q) if (ok[q]) rsb[(2 * q + (tid >> 8)) * 256 + (tid & 255)] = in[q] ? v[q] : (gather ? 0x0000ffffu : 0u);
    }
    __device__ __forceinline__ bool next(int i, Unit& u) const {
        u.ord = i;
        if (!o.map(i, u.pm, u.pn)) return false;
        int e = 0;
#pragma unroll
        for (int j = 1; j < 8; ++j) e += (u.pm >= __builtin_amdgcn_readfirstlane(tab[8 + j])) ? 1 : 0;
        u.e = e; u.lp = u.pm - __builtin_amdgcn_readfirstlane(tab[8 + e]); return true;
    }
    __device__ __forceinline__ const char* b_base(const Unit& u) const { return Bt + (size_t)u.e * estepB + (size_t)u.pn * tstepB; }
    __device__ __forceinline__ void a_off(const Unit& u, int tid, int ldb, unsigned& o00, unsigned& o01, unsigned& o10, unsigned& o11) const {
        int RA[2], CA[2]; stage_rc(tid * 16, RA[0], CA[0]); stage_rc(tid * 16 + 8192, RA[1], CA[1]);
        if (gather) {
            const LAS int* tk = (const LAS int*)rsbp + u.ord * 256;
            int t00 = tk[RA[0]] & 0xffff, t01 = tk[RA[1]] & 0xffff, t10 = tk[128 + RA[0]] & 0xffff, t11 = tk[128 + RA[1]] & 0xffff;
            t00 = t00 == 0xffff ? 0 : t00; t01 = t01 == 0xffff ? 0 : t01; t10 = t10 == 0xffff ? 0 : t10; t11 = t11 == 0xffff ? 0 : t11;
            o00 = (unsigned)(t00 * ldb + CA[0] * 2); o01 = (unsigned)(t01 * ldb + CA[1] * 2); o10 = (unsigned)(t10 * ldb + CA[0] * 2); o11 = (unsigned)(t11 * ldb + CA[1] * 2);
        } else {
            const int r0 = u.pm * 256;
            o00 = (unsigned)((r0 + RA[0]) * ldb + CA[0] * 2); o01 = (unsigned)((r0 + RA[1]) * ldb + CA[1] * 2);
            o10 = (unsigned)((r0 + 128 + RA[0]) * ldb + CA[0] * 2); o11 = (unsigned)((r0 + 128 + RA[1]) * ldb + CA[1] * 2);
        }
    }
};

struct MoeTailSched {
    TileOrder o; const char* Bt; size_t estepB, tstepB; const LAS int* tab; const float* tgate; const LAS int* baseL; int Lmain, R, S, Kslice;
    __device__ __forceinline__ bool next(int i, Unit& u) const {
        u.ord = i;
        if (i != 0 || o.c >= R * S) return false;
        if (!o.mapL(Lmain + o.c / S, u.pm, u.pn)) return false;
        int e = 0;
#pragma unroll
        for (int j = 1; j < 8; ++j) e += (u.pm >= __builtin_amdgcn_readfirstlane(tab[8 + j])) ? 1 : 0;
        u.e = e; u.lp = u.pm - __builtin_amdgcn_readfirstlane(tab[8 + e]); u.ks = o.c % S; return true;
    }
    __device__ __forceinline__ bool a_early() const { return true; }
    __device__ __forceinline__ void stage(LAS unsigned* rsb, int tid) const {
        Unit u; if (!next(0, u)) return;
        if (tid < 256) { const int cnt = __builtin_amdgcn_readfirstlane(tab[u.e]), sl = u.lp * 256 + tid; rsb[tid] = (sl < cnt) ? __builtin_bit_cast(unsigned, tgate[slot_src(baseL, u.e, sl)]) : 0u; }
    }
    __device__ __forceinline__ const char* b_base(const Unit& u) const { return Bt + (size_t)u.e * estepB + (size_t)u.pn * tstepB + (size_t)u.ks * Kslice; }
    __device__ __forceinline__ void a_off(const Unit& u, int tid, int ldb, unsigned& o00, unsigned& o01, unsigned& o10, unsigned& o11) const {
        int RA[2], CA[2]; stage_rc(tid * 16, RA[0], CA[0]); stage_rc(tid * 16 + 8192, RA[1], CA[1]);
        const int r0 = u.pm * 256, kb = u.ks * Kslice;
        o00 = (unsigned)((r0 + RA[0]) * ldb + CA[0] * 2 + kb); o01 = (unsigned)((r0 + RA[1]) * ldb + CA[1] * 2 + kb);
        o10 = (unsigned)((r0 + 128 + RA[0]) * ldb + CA[0] * 2 + kb); o11 = (unsigned)((r0 + 128 + RA[1]) * ldb + CA[1] * 2 + kb);
    }
};

__device__ __forceinline__ u32x4 pair16(u32x2 a, u32x2 b) {
    auto rx = __builtin_amdgcn_permlane16_swap(a.x, b.x, false, false); auto ry = __builtin_amdgcn_permlane16_swap(a.y, b.y, false, false);
    return (u32x4){(unsigned)rx[0], (unsigned)ry[0], (unsigned)rx[1], (unsigned)ry[1]};
}
__device__ __forceinline__ void swiglu8f(const f32x4 a0, const f32x4 a1, const f32x4 b0, const f32x4 b1, const float rs, const float osc, f32x4& o0, f32x4& o1) {
    const float nl = -1.4426950408889634f * rs, r2 = rs * rs * osc;
    const f32x4 x0 = a0 * nl, x1 = a1 * nl;
    f32x4 e0, e1;
    e0.x = __builtin_amdgcn_exp2f(x0.x); e0.y = __builtin_amdgcn_exp2f(x0.y); e0.z = __builtin_amdgcn_exp2f(x0.z); e0.w = __builtin_amdgcn_exp2f(x0.w);
    e1.x = __builtin_amdgcn_exp2f(x1.x); e1.y = __builtin_amdgcn_exp2f(x1.y); e1.z = __builtin_amdgcn_exp2f(x1.z); e1.w = __builtin_amdgcn_exp2f(x1.w);
    const f32x4 d0 = e0 + 1.0f, d1 = e1 + 1.0f;
    f32x4 s0, s1;
    s0.x = __builtin_amdgcn_rcpf(d0.x); s0.y = __builtin_amdgcn_rcpf(d0.y); s0.z = __builtin_amdgcn_rcpf(d0.z); s0.w = __builtin_amdgcn_rcpf(d0.w);
    s1.x = __builtin_amdgcn_rcpf(d1.x); s1.y = __builtin_amdgcn_rcpf(d1.y); s1.z = __builtin_amdgcn_rcpf(d1.z); s1.w = __builtin_amdgcn_rcpf(d1.w);
    o0 = ((a0 * b0) * r2) * s0; o1 = ((a1 * b1) * r2) * s1;
}
__device__ __forceinline__ void swiglu8(const f32x4 a0, const f32x4 a1, const f32x4 b0, const f32x4 b1, const float rs, u32x4& w) {
    f32x4 o0, o1; swiglu8f(a0, a1, b0, b1, rs, 1.0f, o0, o1);
    w.x = cvt_pk_bf16(o0.x, o0.y); w.y = cvt_pk_bf16(o0.z, o0.w); w.z = cvt_pk_bf16(o1.x, o1.y); w.w = cvt_pk_bf16(o1.z, o1.w);
}
struct EpiProj {
    static constexpr bool PERM = true, PRELOAD = false;
    bf16_t* O; const LAS float* rsb; bf16_t* GT; float sc;
    __device__ __forceinline__ void operator()(const f32x4 (&acc)[2][2][4][2], const Unit& u, int wr, int wc, int fr, int fq) const {
        const int row0 = u.pm * BM + wr * 64 + fr, col0 = u.pn * BM + wc * 32 + 8 * fq;
        float rsv[2][4];
#pragma unroll
        for (int ai = 0; ai < 2; ++ai)
#pragma unroll
            for (int m = 0; m < 4; ++m) rsv[ai][m] = rsb[u.ord * 256 + wr * 64 + fr + ai * HALF + m * 16] * sc;
#pragma unroll
        for (int ai = 0; ai < 2; ++ai)
#pragma unroll
            for (int m = 0; m < 4; ++m) {
                const int r = row0 + ai * HALF + m * 16; const float rs = rsv[ai][m];
                bf16_t* rowp = O + (size_t)r * DIN + col0;
                if (u.pn >= PC_G / 256) {
#pragma unroll
                    for (int bj = 0; bj < 2; ++bj) { f32x4 v0 = acc[ai][bj][m][0] * rs, v1 = acc[ai][bj][m][1] * rs;
                        { const f32x4 x0 = v0 * -1.4426950408889634f, x1 = v1 * -1.4426950408889634f; f32x4 e0, e1, s0, s1;
                          e0.x = __builtin_amdgcn_exp2f(x0.x); e0.y = __builtin_amdgcn_exp2f(x0.y); e0.z = __builtin_amdgcn_exp2f(x0.z); e0.w = __builtin_amdgcn_exp2f(x0.w);
                          e1.x = __builtin_amdgcn_exp2f(x1.x); e1.y = __builtin_amdgcn_exp2f(x1.y); e1.z = __builtin_amdgcn_exp2f(x1.z); e1.w = __builtin_amdgcn_exp2f(x1.w);
                          const f32x4 d0 = e0 + 1.0f, d1 = e1 + 1.0f;
                          s0.x = __builtin_amdgcn_rcpf(d0.x); s0.y = __builtin_amdgcn_rcpf(d0.y); s0.z = __builtin_amdgcn_rcpf(d0.z); s0.w = __builtin_amdgcn_rcpf(d0.w);
                          s1.x = __builtin_amdgcn_rcpf(d1.x); s1.y = __builtin_amdgcn_rcpf(d1.y); s1.z = __builtin_amdgcn_rcpf(d1.z); s1.w = __builtin_amdgcn_rcpf(d1.w);
                          v0 = v0 * s0; v1 = v1 * s1; }
                        const int c = col0 - PC_G + bj * HALF, hd = c >> 7, vt = (c >> 5) & 3, g = (c >> 3) & 3;
                        u32x2* gp = (u32x2*)GT + ((size_t)((hd * 512 + (r >> 5)) * 16 + vt * 4 + g)) * 64 + (r & 31);
                        u32x2 w0; w0.x = cvt_pk_bf16(v0[0], v0[1]); w0.y = cvt_pk_bf16(v0[2], v0[3]); gp[0] = w0;
                        u32x2 w1; w1.x = cvt_pk_bf16(v1[0], v1[1]); w1.y = cvt_pk_bf16(v1[2], v1[3]); gp[32] = w1; }
                } else {
#pragma unroll
                for (int bj = 0; bj < 2; ++bj) { const f32x4 v0 = acc[ai][bj][m][0] * rs, v1 = acc[ai][bj][m][1] * rs;
                    u32x4 w; w.x = cvt_pk_bf16(v0[0], v0[1]); w.y = cvt_pk_bf16(v0[2], v0[3]); w.z = cvt_pk_bf16(v1[0], v1[1]); w.w = cvt_pk_bf16(v1[2], v1[3]);
                    *(u32x4*)(rowp + bj * HALF) = w; }
                }
            }
    }
};
template <int F8S>
struct EpiResid {
    static constexpr bool PERM = true, PRELOAD = true;
    bf16_t* hb; float* ssq; unsigned char* hb8;
    __device__ __forceinline__ void preload(f32x4 (&acc)[2][2][4][2], const Unit& u, int wr, int wc, int fr, int fq) const {
        const int row0 = u.pm * BM + wr * 64 + fr, col0 = u.pn * BM + wc * 32 + 8 * fq;
#pragma unroll
        for (int ai = 0; ai < 2; ++ai)
#pragma unroll
            for (int m = 0; m < 4; ++m)
#pragma unroll
                for (int bj = 0; bj < 2; ++bj) { const u32x4 w = *(const u32x4*)(hb + (size_t)(row0 + ai * HALF + m * 16) * D + col0 + bj * HALF);
                    acc[ai][bj][m][0] = (f32x4){bflo(w.x), bfhi(w.x), bflo(w.y), bfhi(w.y)}; acc[ai][bj][m][1] = (f32x4){bflo(w.z), bfhi(w.z), bflo(w.w), bfhi(w.w)};
                    if constexpr (F8S != 0) { acc[ai][bj][m][0] *= (float)F8S; acc[ai][bj][m][1] *= (float)F8S; } }
    }
    __device__ __forceinline__ void operator()(const f32x4 (&acc)[2][2][4][2], const Unit& u, int wr, int wc, int fr, int fq) const {
        const int row0 = u.pm * BM + wr * 64 + fr, col0 = u.pn * BM + wc * 32 + 8 * fq, ln_ = fq * 16 + fr;
#pragma unroll
        for (int ai = 0; ai < 2; ++ai) {
            u32x2 w8[4][2];
#pragma unroll
            for (int m = 0; m < 4; ++m) {
                const int r = row0 + ai * HALF + m * 16; const size_t ro = (size_t)r * D + col0; float ss = 0.f;
#pragma unroll
                for (int bj = 0; bj < 2; ++bj) { const size_t o = ro + bj * HALF;
                    const f32x4 h0 = F8S ? acc[ai][bj][m][0] * (1.0f / (F8S ? F8S : 1)) : acc[ai][bj][m][0], h1 = F8S ? acc[ai][bj][m][1] * (1.0f / (F8S ? F8S : 1)) : acc[ai][bj][m][1];
                    u32x4 w; w.x = cvt_pk_bf16(h0[0], h0[1]); w.y = cvt_pk_bf16(h0[2], h0[3]); w.z = cvt_pk_bf16(h1[0], h1[1]); w.w = cvt_pk_bf16(h1[2], h1[3]); *(u32x4*)(hb + o) = w;
                    if (hb8) { w8[m][bj].x = pk4_f8(h0[0], h0[1], h0[2], h0[3]); w8[m][bj].y = pk4_f8(h1[0], h1[1], h1[2], h1[3]); }
                    ss += ((h0[0] * h0[0] + h0[1] * h0[1]) + (h0[2] * h0[2] + h0[3] * h0[3])) + ((h1[0] * h1[0] + h1[1] * h1[1]) + (h1[2] * h1[2] + h1[3] * h1[3])); }
                ss += shx(ss, 16, ln_); ss += shx(ss, 32, ln_);
                if (fq == 0) ssq[(size_t)r * 16 + u.pn * 4 + wc] = ss;
            }
            if (hb8) {
#pragma unroll
                for (int p = 0; p < 2; ++p)
#pragma unroll
                    for (int bj = 0; bj < 2; ++bj) { const int r = row0 + ai * HALF + (2 * p + (fq & 1)) * 16;
                        *(u32x4*)(hb8 + (size_t)r * D + col0 - 8 * (fq & 1) + bj * HALF) = pair16(w8[2 * p][bj], w8[2 * p + 1][bj]); }
            }
        }
    }
};
template <bool F8O>
struct EpiSwiglu {
    static constexpr bool PERM = true, PRELOAD = false;
    unsigned char* O; const LAS float* rsb;
    __device__ __forceinline__ void operator()(const f32x4 (&acc)[2][2][4][2], const Unit& u, int wr, int wc, int fr, int fq) const {
        const int row0 = u.pm * BM + wr * 64 + fr, col0 = u.pn * HALF + wc * 32 + 8 * fq;
        float rsv[2][4];
#pragma unroll
        for (int ai = 0; ai < 2; ++ai)
#pragma unroll
            for (int m = 0; m < 4; ++m) rsv[ai][m] = rsb[u.ord * 256 + wr * 64 + fr + ai * HALF + m * 16] * (F8O ? 0.03125f : 1.0f);
#pragma unroll
        for (int ai = 0; ai < 2; ++ai) {
            if constexpr (F8O) {
                u32x2 w8[4];
#pragma unroll
                for (int m = 0; m < 4; ++m) {
                    f32x4 o0, o1; swiglu8f(acc[ai][0][m][0], acc[ai][0][m][1], acc[ai][1][m][0], acc[ai][1][m][1], rsv[ai][m], 4.0f, o0, o1);
                    w8[m].x = pk4_f8(o0.x, o0.y, o0.z, o0.w); w8[m].y = pk4_f8(o1.x, o1.y, o1.z, o1.w); }
#pragma unroll
                for (int p = 0; p < 2; ++p) { const int r = row0 + ai * HALF + (2 * p + (fq & 1)) * 16;
                    *(u32x4*)(O + (size_t)r * DFF + col0 - 8 * (fq & 1)) = pair16(w8[2 * p], w8[2 * p + 1]); }
            } else {
#pragma unroll
                for (int m = 0; m < 4; ++m) { const int r = row0 + ai * HALF + m * 16;
                    u32x4 w; swiglu8(acc[ai][0][m][0], acc[ai][0][m][1], acc[ai][1][m][0], acc[ai][1][m][1], rsv[ai][m], w);
                    *(u32x4*)((bf16_t*)O + (size_t)r * DFF + col0) = w; }
            }
        }
    }
};
struct EpiSwigluMoe {
    static constexpr bool PERM = true, PRELOAD = false;
    unsigned char* O; const float* rstd_tok; const LAS int* tkb;
    __device__ __forceinline__ void operator()(const f32x4 (&acc)[2][2][4][2], const Unit& u, int wr, int wc, int fr, int fq) const {
        const int trow0 = wr * 64 + fr, col0 = u.pn * HALF + wc * 32 + 8 * fq;
        float rsv[2][4];
#pragma unroll
        for (int ai = 0; ai < 2; ++ai)
#pragma unroll
            for (int m = 0; m < 4; ++m) rsv[ai][m] = bfhi((unsigned)tkb[u.ord * 256 + trow0 + ai * HALF + m * 16]) * 0.03125f;
#pragma unroll
        for (int ai = 0; ai < 2; ++ai) {
            u32x2 w[4];
#pragma unroll
            for (int m = 0; m < 4; ++m) {
                f32x4 o0, o1; swiglu8f(acc[ai][0][m][0], acc[ai][0][m][1], acc[ai][1][m][0], acc[ai][1][m][1], rsv[ai][m], 4.0f, o0, o1);
                w[m].x = pk4_f8(o0.x, o0.y, o0.z, o0.w); w[m].y = pk4_f8(o1.x, o1.y, o1.z, o1.w); }
#pragma unroll
            for (int p = 0; p < 2; ++p) { const int tr = trow0 + ai * HALF + (2 * p + (fq & 1)) * 16;
                *(u32x4*)(O + (size_t)(u.pm * BM + tr) * DFF + col0 - 8 * (fq & 1)) = pair16(w[2 * p], w[2 * p + 1]); }
        }
    }
};
struct EpiMoeOut {
    static constexpr bool PERM = true, PRELOAD = false;
    unsigned char* O; const LAS float* gb;
    __device__ __forceinline__ void operator()(const f32x4 (&acc)[2][2][4][2], const Unit& u, int wr, int wc, int fr, int fq) const {
        const int trow0 = wr * 64 + fr, col0 = u.pn * BM + wc * 32 + 8 * fq;
        float gv[2][4];
#pragma unroll
        for (int ai = 0; ai < 2; ++ai)
#pragma unroll
            for (int m = 0; m < 4; ++m) gv[ai][m] = gb[u.ord * 256 + trow0 + ai * HALF + m * 16] * (16.0f / 256.0f);
#pragma unroll
        for (int ai = 0; ai < 2; ++ai) {
            u32x2 w8[4][2];
#pragma unroll
            for (int m = 0; m < 4; ++m) { const float g = gv[ai][m];
#pragma unroll
                for (int bj = 0; bj < 2; ++bj) { const f32x4 v0 = acc[ai][bj][m][0] * g, v1 = acc[ai][bj][m][1] * g;
                    w8[m][bj].x = pk4_f8(v0[0], v0[1], v0[2], v0[3]); w8[m][bj].y = pk4_f8(v1[0], v1[1], v1[2], v1[3]); } }
#pragma unroll
            for (int p = 0; p < 2; ++p)
#pragma unroll
                for (int bj = 0; bj < 2; ++bj) { const int tr = trow0 + ai * HALF + (2 * p + (fq & 1)) * 16;
                    *(u32x4*)(O + (size_t)(u.pm * BM + tr) * D + col0 - 8 * (fq & 1) + bj * HALF) = pair16(w8[2 * p][bj], w8[2 * p + 1][bj]); }
        }
    }
};
struct EpiMoeTail {
    static constexpr bool PERM = true, PRELOAD = false;
    bf16_t* O; const LAS float* gb;
    __device__ __forceinline__ void operator()(const f32x4 (&acc)[2][2][4][2], const Unit& u, int wr, int wc, int fr, int fq) const {
        const int trow0 = wr * 64 + fr, col0 = wc * 32 + 8 * fq;
#pragma unroll
        for (int ai = 0; ai < 2; ++ai)
#pragma unroll
            for (int m = 0; m < 4; ++m) {
                const int tr = trow0 + ai * HALF + m * 16; const float g = gb[tr] * (1.0f / 256.0f);
                bf16_t* rowp = O + (size_t)tr * 256 + col0;
#pragma unroll
                for (int bj = 0; bj < 2; ++bj) { const f32x4 v0 = acc[ai][bj][m][0] * g, v1 = acc[ai][bj][m][1] * g;
                    u32x4 w; w.x = cvt_pk_bf16(v0[0], v0[1]); w.y = cvt_pk_bf16(v0[2], v0[3]); w.z = cvt_pk_bf16(v1[0], v1[1]); w.w = cvt_pk_bf16(v1[2], v1[3]);
                    *(u32x4*)(rowp + bj * HALF) = w; }
            }
    }
};
}

#define XB_TMO      128
#define XB_XCNT(j)  (256  + 64 * (j))
#define XB_XSUB(j)  (1280 + 64 * (j))
#define XB_XGEN(j)  (2304 + 64 * (j))
#define XB_TOP      3328
#define XB_TOPGEN   3392
#define XCD_BAR_WORDS 3456
#define XB_SPIN_CAP (1u << 18)
__device__ __forceinline__ unsigned xb_ld(unsigned* p)              { return __hip_atomic_load(p, __ATOMIC_RELAXED, __HIP_MEMORY_SCOPE_AGENT); }
__device__ __forceinline__ unsigned xb_add(unsigned* p, unsigned v) { return __hip_atomic_fetch_add(p, v, __ATOMIC_RELAXED, __HIP_MEMORY_SCOPE_AGENT); }
__device__ __forceinline__ unsigned xb_xcc_id() { return (unsigned)__builtin_amdgcn_s_getreg((3 << 11) | 20) & 0xFu; }
#define XB_SPIN(cond, bar) do { unsigned _sp = 0; while (cond) { __builtin_amdgcn_s_sleep(1); \
    if ((++_sp & 255u) == 0u) { if (xb_ld(&(bar)[XB_TMO])) break; if (_sp > XB_SPIN_CAP) { atomicAdd(&(bar)[XB_TMO], 1u); break; } } } } while (0)
struct XcdBarrier { unsigned* bar; unsigned x; volatile LAS unsigned* st; };
__device__ __forceinline__ XcdBarrier xcd_barrier_post(unsigned* bar, volatile LAS unsigned* st) {
    XcdBarrier b; b.bar = bar; b.x = xb_xcc_id(); b.st = st;
    if (threadIdx.x == 0) (void)xb_add(&bar[XB_XCNT(b.x)], 1u);
    return b;
}
__device__ __forceinline__ void xcd_barrier_complete(unsigned* bar, unsigned x, unsigned& nloc, unsigned& nx) {
    const unsigned G = gridDim.x * gridDim.y * gridDim.z;
    unsigned sum, cnt, mine, sp = 0u;
    for (;;) {
        sum = 0u; cnt = 0u; mine = 0u;
#pragma unroll
        for (unsigned j = 0; j < 16; ++j) { const unsigned c = xb_ld(&bar[XB_XCNT(j)]); sum += c; cnt += (c > 0u) ? 1u : 0u; }
        mine = xb_ld(&bar[XB_XCNT(x)]);
        if (sum == G) break;
        __builtin_amdgcn_s_sleep(1);
        if ((++sp & 255u) == 0u) { if (xb_ld(&bar[XB_TMO])) break; if (sp > XB_SPIN_CAP) { atomicAdd(&bar[XB_TMO], 1u); break; } }
    }
    nloc = mine > 0u ? mine : 1u; nx = cnt > 0u ? cnt : 1u;
}
__device__ __forceinline__ void xcd_barrier(const XcdBarrier& b) {
    asm volatile("s_waitcnt vmcnt(0)" ::: "memory");
    __syncthreads();
    if (threadIdx.x == 0) {
        unsigned* bar = b.bar;
        __builtin_amdgcn_s_waitcnt(0);
        unsigned nloc = b.st[0], nx = b.st[1];
        if (nloc == 0u) { xcd_barrier_complete(bar, b.x, nloc, nx); b.st[0] = nloc; b.st[1] = nx; }
        const unsigned old = xb_add(&bar[XB_XSUB(b.x)], 1u);
        const unsigned gen = old / nloc;
        if (old + 1u == (gen + 1u) * nloc) {
            __builtin_amdgcn_fence(__ATOMIC_RELEASE, "agent");
            asm volatile("s_waitcnt vmcnt(0)" ::: "memory");
            const unsigned og = xb_add(&bar[XB_TOP], 1u);
            const unsigned tgt = (og / nx + 1u) * nx;
            if (og + 1u != tgt) XB_SPIN(xb_ld(&bar[XB_TOP]) < tgt, bar);
            __builtin_amdgcn_fence(__ATOMIC_ACQUIRE, "agent");
            xb_add(&bar[XB_XGEN(b.x)], 1u);
            asm volatile("s_waitcnt vmcnt(0)" ::: "memory");
        } else {
            XB_SPIN(xb_ld(&bar[XB_XGEN(b.x)]) == gen, bar);
            __builtin_amdgcn_fence(__ATOMIC_ACQUIRE, "agent");
            asm volatile("s_waitcnt vmcnt(0)" ::: "memory");
        }
    }
    __syncthreads();
}

struct Args { const float* in[27]; float* out; unsigned char* ws; int ph_lo, ph_hi; };
static_assert(sizeof(Args) == 27 * 8 + 8 + 8 + 8, "Args has no padding");
enum { I_X = 0, I_ATTN_NORM, I_FFN_NORM, I_FINAL_NORM, I_W_IN, I_W_OUT, I_S5_LRE, I_S5_LIM, I_S5_LOGDT, I_S5_BRE, I_S5_BIM, I_S5_CRE, I_S5_CIM, I_S5_D, I_S5_GLU, I_S5_ONORM,
       I_CONV_W, I_CONV_ONORM, I_HG_LB, I_HG_ONORM, I_FFN_W1, I_FFN_W3, I_FFN_W2, I_MOE_ROUTER, I_MOE_W1, I_MOE_W3, I_MOE_W2 };

struct Ctx {
    LAS unsigned char* lds; int tid, lane, wave, G, bid;
    const float* const* in; float* out; unsigned char* ws;
};

struct P0Item { const float* W; bf16_t* WT; const float* gain; int K, N, map, item; float f8s; };
__device__ __forceinline__ void p0_resolve(const float* const* in, unsigned char* ws, int it, P0Item& d) {
    constexpr int IT_IN = 16 * 96, IT_OUT = 16 * 32, IT_GLU = 4 * 8, IT_FF = 16 * 112;
    constexpr int S0 = 4 * IT_IN, S1 = S0 + 4 * IT_OUT, S2 = S1 + 4 * IT_GLU, S3 = S2 + 2 * IT_FF, S4 = S3 + 2 * IT_FF, S5 = S4 + 2 * IT_FF, S6 = S5 + 16 * IT_FF, S7 = S6 + 16 * IT_FF;
    d.gain = nullptr; d.map = 0; d.f8s = 0.f;
    if (it < S0) { const int l = it / IT_IN; d.item = it % IT_IN; d.W = in[I_W_IN] + (size_t)l * D * DIN; d.K = D; d.N = DIN; d.WT = (bf16_t*)(ws + WS_WIN) + (size_t)l * DIN * D; d.gain = in[I_ATTN_NORM] + l * D; d.f8s = ((F8_IN >> l) & 1) ? 32.f : 0.f; }
    else if (it < S1) { const int q = it - S0, l = q / IT_OUT; d.item = q % IT_OUT; d.W = in[I_W_OUT] + (size_t)l * D * D; d.K = D; d.N = D; d.WT = (bf16_t*)(ws + WS_WOUT) + (size_t)l * D * D; d.f8s = ((F8_OUT >> l) & 1) ? 32.f : 0.f; }
    else if (it < S2) { const int q = it - S1, l = q / IT_GLU; d.item = q % IT_GLU; d.W = in[I_S5_GLU] + (size_t)l * 256 * 256; d.K = 256; d.N = 256; d.WT = (bf16_t*)(ws + WS_GLU) + (size_t)l * 256 * 256; }
    else if (it < S3) { const int q = it - S2, j = q / IT_FF; d.item = q % IT_FF; d.W = in[I_FFN_W1] + (size_t)j * D * DFF; d.K = D; d.N = DFF; d.WT = (bf16_t*)(ws + WS_W13 + (size_t)j * 2 * DFF * D * 2); d.map = 1; d.gain = in[I_FFN_NORM] + (2 * j) * D; d.f8s = ((F8_FFN >> (2 * j)) & 1) ? 32.f : 0.f; }
    else if (it < S4) { const int q = it - S3, j = q / IT_FF; d.item = q % IT_FF; d.W = in[I_FFN_W3] + (size_t)j * D * DFF; d.K = D; d.N = DFF; d.WT = (bf16_t*)(ws + WS_W13 + (size_t)j * 2 * DFF * D * 2); d.map = 2; d.gain = in[I_FFN_NORM] + (2 * j) * D; d.f8s = ((F8_FFN >> (2 * j)) & 1) ? 32.f : 0.f; }
    else if (it < S5) { const int q = it - S4, j = q / IT_FF; d.item = q % IT_FF; d.W = in[I_FFN_W2] + (size_t)j * DFF * D; d.K = DFF; d.N = D; d.WT = (bf16_t*)(ws + WS_W2 + (size_t)j * D * DFF * 2); d.f8s = ((F8_FFN >> (2 * j)) & 1) ? 64.f : 0.f; }
    else if (it < S6) { const int q = it - S5, je = q / IT_FF, j = je >> 3; d.item = q % IT_FF; d.W = in[I_MOE_W1] + (size_t)je * D * DFF; d.K = D; d.N = DFF; d.WT = (bf16_t*)(ws + WS_MW13 + (size_t)je * 2 * DFF * D); d.map = 1; d.gain = in[I_FFN_NORM] + (2 * j + 1) * D; d.f8s = 32.f; }
    else if (it < S7) { const int q = it - S6, je = q / IT_FF, j = je >> 3; d.item = q % IT_FF; d.W = in[I_MOE_W3] + (size_t)je * D * DFF; d.K = D; d.N = DFF; d.WT = (bf16_t*)(ws + WS_MW13 + (size_t)je * 2 * DFF * D); d.map = 2; d.gain = in[I_FFN_NORM] + (2 * j + 1) * D; d.f8s = 32.f; }
    else { const int q = it - S7, je = q / IT_FF; d.item = q % IT_FF; d.W = in[I_MOE_W2] + (size_t)je * DFF * D; d.K = DFF; d.N = D; d.WT = (bf16_t*)(ws + WS_MW2 + (size_t)je * D * DFF); d.f8s = 64.f; }
}
__device__ __forceinline__ void p0_load(const P0Item& d, float (&v)[32], int lane) {
    const int nblk = d.N / 32, kb = d.item / nblk, nb = d.item % nblk, k0 = 64 * kb, n0 = 32 * nb;
    const float* p = d.W + (size_t)(k0 + (lane >> 5)) * d.N + n0 + (lane & 31);
#pragma unroll
    for (int i = 0; i < 32; ++i) v[i] = p[(size_t)(2 * i) * d.N];
}
__device__ __forceinline__ void p0_store(const P0Item& d, const float (&v)[32], LAS float* scr, int lane) {
    const int nblk = d.N / 32, kb = d.item / nblk, nb = d.item % nblk, k0 = 64 * kb, n0 = 32 * nb;
    const float sc = (d.f8s != 0.f) ? d.f8s : 1.0f;
    if (d.gain) {
#pragma unroll
        for (int i = 0; i < 32; ++i) scr[(2 * i + (lane >> 5)) * 33 + (lane & 31)] = v[i] * (d.gain[k0 + 2 * i + (lane >> 5)] * sc);
    } else {
#pragma unroll
        for (int i = 0; i < 32; ++i) scr[(2 * i + (lane >> 5)) * 33 + (lane & 31)] = v[i] * sc;
    }
    asm volatile("s_waitcnt lgkmcnt(0)" ::: "memory");
    if (d.f8s != 0.f) {
        const int c = lane & 3;
#pragma unroll
        for (int j = 0; j < 2; ++j) { const int n = n0 + (lane >> 2) + 16 * j; const LAS float* s = scr + (16 * c) * 33 + (lane >> 2) + 16 * j;
            const int drow = (d.map == 0) ? n : ((n >> 7) * 256 + (n & 127) + (d.map == 2 ? 128 : 0));
            u32x4 o; o.x = pk4_f8(s[0 * 33], s[1 * 33], s[2 * 33], s[3 * 33]); o.y = pk4_f8(s[4 * 33], s[5 * 33], s[6 * 33], s[7 * 33]);
            o.z = pk4_f8(s[8 * 33], s[9 * 33], s[10 * 33], s[11 * 33]); o.w = pk4_f8(s[12 * 33], s[13 * 33], s[14 * 33], s[15 * 33]);
            *(u32x4*)((unsigned char*)d.WT + (size_t)drow * d.K + k0 + 16 * c) = o; }
        asm volatile("s_waitcnt lgkmcnt(0)" ::: "memory");
        return;
    }
    const int c = lane & 7;
#pragma unroll
    for (int j = 0; j < 4; ++j) { const int n = n0 + (lane >> 3) + 8 * j; const LAS float* s = scr + (8 * c) * 33 + (lane >> 3) + 8 * j;
        const int drow = (d.map == 0) ? n : ((n >> 7) * 256 + (n & 127) + (d.map == 2 ? 128 : 0));
        u32x4 o; o.x = pg8::cvt_pk_bf16(s[0 * 33], s[1 * 33]); o.y = pg8::cvt_pk_bf16(s[2 * 33], s[3 * 33]); o.z = pg8::cvt_pk_bf16(s[4 * 33], s[5 * 33]); o.w = pg8::cvt_pk_bf16(s[6 * 33], s[7 * 33]);
        *(u32x4*)(d.WT + (size_t)drow * d.K + k0 + 8 * c) = o; }
    asm volatile("s_waitcnt lgkmcnt(0)" ::: "memory");
}
__device__ __forceinline__ void p0_prologue(Ctx& F) {
    LAS float* scr = (LAS float*)(F.lds + F.wave * 16384);
    const int gw = F.bid * 8 + F.wave, NGW = F.G * 8;
    const float* const* in = F.in; unsigned char* ws = F.ws;
    constexpr int IT_IN = 16 * 96, IT_OUT = 16 * 32, IT_GLU = 4 * 8, IT_FF = 16 * 112;
    constexpr int S8 = 4 * IT_IN + 4 * IT_OUT + 4 * IT_GLU + 6 * IT_FF + 48 * IT_FF;
    {
        P0Item d0, d1; float v0[32], v1[32];
        int it = gw;
        if (it < S8) { p0_resolve(in, ws, it, d0); p0_load(d0, v0, F.lane); }
        for (; it < S8; it += 2 * NGW) {
            const int it1 = it + NGW, it2 = it + 2 * NGW;
            if (it1 < S8) { p0_resolve(in, ws, it1, d1); p0_load(d1, v1, F.lane); }
            p0_store(d0, v0, scr, F.lane);
            if (it1 < S8) {
                if (it2 < S8) { p0_resolve(in, ws, it2, d0); p0_load(d0, v0, F.lane); }
                p0_store(d1, v1, scr, F.lane);
            }
        }
    }
    bf16_t* hb = (bf16_t*)(ws + WS_HB); float* ssq = (float*)(ws + WS_SSQ);
    for (int mb = gw * 4; mb < T; mb += NGW * 4) {
        f32x4 v[4][4]; float sq[4];
#pragma unroll
        for (int k = 0; k < 4; ++k)
#pragma unroll
            for (int j = 0; j < 4; ++j) v[k][j] = *((const f32x4*)(in[I_X] + (size_t)(mb + k) * D) + F.lane + 64 * j);
#pragma unroll
        for (int k = 0; k < 4; ++k) { sq[k] = 0.f; u32x2* o8 = (u32x2*)(hb + (size_t)(mb + k) * D) + F.lane;
#pragma unroll
            for (int j = 0; j < 4; ++j) { const f32x4 x = v[k][j]; sq[k] += (x.x * x.x + x.y * x.y) + (x.z * x.z + x.w * x.w); u32x2 w; w.x = pk2(x.x, x.y); w.y = pk2(x.z, x.w); o8[64 * j] = w;
                if (F8_IN & 1) *((unsigned*)(ws + WS_HB8 + (size_t)(mb + k) * D) + F.lane + 64 * j) = pk4_f8(x.x, x.y, x.z, x.w); } }
#pragma unroll
        for (int o = 1; o < 64; o <<= 1) {
#pragma unroll
            for (int k = 0; k < 4; ++k) sq[k] += shx(sq[k], o, F.lane); }
#pragma unroll
        for (int k = 0; k < 4; ++k) if (F.lane < 16) ssq[(size_t)(mb + k) * 16 + F.lane] = (F.lane == 0) ? sq[k] : 0.f;
    }
    float* tab = (float*)(ws + WS_TAB);
    const int gt = F.bid * 512 + F.tid, NGT = F.G * 512;
    for (int i = gt; i < 512; i += NGT) {
        const float* lb = in[I_HG_LB]; const float a0 = lb[i], a1 = lb[512 + i], a2 = lb[1024 + i], a3 = lb[1536 + i];
        const float mx = fmaxf(fmaxf(a0, a1), fmaxf(a2, a3)); const float e0 = expf(a0 - mx), e1 = expf(a1 - mx), e2 = expf(a2 - mx), e3 = expf(a3 - mx);
        const float inv = 1.f / (((e0 + e1) + e2) + e3); const float s1 = e1 * inv, s2 = e2 * inv, s3 = e3 * inv;
        const float hi = 1.0f - 1e-6f;
        tab[TB_LBC + i] = 0.f; tab[TB_LBC + 512 + i] = fminf(fmaxf(s1, 0.f), hi); tab[TB_LBC + 1024 + i] = fminf(fmaxf(s1 + s2, 0.f), hi); tab[TB_LBC + 1536 + i] = fminf(fmaxf((s1 + s2) + s3, 0.f), hi);
    }
    for (int i = gt; i < 4 * 16 * 64; i += NGT) {
        const int lg = i >> 6;
        const float lre = in[I_S5_LRE][i], lim = in[I_S5_LIM][i], dt = expf(in[I_S5_LOGDT][lg]);
        const float er = expf(lre * dt), lbr = er * cosf(lim * dt), lbi = er * sinf(lim * dt);
        tab[TB_LAMB + 2 * i] = lbr; tab[TB_LAMB + 2 * i + 1] = lbi;
        const float den = 1.f / (lre * lre + lim * lim), nr = lbr - 1.f, ni = lbi;
        const float cr = (nr * lre + ni * lim) * den, ci = (ni * lre - nr * lim) * den;
        bf16_t* bbi = (bf16_t*)(ws + WS_BB); bf16_t* cmi = (bf16_t*)(ws + WS_CM); const int p = i & 63;
        for (int c = 0; c < 16; ++c) { const float br = in[I_S5_BRE][(size_t)i * 16 + c], bi = in[I_S5_BIM][(size_t)i * 16 + c];
            const float vr = cr * br - ci * bi, vi = cr * bi + ci * br;
            tab[TB_BBAR + ((size_t)i * 16 + c) * 2] = vr; tab[TB_BBAR + ((size_t)i * 16 + c) * 2 + 1] = vi;
            bbi[((size_t)lg * 128 + 2 * p) * 16 + c] = (bf16_t)f2bf(vr); bbi[((size_t)lg * 128 + 2 * p + 1) * 16 + c] = (bf16_t)f2bf(vi);
            cmi[((size_t)lg * 16 + c) * 128 + 2 * p] = (bf16_t)f2bf(in[I_S5_CRE][((size_t)lg * 16 + c) * 64 + p]);
            cmi[((size_t)lg * 16 + c) * 128 + 2 * p + 1] = (bf16_t)f2bf(-in[I_S5_CIM][((size_t)lg * 16 + c) * 64 + p]); }
    }
    for (int i = gt; i < 4 * 16 * 64 * 64; i += NGT) {
        const int sidx = i & 63, lgp = i >> 6, lg = lgp >> 6, p = lgp & 63;
        const float lre = in[I_S5_LRE][lgp], lim = in[I_S5_LIM][lgp], dt = expf(in[I_S5_LOGDT][lg]);
        const float er = expf(lre * dt), lbr = er * cosf(lim * dt), lbi = er * sinf(lim * dt);
        const float den = 1.f / (lre * lre + lim * lim), nr = lbr - 1.f, ni = lbi;
        const float cr = (nr * lre + ni * lim) * den, ci = (ni * lre - nr * lim) * den;
        const float tau = (float)(63 - sidx), pe = expf(tau * lre * dt), pr = pe * cosf(tau * lim * dt), pi = pe * sinf(tau * lim * dt);
        const float wr = pr * cr - pi * ci, wi = pr * ci + pi * cr;
        unsigned ore[8], oim[8];
#pragma unroll
        for (int c2 = 0; c2 < 8; ++c2) { const float b0r = in[I_S5_BRE][(size_t)lgp * 16 + 2 * c2], b0i = in[I_S5_BIM][(size_t)lgp * 16 + 2 * c2], b1r = in[I_S5_BRE][(size_t)lgp * 16 + 2 * c2 + 1], b1i = in[I_S5_BIM][(size_t)lgp * 16 + 2 * c2 + 1];
            ore[c2] = pk2(wr * b0r - wi * b0i, wr * b1r - wi * b1i); oim[c2] = pk2(wr * b0i + wi * b0r, wr * b1i + wi * b1r); }
        bf16_t* vt = (bf16_t*)(ws + WS_VT) + ((size_t)lg * 128 + 2 * p) * 1024 + sidx * 16;
        *(u32x4*)vt = (u32x4){ore[0], ore[1], ore[2], ore[3]}; *(u32x4*)(vt + 8) = (u32x4){ore[4], ore[5], ore[6], ore[7]};
        *(u32x4*)(vt + 1024) = (u32x4){oim[0], oim[1], oim[2], oim[3]}; *(u32x4*)(vt + 1024 + 8) = (u32x4){oim[4], oim[5], oim[6], oim[7]};
    }
    for (int i = gt; i < 2 * 8 * 1024; i += NGT) {
        const int j = i >> 13, e = (i >> 10) & 7, k = i & 1023;
        tab[TB_RG + i] = in[I_MOE_ROUTER][((size_t)j * D + k) * NE + e] * in[I_FFN_NORM][(2 * j + 1) * D + k];
    }
}

__device__ __forceinline__ void conv_phase(Ctx& F, int l) {
    const bf16_t* proj = (const bf16_t*)(F.ws + WS_PROJ); bf16_t* mix = (bf16_t*)(F.ws + WS_MIX);
    const float* cw = F.in[I_CONV_W] + l * 3 * CW; const float* gn = F.in[I_CONV_ONORM] + l * CW;
    const int c = 4 * F.lane;
    const f32x4 w0 = *(const f32x4*)(cw + c), w1 = *(const f32x4*)(cw + CW + c), w2 = *(const f32x4*)(cw + 2 * CW + c), g = *(const f32x4*)(gn + c);
    const int gw = F.bid * 8 + F.wave, NGW = F.G * 8;
    for (int tb = gw * 8; tb < T; tb += NGW * 8) {
        u32x2 ra[10], rb[10], rg[8];
#pragma unroll
        for (int j = 0; j < 10; ++j) { const int tt = tb - 2 + j; ra[j] = (u32x2){0u, 0u}; rb[j] = (u32x2){0u, 0u};
            if (tt >= 0) { const bf16_t* row = proj + (size_t)tt * DIN; ra[j] = *(const u32x2*)(row + PC_CC + c); rb[j] = *(const u32x2*)(row + PC_CV + c); } }
#pragma unroll
        for (int j = 0; j < 8; ++j) rg[j] = *(const u32x2*)(proj + (size_t)(tb + j) * DIN + PC_CB + c);
        f32x4 z[10];
#pragma unroll
        for (int j = 0; j < 10; ++j) z[j] = (f32x4){bflo(ra[j].x) * bflo(rb[j].x), bfhi(ra[j].x) * bfhi(rb[j].x), bflo(ra[j].y) * bflo(rb[j].y), bfhi(ra[j].y) * bfhi(rb[j].y)};
        f32x4 y[8]; float ss[8];
#pragma unroll
        for (int j = 0; j < 8; ++j) { y[j] = (z[j] * w0 + z[j + 1] * w1 + z[j + 2] * w2) * (f32x4){bflo(rg[j].x), bfhi(rg[j].x), bflo(rg[j].y), bfhi(rg[j].y)};
            ss[j] = (y[j].x * y[j].x + y[j].y * y[j].y) + (y[j].z * y[j].z + y[j].w * y[j].w); }
#pragma unroll
        for (int o = 1; o < 64; o <<= 1) {
#pragma unroll
            for (int j = 0; j < 8; ++j) ss[j] += shx(ss[j], o, F.lane); }
#pragma unroll
        for (int j = 0; j < 8; ++j) { const float rs = __builtin_amdgcn_rsqf(ss[j] * (1.f / CW) + NORM_EPS); const f32x4 v = y[j] * rs * g;
            if ((F8_OUT >> l) & 1) *(unsigned*)(F.ws + WS_MIX8 + (size_t)(tb + j) * D + 256 + c) = pk4_f8(v.x, v.y, v.z, v.w);
            else { u32x2 o; o.x = pk2(v.x, v.y); o.y = pk2(v.z, v.w); *(u32x2*)(mix + (size_t)(tb + j) * D + 256 + c) = o; } }
    }
}

#if 1
__device__ __forceinline__ void ref_hg_prep(Ctx& F, int l) {
    const bf16_t* proj = (const bf16_t*)(F.ws + WS_PROJ); const float* lbc = (const float*)(F.ws + WS_TAB) + TB_LBC + l * 512;
    float* fv = (float*)(F.ws + SC_F); float* kv = (float*)(F.ws + SC_K); float* qv = (float*)(F.ws + SC_Q);
    const size_t gt = (size_t)F.bid * 512 + F.tid, NGT = (size_t)F.G * 512;
    for (size_t i = gt; i < (size_t)T * 512; i += NGT) {
        const int t = (int)(i >> 9), c = (int)(i & 511);
        const float fp = bf2f(proj[(size_t)t * DIN + PC_F + c]), q = bf2f(proj[(size_t)t * DIN + PC_Q + c]), lb = lbc[c];
        const float sg = 1.f / (1.f + expf(-fp));
        fv[i] = lb + (1.f - lb) * sg; kv[i] = (1.f - lb) * (1.f - sg); qv[i] = q / (1.f + expf(-q));
    }
}
__device__ __forceinline__ void ref_hg_scan(Ctx& F, int unit) {
    const bf16_t* proj = (const bf16_t*)(F.ws + WS_PROJ);
    const float* fv = (const float*)(F.ws + SC_F); const float* kv = (const float*)(F.ws + SC_K); const float* qv = (const float*)(F.ws + SC_Q); float* ov = (float*)(F.ws + SC_O);
    const int head = unit >> 1, v = (unit & 1) * 64 + F.lane;
    float S[128];
#pragma unroll
    for (int k = 0; k < 128; ++k) S[k] = 0.f;
    for (int t = 0; t < T; ++t) {
        const float iv = bf2f(proj[(size_t)t * DIN + PC_I + head * 128 + v]);
        const float* f = fv + (size_t)t * 512 + head * 128; const float* kk = kv + (size_t)t * 512 + head * 128; const float* q = qv + (size_t)t * 512 + head * 128;
        float acc = 0.f;
#pragma unroll
        for (int k = 0; k < 128; ++k) { S[k] = f[k] * S[k] + kk[k] * iv; acc += S[k] * q[k]; }
        ov[(size_t)t * 512 + head * 128 + v] = acc;
    }
}
__device__ __forceinline__ void ref_s5_scan(Ctx& F, int l, int g) {
    const bf16_t* proj = (const bf16_t*)(F.ws + WS_PROJ); const float* tab = (const float*)(F.ws + WS_TAB);
    float* y1 = (float*)(F.ws + SC_Y1);
    const int p = F.lane, lgp = (l * 16 + g) * 64 + p;
    const float lbr = tab[TB_LAMB + 2 * lgp], lbi = tab[TB_LAMB + 2 * lgp + 1];
    float Br[16], Bi[16], Cr[16], Ci[16];
#pragma unroll
    for (int c = 0; c < 16; ++c) { Br[c] = tab[TB_BBAR + ((size_t)lgp * 16 + c) * 2]; Bi[c] = tab[TB_BBAR + ((size_t)lgp * 16 + c) * 2 + 1];
        Cr[c] = F.in[I_S5_CRE][((size_t)(l * 16 + g) * 16 + c) * 64 + p]; Ci[c] = F.in[I_S5_CIM][((size_t)(l * 16 + g) * 16 + c) * 64 + p]; }
    const float dl = (F.lane < 16) ? F.in[I_S5_D][l * S5W + g * 16 + F.lane] : 0.f;
    float xr = 0.f, xi = 0.f;
    for (int t = 0; t < T; ++t) {
        const u32x4* up = (const u32x4*)(proj + (size_t)t * DIN + PC_U + g * 16); const u32x4 ua = up[0], ub = up[1];
        float u[16];
        u[0] = bflo(ua.x); u[1] = bfhi(ua.x); u[2] = bflo(ua.y); u[3] = bfhi(ua.y); u[4] = bflo(ua.z); u[5] = bfhi(ua.z); u[6] = bflo(ua.w); u[7] = bfhi(ua.w);
        u[8] = bflo(ub.x); u[9] = bfhi(ub.x); u[10] = bflo(ub.y); u[11] = bfhi(ub.y); u[12] = bflo(ub.z); u[13] = bfhi(ub.z); u[14] = bflo(ub.w); u[15] = bfhi(ub.w);
        float bur = 0.f, bui = 0.f;
#pragma unroll
        for (int c = 0; c < 16; ++c) { bur += Br[c] * u[c]; bui += Bi[c] * u[c]; }
        const float nxr = lbr * xr - lbi * xi + bur, nxi = lbr * xi + lbi * xr + bui; xr = nxr; xi = nxi;
        float my = 0.f, myu = 0.f;
#pragma unroll
        for (int c = 0; c < 16; ++c) { const float s = wave_sum(Cr[c] * xr - Ci[c] * xi, F.lane); if (F.lane == c) { my = s; myu = u[c]; } }
        if (F.lane < 16) y1[(size_t)t * S5W + g * 16 + F.lane] = gelu_tanh(my + dl * myu);
    }
}
__device__ __forceinline__ void ref_finalize_s5(Ctx& F, int l) {
    bf16_t* mix = (bf16_t*)(F.ws + WS_MIX);
    const float* y1 = (const float*)(F.ws + SC_Y1);
    const float* wg = F.in[I_S5_GLU] + (size_t)l * 256 * 256; const float* gs = F.in[I_S5_ONORM] + l * 256;
    const int gw = F.bid * 8 + F.wave, NGW = F.G * 8;
    for (int t = gw; t < T; t += NGW) {
        const float* yr = y1 + (size_t)t * 256; f32x4 z = (f32x4){0.f, 0.f, 0.f, 0.f};
        for (int i = 0; i < 256; ++i) { const float a = yr[i]; const f32x4 w = *(const f32x4*)(wg + (size_t)i * 256 + 4 * F.lane); z += w * a; }
        const f32x4 yv = *(const f32x4*)(yr + 4 * F.lane);
        f32x4 y2 = (f32x4){yv.x * sigmoidf_(z.x), yv.y * sigmoidf_(z.y), yv.z * sigmoidf_(z.z), yv.w * sigmoidf_(z.w)};
        const float ss = wave_sum((y2.x * y2.x + y2.y * y2.y) + (y2.z * y2.z + y2.w * y2.w), F.lane);
        const float rs = __builtin_amdgcn_rsqf(ss * (1.f / 256.f) + NORM_EPS);
        const f32x4 g = *(const f32x4*)(gs + 4 * F.lane); y2 = y2 * rs * g;
        u32x2 o; o.x = pk2(y2.x, y2.y); o.y = pk2(y2.z, y2.w); *(u32x2*)(mix + (size_t)t * D + 4 * F.lane) = o;
    }
}
__device__ __forceinline__ void ref_finalize_hg(Ctx& F, int l) {
    const bf16_t* proj = (const bf16_t*)(F.ws + WS_PROJ); bf16_t* mix = (bf16_t*)(F.ws + WS_MIX);
    const float* ov = (const float*)(F.ws + SC_O); const float* gh = F.in[I_HG_ONORM] + l * 512;
    const int gw = F.bid * 8 + F.wave, NGW = F.G * 8;
    for (int t = gw; t < T; t += NGW) {
        const int c = 8 * F.lane; const f32x4 a = *(const f32x4*)(ov + (size_t)t * 512 + c), b = *(const f32x4*)(ov + (size_t)t * 512 + c + 4);
        float ss = ((a.x * a.x + a.y * a.y) + (a.z * a.z + a.w * a.w)) + ((b.x * b.x + b.y * b.y) + (b.z * b.z + b.w * b.w));
        ss += shx(ss, 1, F.lane); ss += shx(ss, 2, F.lane); ss += shx(ss, 4, F.lane); ss += shx(ss, 8, F.lane);
        const float rs = __builtin_amdgcn_rsqf(ss * (1.f / 128.f) + NORM_EPS);
        const f32x4 g0 = *(const f32x4*)(gh + c), g1 = *(const f32x4*)(gh + c + 4);
        const u32x4 gt = *(const u32x4*)(proj + (size_t)t * DIN + PC_G + c);
        float o[8];
        o[0] = a.x * rs * g0.x * siluf_(bflo(gt.x)); o[1] = a.y * rs * g0.y * siluf_(bfhi(gt.x)); o[2] = a.z * rs * g0.z * siluf_(bflo(gt.y)); o[3] = a.w * rs * g0.w * siluf_(bfhi(gt.y));
        o[4] = b.x * rs * g1.x * siluf_(bflo(gt.z)); o[5] = b.y * rs * g1.y * siluf_(bfhi(gt.z)); o[6] = b.z * rs * g1.z * siluf_(bflo(gt.w)); o[7] = b.w * rs * g1.w * siluf_(bfhi(gt.w));
        u32x4 w; w.x = pk2(o[0], o[1]); w.y = pk2(o[2], o[3]); w.z = pk2(o[4], o[5]); w.w = pk2(o[6], o[7]);
        *(u32x4*)(mix + (size_t)t * D + 512 + c) = w;
    }
}
#endif


typedef float f32x16 __attribute__((ext_vector_type(16)));
template <class V> __device__ __forceinline__ void mfma_settle(V& v) { asm volatile("s_nop 15\n\ts_nop 7" : "+v"(v)); }
template <int KSTEPS>
__device__ __forceinline__ void mma32(f32x16& acc, const LAS unsigned char* A, int lda, const LAS unsigned char* Bt, int ldb, int lane) {
    const LAS unsigned char* pa = A + (lane & 31) * lda + (lane >> 5) * 16;
    const LAS unsigned char* pb = Bt + (lane & 31) * ldb + (lane >> 5) * 16;
#pragma unroll
    for (int s = 0; s < KSTEPS; ++s) {
        const bf16x8 a = *(const LAS bf16x8*)(pa + s * 32), b = *(const LAS bf16x8*)(pb + s * 32);
        acc = __builtin_amdgcn_mfma_f32_32x32x16_bf16(a, b, acc, 0, 0, 0);
    }
    mfma_settle(acc);
}
__device__ __forceinline__ u32x2 pack4(float a, float b, float c, float d) { u32x2 w; w.x = pg8::cvt_pk_bf16(a, b); w.y = pg8::cvt_pk_bf16(c, d); return w; }

constexpr int HS128 = 272, HS64 = 144;
constexpr int HL_QP = 0, HL_KP = HL_QP + 64 * HS128, HL_AQ = HL_KP + 64 * HS128, HL_KDT = HL_AQ + 64 * HS128, HL_VT = HL_KDT + 128 * HS64,
              HL_P = HL_VT + 128 * HS64, HL_ST = HL_P + 64 * HS64, HL_TOT = HL_ST + 128 * HS128, HL_DV = HL_TOT + 4096, HL_END = HL_DV + 512;
static_assert(HL_END <= MISC_OFF, "HGRN2 LDS map");
__device__ __forceinline__ void hg_local(Ctx& F, int l, int unit) {
    const int hd = unit & 3, sg = unit >> 2;
    const bf16_t* proj = (const bf16_t*)(F.ws + WS_PROJ);
    bf16_t* oloc = (bf16_t*)(F.ws + FS_OLOC); bf16_t* aseg = (bf16_t*)(F.ws + FS_ASEG);
    float* send = (float*)(F.ws + FS_SEND); float* dseg = (float*)(F.ws + FS_DSEG);
    LAS unsigned char* L = F.lds;
    LAS float* tot = (LAS float*)(L + HL_TOT); LAS float* dv = (LAS float*)(L + HL_DV);
    const int tid = F.tid, lane = F.lane, w = F.wave, r = lane & 31, h = lane >> 5;
    const int kp = tid & 63, oc = tid >> 6, k0 = 2 * kp;
    const float lbA = ((const float*)(F.ws + WS_TAB))[TB_LBC + l * 512 + hd * 128 + k0], lbB = ((const float*)(F.ws + WS_TAB))[TB_LBC + l * 512 + hd * 128 + k0 + 1];
    const float omA = 1.f - lbA, omB = 1.f - lbB;
    float BsegA = 0.f, BsegB = 0.f;
    f32x16 S0, S1;
#pragma unroll
    for (int i = 0; i < 16; ++i) { S0[i] = 0.f; S1[i] = 0.f; }
    { unsigned zz = 0u; asm volatile("" : "+v"(zz)); for (int i = tid; i < 128 * HS128 / 16; i += 512) ((LAS u32x4*)(L + HL_ST))[i] = (u32x4){zz, zz, zz, zz}; }
    const int kt0 = (2 * w) >> 2, vt0 = (2 * w) & 3, kt1 = (2 * w + 1) >> 2, vt1 = (2 * w + 1) & 3;
#define HG_BAR() do { asm volatile("s_waitcnt lgkmcnt(0)" ::: "memory"); __builtin_amdgcn_s_barrier(); asm volatile("" ::: "memory"); } while (0)
    unsigned rq[8], rf[8], ri[8];
    {
        const unsigned* p0 = (const unsigned*)(proj + (size_t)(sg * 256 + oc * 8) * DIN + PC_Q + hd * 128 + k0);
#pragma unroll
        for (int i = 0; i < 8; ++i) { rq[i] = p0[(size_t)i * (DIN / 2)]; rf[i] = p0[(size_t)i * (DIN / 2) + (PC_F - PC_Q) / 2]; ri[i] = p0[(size_t)i * (DIN / 2) + (PC_I - PC_Q) / 2]; }
    }
    for (int c = 0; c < 4; ++c) {
        const int tc = sg * 256 + c * 64, t0 = tc + oc * 8;
        float lfA[8], lfB[8], qsA[8], qsB[8], kkA[8], kkB[8]; unsigned ivw[8];
        {
            float ef[16], eq[16];
#pragma unroll
            for (int i = 0; i < 8; ++i) { ivw[i] = ri[i];
                ef[2 * i] = __builtin_amdgcn_exp2f(bflo(rf[i]) * -1.4426950408889634f); ef[2 * i + 1] = __builtin_amdgcn_exp2f(bfhi(rf[i]) * -1.4426950408889634f);
                eq[2 * i] = __builtin_amdgcn_exp2f(bflo(rq[i]) * -1.4426950408889634f); eq[2 * i + 1] = __builtin_amdgcn_exp2f(bfhi(rq[i]) * -1.4426950408889634f); }
#pragma unroll
            for (int i = 0; i < 16; ++i) { ef[i] = __builtin_amdgcn_rcpf(1.f + ef[i]); eq[i] = __builtin_amdgcn_rcpf(1.f + eq[i]); }
#pragma unroll
            for (int i = 0; i < 8; ++i) {
                lfA[i] = __builtin_amdgcn_logf(fmaxf(lbA, 1e-30f) + omA * ef[2 * i]) * 0.6931471805599453f; lfB[i] = __builtin_amdgcn_logf(fmaxf(lbB, 1e-30f) + omB * ef[2 * i + 1]) * 0.6931471805599453f;
                kkA[i] = omA * (1.f - ef[2 * i]); kkB[i] = omB * (1.f - ef[2 * i + 1]);
                qsA[i] = bflo(rq[i]) * eq[2 * i]; qsB[i] = bfhi(rq[i]) * eq[2 * i + 1]; }
        }
#pragma unroll
        for (int i = 1; i < 8; ++i) { lfA[i] += lfA[i - 1]; lfB[i] += lfB[i - 1]; }
        *(LAS f32x2*)(tot + oc * 128 + k0) = (f32x2){lfA[7], lfB[7]};
        HG_BAR();
        float preA = 0.f, preB = 0.f, midA = 0.f, midB = 0.f, lastA = 0.f, lastB = 0.f;
#pragma unroll
        for (int o2 = 0; o2 < 8; ++o2) { const f32x2 tv = *(const LAS f32x2*)(tot + o2 * 128 + k0);
            if (o2 < oc) { preA += tv.x; preB += tv.y; } if (o2 < 4) { midA += tv.x; midB += tv.y; } lastA += tv.x; lastB += tv.y; }
        const float EmA = __expf(midA), EmB = __expf(midB), EsA = __expf(midA + BsegA), EsB = __expf(midB + BsegB), ElA = __expf(lastA - midA), ElB = __expf(lastB - midB);
        unsigned kdA[4], kdB[4], ivA[4], ivB[4];
        float e1[16], r1[16];
#pragma unroll
        for (int i = 0; i < 8; ++i) { e1[2 * i] = __builtin_amdgcn_exp2f((preA + lfA[i] - midA) * 1.4426950408889634f); e1[2 * i + 1] = __builtin_amdgcn_exp2f((preB + lfB[i] - midB) * 1.4426950408889634f); }
#pragma unroll
        for (int i = 0; i < 16; ++i) { e1[i] = fminf(fmaxf(e1[i], 1e-30f), 1e30f); r1[i] = __builtin_amdgcn_rcpf(e1[i]); }
#pragma unroll
        for (int i = 0; i < 8; ++i) {
            const int tl = oc * 8 + i;
            const float e1A = e1[2 * i], e1B = e1[2 * i + 1], r1A = r1[2 * i], r1B = r1[2 * i + 1];
            const float qpA = qsA[i] * e1A, qpB = qsB[i] * e1B, kpA = kkA[i] * r1A, kpB = kkB[i] * r1B;
            *(LAS unsigned*)(L + HL_QP + tl * HS128 + k0 * 2) = pk2(qpA, qpB);
            *(LAS unsigned*)(L + HL_KP + tl * HS128 + k0 * 2) = pk2(kpA, kpB);
            *(LAS unsigned*)(L + HL_AQ + tl * HS128 + k0 * 2) = pk2(qpA * EmA, qpB * EmB);
            *(unsigned*)(aseg + (size_t)(t0 + i) * 512 + hd * 128 + k0) = pk2(qpA * EsA, qpB * EsB);
            const unsigned kdab = pk2(kpA * ElA, kpB * ElB), va = ivw[i] & 0xffffu, vb = ivw[i] >> 16;
            if (i & 1) { kdA[i >> 1] |= kdab << 16; kdB[i >> 1] |= kdab & 0xffff0000u; ivA[i >> 1] |= va << 16; ivB[i >> 1] |= vb << 16; }
            else { kdA[i >> 1] = kdab & 0xffffu; kdB[i >> 1] = kdab >> 16; ivA[i >> 1] = va; ivB[i >> 1] = vb; }
        }
        *(LAS u32x4*)(L + HL_KDT + k0 * HS64 + oc * 16) = (u32x4){kdA[0], kdA[1], kdA[2], kdA[3]};
        *(LAS u32x4*)(L + HL_KDT + (k0 + 1) * HS64 + oc * 16) = (u32x4){kdB[0], kdB[1], kdB[2], kdB[3]};
        *(LAS u32x4*)(L + HL_VT + k0 * HS64 + oc * 16) = (u32x4){ivA[0], ivA[1], ivA[2], ivA[3]};
        *(LAS u32x4*)(L + HL_VT + (k0 + 1) * HS64 + oc * 16) = (u32x4){ivB[0], ivB[1], ivB[2], ivB[3]};
        if (oc == 0) *(LAS f32x2*)(dv + k0) = (f32x2){__expf(lastA), __expf(lastB)};
        BsegA += lastA; BsegB += lastB;
        if (c < 3) {
            const unsigned* p0 = (const unsigned*)(proj + (size_t)(tc + 64 + oc * 8) * DIN + PC_Q + hd * 128 + k0);
#pragma unroll
            for (int i = 0; i < 8; ++i) { rq[i] = p0[(size_t)i * (DIN / 2)]; rf[i] = p0[(size_t)i * (DIN / 2) + (PC_F - PC_Q) / 2]; ri[i] = p0[(size_t)i * (DIN / 2) + (PC_I - PC_Q) / 2]; }
        }
        HG_BAR();
        if (w < 4) {
            const int a = w & 1, b = w >> 1;
            f32x16 acc;
#pragma unroll
            for (int i = 0; i < 16; ++i) acc[i] = 0.f;
            if (!(a == 1 && b == 0)) {
                mma32<8>(acc, L + HL_KP + a * 32 * HS128, HS128, L + HL_QP + b * 32 * HS128, HS128, lane);
                if (a == b) {
#pragma unroll
                    for (int i = 0; i < 16; ++i) { const int sl = (i & 3) + 8 * (i >> 2) + 4 * h; acc[i] = (sl <= r) ? acc[i] : 0.f; }
                }
            }
#pragma unroll
            for (int g = 0; g < 4; ++g) *(LAS u32x2*)(L + HL_P + (b * 32 + r) * HS64 + (a * 32 + 8 * g + 4 * h) * 2) = pack4(acc[4 * g], acc[4 * g + 1], acc[4 * g + 2], acc[4 * g + 3]);
        }
        HG_BAR();
        {
            const int vt = w & 3, tt = w >> 2;
            f32x16 acc;
#pragma unroll
            for (int i = 0; i < 16; ++i) acc[i] = 0.f;
            mma32<4>(acc, L + HL_VT + vt * 32 * HS64, HS64, L + HL_P + tt * 32 * HS64, HS64, lane);
            mma32<8>(acc, L + HL_ST + vt * 32 * HS128, HS128, L + HL_AQ + tt * 32 * HS128, HS128, lane);
            u32x2* otile = (u32x2*)oloc + ((size_t)((hd * 512 + (tc >> 5) + tt) * 16 + vt * 4)) * 64 + lane;
#pragma unroll
            for (int g = 0; g < 4; ++g) otile[g * 64] = pack4(acc[4 * g], acc[4 * g + 1], acc[4 * g + 2], acc[4 * g + 3]);
        }
#pragma unroll
        for (int i = 0; i < 16; ++i) { const int ko = (i & 3) + 8 * (i >> 2) + 4 * h; S0[i] *= dv[kt0 * 32 + ko]; S1[i] *= dv[kt1 * 32 + ko]; }
        mma32<4>(S0, L + HL_KDT + kt0 * 32 * HS64, HS64, L + HL_VT + vt0 * 32 * HS64, HS64, lane);
        mma32<4>(S1, L + HL_KDT + kt1 * 32 * HS64, HS64, L + HL_VT + vt1 * 32 * HS64, HS64, lane);
        HG_BAR();
#pragma unroll
        for (int g = 0; g < 4; ++g) {
            *(LAS u32x2*)(L + HL_ST + (vt0 * 32 + r) * HS128 + (kt0 * 32 + 8 * g + 4 * h) * 2) = pack4(S0[4 * g], S0[4 * g + 1], S0[4 * g + 2], S0[4 * g + 3]);
            *(LAS u32x2*)(L + HL_ST + (vt1 * 32 + r) * HS128 + (kt1 * 32 + 8 * g + 4 * h) * 2) = pack4(S1[4 * g], S1[4 * g + 1], S1[4 * g + 2], S1[4 * g + 3]);
        }
    }
    float* se = send + ((size_t)(sg * 4 + hd) * 128) * 128;
#pragma unroll
    for (int g = 0; g < 4; ++g) {
        *(f32x4*)(se + (size_t)(vt0 * 32 + r) * 128 + kt0 * 32 + 8 * g + 4 * h) = (f32x4){S0[4 * g], S0[4 * g + 1], S0[4 * g + 2], S0[4 * g + 3]};
        *(f32x4*)(se + (size_t)(vt1 * 32 + r) * 128 + kt1 * 32 + 8 * g + 4 * h) = (f32x4){S1[4 * g], S1[4 * g + 1], S1[4 * g + 2], S1[4 * g + 3]};
    }
    if (oc == 0) { dseg[sg * 512 + hd * 128 + k0] = __expf(BsegA); dseg[sg * 512 + hd * 128 + k0 + 1] = __expf(BsegB); }
    __syncthreads();
#undef HG_BAR
}
__device__ __forceinline__ void hg_carry(Ctx& F, int bu) {
    const float* send = (const float*)(F.ws + FS_SEND); const float* dseg = (const float*)(F.ws + FS_DSEG); bf16_t* sst = (bf16_t*)(F.ws + FS_SST);
    LAS float* gP = (LAS float*)F.lds; LAS float* gL = gP + 512;
    const int el = F.tid & 63, grp = F.tid >> 6, e = bu * 64 + el, hd = e >> 14, k = e & 127;
    float locA[8], PA[8]; float loc = 0.f, P = 1.f;
#pragma unroll
    for (int i = 0; i < 8; ++i) { const int sgi = grp * 8 + i; const float d = dseg[sgi * 512 + hd * 128 + k], x = send[(size_t)sgi * 65536 + e]; loc = d * loc + x; P *= d; locA[i] = loc; PA[i] = P; }
    gP[grp * 64 + el] = P; gL[grp * 64 + el] = loc;
    __syncthreads();
    float X = 0.f;
    for (int g2 = 0; g2 < grp; ++g2) X = gP[g2 * 64 + el] * X + gL[g2 * 64 + el];
#pragma unroll
    for (int i = 0; i < 8; ++i) { const float v = (i == 0) ? X : (PA[i - 1 < 0 ? 0 : i - 1] * X + locA[i - 1 < 0 ? 0 : i - 1]); sst[(size_t)(grp * 8 + i) * 65536 + e] = (bf16_t)f2bf(v); }
    __syncthreads();
}
constexpr int HF_ST = 0, HF_AS = 128 * HS128, HF_END = HF_AS + 256 * HS128;
static_assert(HF_END <= MISC_OFF, "HGRN2 fix-up LDS map");
__device__ __forceinline__ void hg_fix(Ctx& F, int l, int unit) {
    const int hd = unit & 3, sg = unit >> 2;
    bf16_t* mix = (bf16_t*)(F.ws + WS_MIX);
    const bf16_t* oloc = (const bf16_t*)(F.ws + FS_OLOC); const bf16_t* aseg = (const bf16_t*)(F.ws + FS_ASEG); const bf16_t* sst = (const bf16_t*)(F.ws + FS_SST);
    const float* gh = F.in[I_HG_ONORM] + l * 512 + hd * 128;
    LAS unsigned char* L = F.lds;
    const int tid = F.tid, lane = F.lane, w = F.wave, r = lane & 31, h = lane >> 5;
    f32x16 acc[4];
#pragma unroll
    for (int v = 0; v < 4; ++v)
#pragma unroll
        for (int i = 0; i < 16; ++i) acc[v][i] = 0.f;
    const int t32 = sg * 8 + w;
    const u32x2* otile = (const u32x2*)oloc + ((size_t)((hd * 512 + t32) * 16)) * 64 + lane;
    const u32x2* gtile = (const u32x2*)(F.ws + FS_GATE) + ((size_t)((hd * 512 + t32) * 16)) * 64 + lane;
    u32x2 opre[16], gpre[16];
#pragma unroll
    for (int i = 0; i < 16; ++i) { opre[i] = otile[i * 64]; gpre[i] = gtile[i * 64]; }
    if (sg > 0) {
        const bf16_t* ss = sst + ((size_t)(sg * 4 + hd) * 128) * 128;
        for (int i = tid; i < 128 * 16; i += 512) { const int row = i >> 4, ch = i & 15; *(LAS u32x4*)(L + HF_ST + row * HS128 + ch * 16) = *(const u32x4*)(ss + (size_t)row * 128 + ch * 8); }
        for (int i = tid; i < 256 * 16; i += 512) { const int row = i >> 4, ch = i & 15; *(LAS u32x4*)(L + HF_AS + row * HS128 + ch * 16) = *(const u32x4*)(aseg + (size_t)(sg * 256 + row) * 512 + hd * 128 + ch * 8); }
        __syncthreads();
#pragma unroll
        for (int v = 0; v < 4; ++v) mma32<8>(acc[v], L + HF_ST + v * 32 * HS128, HS128, L + HF_AS + w * 32 * HS128, HS128, lane);
    }
    float ssum = 0.f;
#pragma unroll
    for (int v = 0; v < 4; ++v)
#pragma unroll
        for (int g = 0; g < 4; ++g) { const u32x2 o = opre[v * 4 + g];
            acc[v][4 * g] += bflo(o.x); acc[v][4 * g + 1] += bfhi(o.x); acc[v][4 * g + 2] += bflo(o.y); acc[v][4 * g + 3] += bfhi(o.y);
            ssum += (acc[v][4 * g] * acc[v][4 * g] + acc[v][4 * g + 1] * acc[v][4 * g + 1]) + (acc[v][4 * g + 2] * acc[v][4 * g + 2] + acc[v][4 * g + 3] * acc[v][4 * g + 3]); }
    ssum += shx(ssum, 32, lane);
    const float rs = __builtin_amdgcn_rsqf(ssum * (1.f / 128.f) + NORM_EPS);
    __syncthreads();
    LAS unsigned char* ost = L + w * 32 * HS128;
#pragma unroll
    for (int v = 0; v < 4; ++v)
#pragma unroll
        for (int g = 0; g < 4; ++g) { const int vo = v * 32 + 8 * g + 4 * h; const u32x2 gt = gpre[v * 4 + g]; const f32x4 gn = *(const f32x4*)(gh + vo);
            *(LAS u32x2*)(ost + r * HS128 + vo * 2) = pack4(acc[v][4 * g] * rs * gn.x * bflo(gt.x), acc[v][4 * g + 1] * rs * gn.y * bfhi(gt.x),
                                                            acc[v][4 * g + 2] * rs * gn.z * bflo(gt.y), acc[v][4 * g + 3] * rs * gn.w * bfhi(gt.y)); }
    __syncthreads();
    {
        const int t0 = sg * 256 + w * 32;
#pragma unroll
        for (int it = 0; it < 8; ++it) { const int row = it * 4 + (lane >> 4), ch = lane & 15;
            const u32x4 wv = *(const LAS u32x4*)(ost + row * HS128 + ch * 16);
            if ((F8_OUT >> l) & 1) *(u32x2*)(F.ws + WS_MIX8 + (size_t)(t0 + row) * D + 512 + hd * 128 + ch * 8) = bf8_to_f8(wv);
            else *(u32x4*)(mix + (size_t)(t0 + row) * D + 512 + hd * 128 + ch * 8) = wv; }
    }
    __syncthreads();
}

constexpr int S5_XS = 272, S5_Y1S = 528;
constexpr int S5L_X = 0, S5L_Y1 = S5L_X + 8 * 32 * S5_XS, S5L_PART = S5L_Y1 + 64 * S5_Y1S, S5L_END = S5L_PART + 64 * 4 * 4;
static_assert(S5L_END <= MISC_OFF, "S5 LDS map");
template <bool FULL>
__device__ __forceinline__ void s5_pass(Ctx& F, int l, int cidx) {
    const bf16_t* proj = (const bf16_t*)(F.ws + WS_PROJ); const float* tab = (const float*)(F.ws + WS_TAB);
    float* xe = (float*)(F.ws + FS_XE); const float* xin = (const float*)(F.ws + FS_XIN);
    const bf16_t* bbi = (const bf16_t*)(F.ws + WS_BB); const bf16_t* cmi = (const bf16_t*)(F.ws + WS_CM);
    LAS unsigned char* L = F.lds;
    const int lane = F.lane, w = F.wave, r = lane & 31, h = lane >> 5;
    LAS unsigned char* X = L + S5L_X + w * 32 * S5_XS;
    const int tc = cidx * 64;
#define S5_BAR() do { asm volatile("s_waitcnt lgkmcnt(0)" ::: "memory"); __builtin_amdgcn_s_barrier(); asm volatile("" ::: "memory"); } while (0)
    for (int gi = 0; gi < 2; ++gi) {
        const int g = 2 * w + gi, lg = l * 16 + g, st = g * 64 + lane;
        const float lbr = tab[TB_LAMB + 2 * (lg * 64 + lane)], lbi = tab[TB_LAMB + 2 * (lg * 64 + lane) + 1];
        bf16x8 Bf[4];
#pragma unroll
        for (int nt = 0; nt < 4; ++nt) Bf[nt] = *(const bf16x8*)(bbi + ((size_t)lg * 128 + nt * 32 + r) * 16 + h * 8);
        bf16x8 Cf[8];
        if (FULL) {
#pragma unroll
            for (int s2 = 0; s2 < 8; ++s2) { Cf[s2] = (bf16x8){0, 0, 0, 0, 0, 0, 0, 0}; if (r < 16) Cf[s2] = *(const bf16x8*)(cmi + ((size_t)lg * 16 + r) * 128 + s2 * 16 + h * 8); }
        }
        float xr = 0.f, xi = 0.f;
        if (FULL) { xr = xin[((size_t)cidx * 1024 + st) * 2]; xi = xin[((size_t)cidx * 1024 + st) * 2 + 1]; }
        bf16x8 Af2[2];
#pragma unroll
        for (int hf = 0; hf < 2; ++hf) Af2[hf] = *(const bf16x8*)(proj + (size_t)(tc + hf * 32 + r) * DIN + PC_U + g * 16 + h * 8);
        bf16x8 Df = (bf16x8){0, 0, 0, 0, 0, 0, 0, 0};
        if (FULL) { const short db = (short)f2bf(F.in[I_S5_D][l * S5W + g * 16 + (r & 15)]);
#pragma unroll
            for (int j = 0; j < 8; ++j) Df[j] = (r < 16 && r - 8 * h == j) ? db : (short)0; }
        for (int half = 0; half < 2; ++half) {
            const bf16x8 Af = Af2[half];
            f32x16 acc4[4];
#pragma unroll
            for (int nt = 0; nt < 4; ++nt) {
#pragma unroll
                for (int i = 0; i < 16; ++i) acc4[nt][i] = 0.f;
                acc4[nt] = __builtin_amdgcn_mfma_f32_32x32x16_bf16(Bf[nt], Af, acc4[nt], 0, 0, 0);
            }
            asm volatile("s_nop 15\n\ts_nop 7" : "+v"(acc4[0]), "+v"(acc4[1]), "+v"(acc4[2]), "+v"(acc4[3]));
#pragma unroll
            for (int nt = 0; nt < 4; ++nt)
#pragma unroll
                for (int g4 = 0; g4 < 4; ++g4) *(LAS u32x2*)(X + r * S5_XS + (nt * 32 + 8 * g4 + 4 * h) * 2) = pack4(acc4[nt][4 * g4], acc4[nt][4 * g4 + 1], acc4[nt][4 * g4 + 2], acc4[nt][4 * g4 + 3]);
            S5_BAR();
#pragma unroll 8
            for (int i = 0; i < 32; ++i) {
                const unsigned bw = *(const LAS unsigned*)(X + i * S5_XS + lane * 4);
                const float nr = lbr * xr - lbi * xi + bflo(bw), ni = lbr * xi + lbi * xr + bfhi(bw); xr = nr; xi = ni;
                if (FULL) *(LAS unsigned*)(X + i * S5_XS + lane * 4) = pk2(xr, xi);
            }
            S5_BAR();
            if (FULL) {
                f32x16 ya;
#pragma unroll
                for (int i = 0; i < 16; ++i) ya[i] = 0.f;
#pragma unroll
                for (int s2 = 0; s2 < 8; ++s2) { const bf16x8 xa = *(const LAS bf16x8*)(X + r * S5_XS + s2 * 32 + h * 16); ya = __builtin_amdgcn_mfma_f32_32x32x16_bf16(Cf[s2], xa, ya, 0, 0, 0); }
                ya = __builtin_amdgcn_mfma_f32_32x32x16_bf16(Df, Af, ya, 0, 0, 0);
                mfma_settle(ya);
#pragma unroll
                for (int g2 = 0; g2 < 2; ++g2) *(LAS u32x2*)(L + S5L_Y1 + (half * 32 + r) * S5_Y1S + (g * 16 + 8 * g2 + 4 * h) * 2) =
                    pack4(gelu_tanh(ya[4 * g2]), gelu_tanh(ya[4 * g2 + 1]), gelu_tanh(ya[4 * g2 + 2]), gelu_tanh(ya[4 * g2 + 3]));
            }
            S5_BAR();
        }
        if (!FULL) { xe[((size_t)cidx * 1024 + st) * 2] = xr; xe[((size_t)cidx * 1024 + st) * 2 + 1] = xi; }
    }
    if (FULL) {
        __syncthreads();
        const bf16_t* wgt = (const bf16_t*)(F.ws + WS_GLU) + (size_t)l * 256 * 256;
        const float* gs = F.in[I_S5_ONORM] + l * 256; bf16_t* mix = (bf16_t*)(F.ws + WS_MIX);
        LAS float* part = (LAS float*)(L + S5L_PART);
        const int r = lane & 31, h = lane >> 5, tt = w & 1, jg = w >> 1;
        f32x16 z[2];
#pragma unroll
        for (int jt = 0; jt < 2; ++jt) {
#pragma unroll
            for (int i = 0; i < 16; ++i) z[jt][i] = 0.f;
            const bf16_t* wa = wgt + (size_t)((jg * 2 + jt) * 32 + r) * 256 + h * 8;
            const LAS unsigned char* pb = L + S5L_Y1 + (tt * 32 + r) * S5_Y1S + h * 16;
#pragma unroll
#ifndef EXP_NOGLU
            for (int s2 = 0; s2 < 16; ++s2) { const bf16x8 a = *(const bf16x8*)(wa + s2 * 16), b = *(const LAS bf16x8*)(pb + s2 * 32); z[jt] = __builtin_amdgcn_mfma_f32_32x32x16_bf16(a, b, z[jt], 0, 0, 0); }
#else
            for (int s2 = 0; s2 < 1; ++s2) { (void)wa; (void)pb; }
#endif
            mfma_settle(z[jt]);
        }
        float ssum = 0.f;
#pragma unroll
        for (int jt = 0; jt < 2; ++jt)
#pragma unroll
            for (int g4 = 0; g4 < 4; ++g4) { const int j0 = (jg * 2 + jt) * 32 + 8 * g4 + 4 * h; const u32x2 yv = *(const LAS u32x2*)(L + S5L_Y1 + (tt * 32 + r) * S5_Y1S + j0 * 2);
                const float y0 = bflo(yv.x) * sigmoidf_(z[jt][4 * g4]), y1v = bfhi(yv.x) * sigmoidf_(z[jt][4 * g4 + 1]), y2 = bflo(yv.y) * sigmoidf_(z[jt][4 * g4 + 2]), y3 = bfhi(yv.y) * sigmoidf_(z[jt][4 * g4 + 3]);
                z[jt][4 * g4] = y0; z[jt][4 * g4 + 1] = y1v; z[jt][4 * g4 + 2] = y2; z[jt][4 * g4 + 3] = y3; ssum += (y0 * y0 + y1v * y1v) + (y2 * y2 + y3 * y3); }
        ssum += shx(ssum, 32, lane);
        if (h == 0) part[(tt * 32 + r) * 4 + jg] = ssum;
        __syncthreads();
        const f32x4 pp = *(const LAS f32x4*)(part + (tt * 32 + r) * 4);
        const float rs = __builtin_amdgcn_rsqf(((pp.x + pp.y) + (pp.z + pp.w)) * (1.f / 256.f) + NORM_EPS);
#pragma unroll
        for (int jt = 0; jt < 2; ++jt)
#pragma unroll
            for (int g4 = 0; g4 < 4; ++g4) { const int j0 = (jg * 2 + jt) * 32 + 8 * g4 + 4 * h; const f32x4 gn = *(const f32x4*)(gs + j0);
                *(LAS u32x2*)(L + S5L_Y1 + (tt * 32 + r) * S5_Y1S + j0 * 2) = pack4(z[jt][4 * g4] * rs * gn.x, z[jt][4 * g4 + 1] * rs * gn.y, z[jt][4 * g4 + 2] * rs * gn.z, z[jt][4 * g4 + 3] * rs * gn.w); }
        __syncthreads();
#pragma unroll
        for (int it = 0; it < 4; ++it) { const int row = it * 16 + (F.tid >> 5), ch = F.tid & 31;
            const u32x4 wv = *(const LAS u32x4*)(L + S5L_Y1 + row * S5_Y1S + ch * 16);
            if ((F8_OUT >> l) & 1) *(u32x2*)(F.ws + WS_MIX8 + (size_t)(tc + row) * D + ch * 8) = bf8_to_f8(wv);
            else *(u32x4*)(mix + (size_t)(tc + row) * D + ch * 8) = wv; }
    }
    __syncthreads();
}
__device__ __forceinline__ void s5_endstates(Ctx& F, int l, int bu) {
    const bf16_t* proj = (const bf16_t*)(F.ws + WS_PROJ); const bf16_t* vt = (const bf16_t*)(F.ws + WS_VT); float* xe = (float*)(F.ws + FS_XE);
    const int w = F.wave, wu = bu * 2 + (w >> 2), kq = w & 3;
    const int g = wu >> 5, ct = (wu >> 2) & 7, nt = wu & 3, lane = F.lane, r = lane & 31, h = lane >> 5;
    const bf16_t* pa = proj + (size_t)((ct * 32 + r) * 64 + kq * 16) * DIN + PC_U + g * 16 + h * 8;
    const bf16_t* pb = vt + ((size_t)(l * 16 + g) * 128 + nt * 32 + r) * 1024 + kq * 256 + h * 8;
    f32x16 acc;
#pragma unroll
    for (int i = 0; i < 16; ++i) acc[i] = 0.f;
#pragma unroll
    for (int st = 0; st < 16; ++st) { const bf16x8 a = *(const bf16x8*)(pa + (size_t)st * DIN), b = *(const bf16x8*)(pb + st * 16); acc = __builtin_amdgcn_mfma_f32_32x32x16_bf16(a, b, acc, 0, 0, 0); }
    mfma_settle(acc);
    LAS float* part = (LAS float*)F.lds + (w * 16) * 64 + lane;
#pragma unroll
    for (int i = 0; i < 16; ++i) part[i * 64] = acc[i];
    __syncthreads();
    if (kq == 0) {
        float* xo = xe + (size_t)(ct * 32) * 2048 + g * 128 + nt * 32 + r;
#pragma unroll
        for (int i = 0; i < 16; ++i) { const float v = (part[i * 64] + part[(16 + i) * 64]) + (part[(32 + i) * 64] + part[(48 + i) * 64]);
            xo[(size_t)((i & 3) + 8 * (i >> 2) + 4 * h) * 2048] = v; }
    }
    __syncthreads();
}
__device__ __forceinline__ void s5_carry(Ctx& F, int l, int bu) {
    const float* tab = (const float*)(F.ws + WS_TAB); const float* xe = (const float*)(F.ws + FS_XE); float* xin = (float*)(F.ws + FS_XIN);
    LAS float* gL = (LAS float*)(F.lds + 8192);
    const int sl = F.tid & 31, grp = F.tid >> 5, st = bu * 32 + sl;
    float ar = tab[TB_LAMB + 2 * (l * 1024 + st)], ai = tab[TB_LAMB + 2 * (l * 1024 + st) + 1];
#pragma unroll
    for (int i = 0; i < 6; ++i) { const float nr = ar * ar - ai * ai, ni = 2.f * ar * ai; ar = nr; ai = ni; }
    float lr[16], li[16], pr[16], pi[16]; float cr = 0.f, ci = 0.f, qr = 1.f, qi = 0.f;
#pragma unroll
    for (int i = 0; i < 16; ++i) { const int c = grp * 16 + i; const f32x2 x = *(const f32x2*)(xe + ((size_t)c * 1024 + st) * 2);
        const float nr = ar * cr - ai * ci + x.x, ni = ar * ci + ai * cr + x.y; cr = nr; ci = ni; lr[i] = cr; li[i] = ci;
        const float mr = ar * qr - ai * qi, mi = ar * qi + ai * qr; qr = mr; qi = mi; pr[i] = qr; pi[i] = qi; }
    gL[(grp * 32 + sl) * 2] = cr; gL[(grp * 32 + sl) * 2 + 1] = ci;
    __syncthreads();
    float Xr = 0.f, Xi = 0.f;
    for (int g2 = 0; g2 < grp; ++g2) { const float er = gL[(g2 * 32 + sl) * 2], ei = gL[(g2 * 32 + sl) * 2 + 1]; const float nr = qr * Xr - qi * Xi + er, ni = qr * Xi + qi * Xr + ei; Xr = nr; Xi = ni; }
#pragma unroll
    for (int i = 0; i < 16; ++i) { const int c = grp * 16 + i; float vr = Xr, vi = Xi;
        if (i > 0) { vr = pr[i - 1] * Xr - pi[i - 1] * Xi + lr[i - 1]; vi = pr[i - 1] * Xi + pi[i - 1] * Xr + li[i - 1]; }
        *(f32x2*)(xin + ((size_t)c * 1024 + st) * 2) = (f32x2){vr, vi}; }
    __syncthreads();
}

__device__ __forceinline__ void router_phase(Ctx& F, int j) {
    const float* ssq = (const float*)(F.ws + WS_SSQ); const bf16_t* hb = (const bf16_t*)(F.ws + WS_HB);
    LAS float* lgs = (LAS float*)F.lds;
    LAS float* rgL = (LAS float*)(F.lds + 65536);
    { const f32x4* src = (const f32x4*)((const float*)(F.ws + WS_TAB) + TB_RG + j * 8 * 1024);
#pragma unroll
      for (int i = 0; i < 4; ++i) { const int idx = F.tid + 512 * i, e = idx >> 8, c4 = idx & 255; *(LAS f32x4*)(rgL + e * 1028 + c4 * 4) = src[idx]; } }
    __syncthreads();
    LAS int* sel = (LAS int*)(F.lds + 32768);
    LAS float* selg = (LAS float*)(F.lds + 32768 + 512);
    int* tok_e = (int*)(F.ws + WS_MOE + MO_TOKE); int* tok_p = (int*)(F.ws + WS_MOE + MO_TOKP); float* rstd_tok = (float*)(F.ws + WS_MOE + MO_RSTD);
    int* tcnt = (int*)(F.ws + WS_MOE + MO_TCNT); int* tlist = (int*)(F.ws + WS_MOE + MO_TLIST); float* tgate = (float*)(F.ws + WS_MOE + MO_TGATE);
    for (int tile = F.bid; tile < T / 64; tile += F.G) {
        {
            const int tl = F.tid >> 3, e = F.tid & 7, t = tile * 64 + tl;
            const u32x4* hp = (const u32x4*)(hb + (size_t)t * D); const LAS float* rp = rgL + e * 1028;
            f32x2 a2 = (f32x2){0.f, 0.f}, b2 = (f32x2){0.f, 0.f};
#pragma unroll 8
            for (int k8 = 0; k8 < 128; ++k8) { const u32x4 hw = hp[k8]; const f32x4 r0 = *(const LAS f32x4*)(rp + k8 * 8), r1 = *(const LAS f32x4*)(rp + k8 * 8 + 4);
                a2 += (f32x2){bflo(hw.x), bfhi(hw.x)} * (f32x2){r0.x, r0.y}; b2 += (f32x2){bflo(hw.y), bfhi(hw.y)} * (f32x2){r0.z, r0.w};
                a2 += (f32x2){bflo(hw.z), bfhi(hw.z)} * (f32x2){r1.x, r1.y}; b2 += (f32x2){bflo(hw.w), bfhi(hw.w)} * (f32x2){r1.z, r1.w}; }
            const float a = (a2.x + a2.y) + (b2.x + b2.y);
            float ss = ssq[(size_t)t * 16 + e] + ssq[(size_t)t * 16 + 8 + e];
            ss += shx(ss, 1, F.lane); ss += shx(ss, 2, F.lane); ss += shx(ss, 4, F.lane);
            const float rs = __builtin_amdgcn_rsqf(ss * (1.f / D) + NORM_EPS);
            lgs[tl * 8 + e] = a * rs;
            if (e == 0) rstd_tok[t] = rs;
        }
        __syncthreads();
        if (F.tid < 64) {
            const int tl = F.tid; float lg[8];
#pragma unroll
            for (int e = 0; e < 8; ++e) lg[e] = lgs[tl * 8 + e];
            int i1 = 0; float v1 = lg[0];
#pragma unroll
            for (int e = 1; e < 8; ++e) if (lg[e] > v1) { v1 = lg[e]; i1 = e; }
            int i2 = -1; float v2 = -3.0e38f;
#pragma unroll
            for (int e = 0; e < 8; ++e) if (e != i1 && lg[e] > v2) { v2 = lg[e]; i2 = e; }
            const float g1 = 1.f / (1.f + expf(v2 - v1)), g2 = 1.f - g1;
            sel[tl * 2] = i1; sel[tl * 2 + 1] = i2; selg[tl * 2] = g1; selg[tl * 2 + 1] = g2;
        }
        __syncthreads();
        if (F.tid < 8) {
            const int e = F.tid; int n = 0;
            for (int q = 0; q < 128; ++q) n += (sel[q] == e) ? 1 : 0;
            tcnt[tile * 8 + e] = n;
            int pos = 0;
            for (int q = 0; q < 128; ++q) if (sel[q] == e) { const int t = tile * 64 + (q >> 1);
                tok_e[t * 2 + (q & 1)] = e; tok_p[t * 2 + (q & 1)] = pos; tlist[(tile * 8 + e) * 64 + pos] = t; tgate[(tile * 8 + e) * 64 + pos] = selg[q]; ++pos; }
        }
        __syncthreads();
    }
}
__device__ __forceinline__ void moe_tables(Ctx& F, int j, LAS int* tab) {
    const int* tcnt = (const int*)(F.ws + WS_MOE + MO_TCNT); LAS int* baseL = (LAS int*)(F.lds + BASE_OFF);
    for (int i = F.tid; i < 2048; i += 512) baseL[i] = tcnt[i];
    __syncthreads();
    {
        const int e = F.wave, l4 = F.lane * 4;
        const int c0 = baseL[(l4 + 0) * 8 + e], c1 = baseL[(l4 + 1) * 8 + e], c2 = baseL[(l4 + 2) * 8 + e], c3 = baseL[(l4 + 3) * 8 + e];
        int inc = (c0 + c1) + (c2 + c3);
#pragma unroll
        for (int d = 1; d < 64; d <<= 1) { const int up = __builtin_amdgcn_ds_bpermute(((F.lane - d) & 63) << 2, inc); if (F.lane >= d) inc += up; }
        const int ex = inc - ((c0 + c1) + (c2 + c3));
        baseL[(l4 + 0) * 8 + e] = ex; baseL[(l4 + 1) * 8 + e] = ex + c0; baseL[(l4 + 2) * 8 + e] = ex + c0 + c1; baseL[(l4 + 3) * 8 + e] = ex + c0 + c1 + c2;
        if (F.lane == 63) tab[e] = inc;
    }
    __syncthreads();
    if (F.tid == 0) { int pp = 0; for (int e = 0; e < 8; ++e) { tab[8 + e] = pp; pp += (tab[e] + 255) >> 8; } tab[16] = pp; }
    __syncthreads();
}
__device__ __forceinline__ int slot_src(const LAS int* baseL, int e, int pos) {
    int lo = 0;
#pragma unroll
    for (int st = 128; st >= 1; st >>= 1) { const int m = lo + st; if (m < 256 && baseL[m * 8 + e] <= pos) lo = m; }
    return (lo * 8 + e) * 64 + (pos - baseL[lo * 8 + e]);
}
struct TailGeom { int nwg, Lmain, R, S; };
__device__ __forceinline__ TailGeom tail_geom(int NP, int G) {
    TailGeom t; t.nwg = NP * 4; t.Lmain = (t.nwg / G) * G; t.R = t.nwg - t.Lmain;
    t.S = 1; if (t.R > 0) { if (t.R * 14 <= G) t.S = 14; else if (t.R * 7 <= G) t.S = 7; else if (t.R * 2 <= G) t.S = 2; }
    return t;
}
__device__ __forceinline__ void combine_phase(Ctx& F, int j, float* out, bool last, LAS int* tab) {
    const unsigned char* y = (const unsigned char*)(F.ws + WS_Y); bf16_t* hb = (bf16_t*)(F.ws + WS_HB); float* ssq = (float*)(F.ws + WS_SSQ);
    const bf16_t* yt = (const bf16_t*)(F.ws + WS_YT);
    LAS int* tt = tab + 64;
    const int NP = __builtin_amdgcn_readfirstlane(tab[16]); const TailGeom tg = tail_geom(NP, F.G);
    for (int i = F.tid; i < NP * 4; i += 512) tt[i] = -1;
    __syncthreads();
    if (F.tid < tg.R) { pg8::TileOrder o; o.init(NP, 4, F.G, 0); int pm, pn; if (o.mapL(tg.Lmain + F.tid, pm, pn)) tt[pm * 4 + pn] = F.tid; }
    __syncthreads();
    const int* tok_e = (const int*)(F.ws + WS_MOE + MO_TOKE); const int* tok_p = (const int*)(F.ws + WS_MOE + MO_TOKP);
    const float* fn = F.in[I_FINAL_NORM];
    const int gw = F.bid * 8 + F.wave, NGW = F.G * 8;
    const LAS int* baseL = (const LAS int*)(F.lds + BASE_OFF);
    for (int tb = gw * 4; tb < T; tb += NGW * 4) {
        size_t s1[4], s2[4];
#pragma unroll
        for (int k = 0; k < 4; ++k) { const int t = tb + k, e1 = tok_e[2 * t], e2 = tok_e[2 * t + 1], tl6 = t >> 6;
            s1[k] = (size_t)tab[8 + e1] * 256 + baseL[tl6 * 8 + e1] + tok_p[2 * t]; s2[k] = (size_t)tab[8 + e2] * 256 + baseL[tl6 * 8 + e2] + tok_p[2 * t + 1]; }
        u32x2 hw[4][4]; unsigned ya[4][4], yb[4][4]; int t1[4][4], t2[4][4];
#pragma unroll
        for (int k = 0; k < 4; ++k)
#pragma unroll
            for (int q = 0; q < 4; ++q) {
                t1[k][q] = __builtin_amdgcn_readfirstlane(tt[(int)(s1[k] >> 8) * 4 + q]); t2[k][q] = __builtin_amdgcn_readfirstlane(tt[(int)(s2[k] >> 8) * 4 + q]);
                hw[k][q] = *((const u32x2*)(hb + (size_t)(tb + k) * D) + F.lane + 64 * q);
                ya[k][q] = *((const unsigned*)(y + s1[k] * D) + F.lane + 64 * q);
                yb[k][q] = *((const unsigned*)(y + s2[k] * D) + F.lane + 64 * q); }
        f32x4 v[4][4]; float ss[4];
#pragma unroll
        for (int k = 0; k < 4; ++k) { ss[k] = 0.f;
#pragma unroll
            for (int q = 0; q < 4; ++q) {
                const f32x2 a01 = __builtin_amdgcn_cvt_pk_f32_fp8((int)ya[k][q], false), a23 = __builtin_amdgcn_cvt_pk_f32_fp8((int)ya[k][q], true),
                            b01 = __builtin_amdgcn_cvt_pk_f32_fp8((int)yb[k][q], false), b23 = __builtin_amdgcn_cvt_pk_f32_fp8((int)yb[k][q], true);
                f32x4 fa = (f32x4){a01.x, a01.y, a23.x, a23.y} * 0.0625f, fb = (f32x4){b01.x, b01.y, b23.x, b23.y} * 0.0625f;
                if (t1[k][q] >= 0) { fa = (f32x4){0.f, 0.f, 0.f, 0.f}; const int r1 = (int)(s1[k] & 255);
                    for (int sl = 0; sl < tg.S; ++sl) { const u32x2 a = *((const u32x2*)(yt + ((size_t)(t1[k][q] * tg.S + sl) * 256 + r1) * 256) + F.lane); fa += (f32x4){bflo(a.x), bfhi(a.x), bflo(a.y), bfhi(a.y)}; } }
                if (t2[k][q] >= 0) { fb = (f32x4){0.f, 0.f, 0.f, 0.f}; const int r2 = (int)(s2[k] & 255);
                    for (int sl = 0; sl < tg.S; ++sl) { const u32x2 a = *((const u32x2*)(yt + ((size_t)(t2[k][q] * tg.S + sl) * 256 + r2) * 256) + F.lane); fb += (f32x4){bflo(a.x), bfhi(a.x), bflo(a.y), bfhi(a.y)}; } }
                f32x4 x = (f32x4){bflo(hw[k][q].x), bfhi(hw[k][q].x), bflo(hw[k][q].y), bfhi(hw[k][q].y)}; x = (x + fa) + fb;
                v[k][q] = x; ss[k] += (x.x * x.x + x.y * x.y) + (x.z * x.z + x.w * x.w); } }
#pragma unroll
        for (int o = 1; o < 64; o <<= 1) {
#pragma unroll
            for (int k = 0; k < 4; ++k) ss[k] += shx(ss[k], o, F.lane); }
#pragma unroll
        for (int k = 0; k < 4; ++k) { const int t = tb + k;
            if (last) { const float rs = __builtin_amdgcn_rsqf(ss[k] * (1.f / D) + NORM_EPS); f32x4* orow = (f32x4*)(out + (size_t)t * D) + F.lane;
#pragma unroll
                for (int q = 0; q < 4; ++q) { const f32x4 g = *((const f32x4*)fn + F.lane + 64 * q); orow[64 * q] = v[k][q] * rs * g; }
            } else {
                u32x2* o8 = (u32x2*)(hb + (size_t)t * D) + F.lane;
#pragma unroll
                for (int q = 0; q < 4; ++q) { u32x2 w; w.x = pk2(v[k][q].x, v[k][q].y); w.y = pk2(v[k][q].z, v[k][q].w); o8[64 * q] = w;
                    if (F8_IN & 0x4) *((unsigned*)(F.ws + WS_HB8 + (size_t)t * D) + F.lane + 64 * q) = pk4_f8(v[k][q].x, v[k][q].y, v[k][q].z, v[k][q].w); }
                if (F.lane < 16) ssq[(size_t)t * 16 + F.lane] = (F.lane == 0) ? ss[k] : 0.f;
            } }
    }
}

constexpr int PH_PER_LAYER = 10, N_PHASES = 1 + DEPTH * PH_PER_LAYER;
__host__ __device__ constexpr bool phase_exists(int ph) {
    if (ph == 0) return true;
    const int l = (ph - 1) / PH_PER_LAYER, k = (ph - 1) % PH_PER_LAYER;
    if (k <= 6) return true;
    if (k <= 8) return (l & 1) != 0;
    return false;
}

__global__ void __launch_bounds__(512, 2) fwd(Args args) {
    extern __shared__ __attribute__((aligned(16))) unsigned char lds_raw[];
    Ctx F;
    F.lds = (LAS unsigned char*)lds_raw; F.tid = 0; F.lane = 0; F.wave = __builtin_amdgcn_readfirstlane((int)threadIdx.x >> 6);
    F.G = gridDim.x; F.bid = blockIdx.x; F.in = args.in; F.out = args.out; F.ws = args.ws;
    volatile LAS unsigned* MISC = (volatile LAS unsigned*)(F.lds + MISC_OFF);
    LAS int* mtab = (LAS int*)(F.lds + MISC_OFF + 256);
    const int lo = args.ph_lo, hi = args.ph_hi;
    const bool fused = (hi - lo) > 1;
    XcdBarrier bar; bar.bar = (unsigned*)(F.ws + WS_CTL) + CW_BAR; bar.x = 0; bar.st = nullptr;
    if (fused) {
        if (threadIdx.x < 64) MISC[threadIdx.x] = 0u;
        __syncthreads();
        bar = xcd_barrier_post((unsigned*)(F.ws + WS_CTL) + CW_BAR, MISC + 8);
    }
#define IN(k) (lo <= (k) && (k) < hi)
#define SEAM(k) do { if (fused && (k) + 1 < hi) xcd_barrier(bar); else __syncthreads(); } while (0)
#define SITE_CTX int z_ = 0, zv_; asm volatile("" : "+s"(z_)); Ctx C = F; C.ws = F.ws + z_; C.in = F.in + z_; C.out = F.out + z_; \
    C.wave = F.wave + z_; asm volatile("v_mbcnt_lo_u32_b32 %0, -1, 0\n\tv_mbcnt_hi_u32_b32 %0, -1, %0" : "=v"(zv_)); C.lane = zv_; C.tid = C.wave * 64 + C.lane; C.G = (int)gridDim.x + z_; C.bid = (int)blockIdx.x + z_; unsigned char* ws = C.ws; (void)ws
#define P_HB ((bf16_t*)(ws + WS_HB))
#define P_SSQ ((float*)(ws + WS_SSQ))
#define P_PROJ ((bf16_t*)(ws + WS_PROJ))
#define P_MIX ((bf16_t*)(ws + WS_MIX))
#define P_ACT ((bf16_t*)(ws + WS_ACT))
#define P_YB ((bf16_t*)(ws + WS_Y))
#if SITE(0)
    if (IN(0)) { SITE_CTX; p0_prologue(C); SEAM(0); }
#endif

    for (int l = 0; l < DEPTH; ++l) {
        const int base = 1 + l * PH_PER_LAYER, j = l >> 1;
#if SITE(1)
        if (IN(base + 0)) {
            SITE_CTX;
            pg8::DenseSched S; S.o.init(T / 256, DIN / 256, C.G, C.bid); S.Bt = (const char*)(ws + WS_WIN) + (size_t)l * DIN * D * 2; S.tstepB = (size_t)256 * D * 2; S.ssq = P_SSQ; S.rgsrc = nullptr;
            if ((F8_IN >> l) & 1) { S.tstepB = (size_t)256 * D;
                pg8::EpiProj E{P_PROJ, (const LAS float*)(C.lds + RSB_OFF), (bf16_t*)(ws + FS_GATE), 0.03125f};
                pg8::gemm_phase<true>(C.lds, C.tid, (const char*)(ws + WS_HB8), D, D, S, E);
            } else {
                pg8::EpiProj E{P_PROJ, (const LAS float*)(C.lds + RSB_OFF), (bf16_t*)(ws + FS_GATE), 1.0f};
                pg8::gemm_phase<false>(C.lds, C.tid, (const char*)P_HB, 2 * D, 2 * D, S, E);
            }
            SEAM(base + 0);
        }
#endif
#if SITE(2)
        if (IN(base + 1)) {
            SITE_CTX;
            for (int rr = 0; rr < 1 + XREP_CONV; ++rr) conv_phase(C, l);
#if FAST_HG
            __syncthreads();
            for (int rr = 0; rr < 1 + XREP_HGL; ++rr) for (int u = C.bid; u < 256; u += C.G) hg_local(C, l, u);
#else
            ref_hg_prep(C, l);
#endif
#if FAST_S5
            __syncthreads();
            for (int rr = 0; rr < 1 + XREP_S5A; ++rr) for (int u = C.bid; u < 256; u += C.G) s5_endstates(C, l, u);
#else
            if (C.bid < 16 && C.wave == 0) ref_s5_scan(C, l, C.bid);
#endif
            SEAM(base + 1);
        }
#endif
#if SITE(3)
        if (IN(base + 2)) {
            SITE_CTX;
#if FAST_HG
            for (int u = C.bid; u < 1024; u += C.G) hg_carry(C, u);
#else
            if (C.bid < 8 && C.wave == 0) ref_hg_scan(C, C.bid);
#endif
#if FAST_S5
            for (int u = C.G - 1 - C.bid; u < 32; u += C.G) s5_carry(C, l, u);
#endif
            SEAM(base + 2);
        }
#endif
#if SITE(4)
        if (IN(base + 3)) {
            SITE_CTX;
#if FAST_HG
            for (int rr = 0; rr < 1 + XREP_HGF; ++rr) for (int u = C.bid; u < 256; u += C.G) hg_fix(C, l, u);
#else
            ref_finalize_hg(C, l);
#endif
#if FAST_S5
            __syncthreads();
            for (int rr = 0; rr < 1 + XREP_S5C; ++rr) for (int u = C.bid; u < 256; u += C.G) s5_pass<true>(C, l, u);
#else
            ref_finalize_s5(C, l);
#endif
            SEAM(base + 3);
        }
#endif
#if SITE(5)
        if (IN(base + 4)) {
            SITE_CTX;
            pg8::DenseSched S; S.o.init(T / 256, D / 256, C.G, C.bid); S.Bt = (const char*)(ws + WS_WOUT) + (size_t)l * D * D * 2; S.tstepB = (size_t)256 * D * 2; S.ssq = nullptr; S.rgsrc = nullptr;
            unsigned char* h8 = ((l & 1) || ((F8_FFN >> l) & 1)) ? (unsigned char*)(ws + WS_HB8) : nullptr;
            if ((F8_OUT >> l) & 1) { S.tstepB = (size_t)256 * D;
                pg8::EpiResid<32> E{P_HB, P_SSQ, h8};
                pg8::gemm_phase<true>(C.lds, C.tid, (const char*)(ws + WS_MIX8), D, D, S, E);
            } else {
                pg8::EpiResid<0> E{P_HB, P_SSQ, h8};
                pg8::gemm_phase<false>(C.lds, C.tid, (const char*)P_MIX, 2 * D, 2 * D, S, E);
            }
            SEAM(base + 4);
        }
#endif
        if ((l & 1) == 0) {
#if SITE(6)
            if (IN(base + 5)) {
                SITE_CTX;
                pg8::DenseSched S; S.o.init(T / 256, 2 * DFF / 256, C.G, C.bid); S.Bt = (const char*)(ws + WS_W13) + (size_t)j * 2 * DFF * D * 2; S.ssq = P_SSQ; S.rgsrc = nullptr;
                if ((F8_FFN >> l) & 1) { S.tstepB = (size_t)256 * D;
                    pg8::EpiSwiglu<true> E{(unsigned char*)P_ACT, (const LAS float*)(C.lds + RSB_OFF)};
                    pg8::gemm_phase<true>(C.lds, C.tid, (const char*)(ws + WS_HB8), D, D, S, E);
                } else { S.tstepB = (size_t)256 * D * 2;
                    pg8::EpiSwiglu<false> E{(unsigned char*)P_ACT, (const LAS float*)(C.lds + RSB_OFF)};
                    pg8::gemm_phase<false>(C.lds, C.tid, (const char*)P_HB, 2 * D, 2 * D, S, E);
                }
                SEAM(base + 5);
            }
#endif
#if SITE(7)
            if (IN(base + 6)) {
                SITE_CTX;
                pg8::DenseSched S; S.o.init(T / 256, D / 256, C.G, C.bid); S.Bt = (const char*)(ws + WS_W2) + (size_t)j * D * DFF * 2; S.ssq = nullptr; S.rgsrc = nullptr;
                if ((F8_FFN >> l) & 1) { S.tstepB = (size_t)256 * DFF;
                    pg8::EpiResid<256> E{P_HB, P_SSQ, ((F8_IN >> (l + 1)) & 1) ? (unsigned char*)(ws + WS_HB8) : nullptr};
                    pg8::gemm_phase<true>(C.lds, C.tid, (const char*)P_ACT, DFF, DFF, S, E);
                } else { S.tstepB = (size_t)256 * DFF * 2;
                    pg8::EpiResid<0> E{P_HB, P_SSQ, ((F8_IN >> (l + 1)) & 1) ? (unsigned char*)(ws + WS_HB8) : nullptr};
                    pg8::gemm_phase<false>(C.lds, C.tid, (const char*)P_ACT, 2 * DFF, 2 * DFF, S, E);
                }
                SEAM(base + 6);
            }
#endif
        } else {
#if SITE(8)
            if (IN(base + 5)) { SITE_CTX; router_phase(C, j); SEAM(base + 5); }
#endif
#if SITE(9)
            if (IN(base + 6)) {
                SITE_CTX;
                moe_tables(C, j, mtab);
                pg8::MoeSched S; S.o.init(__builtin_amdgcn_readfirstlane(mtab[16]), 2 * DFF / 256, C.G, C.bid); S.Bt = (const char*)(ws + WS_MW13) + (size_t)j * 8 * 2 * DFF * D; S.estepB = (size_t)2 * DFF * D; S.tstepB = (size_t)256 * D;
                S.tab = mtab; S.tlist = (const int*)(ws + WS_MOE + MO_TLIST); S.gather = true; S.tgate = nullptr; S.rstd_tok = (const float*)(ws + WS_MOE + MO_RSTD); S.baseL = (const LAS int*)(C.lds + BASE_OFF); S.rsbp = (const LAS unsigned*)(C.lds + RSB_OFF);
                pg8::EpiSwigluMoe E{(unsigned char*)P_ACT, (const float*)(ws + WS_MOE + MO_RSTD), (const LAS int*)(C.lds + RSB_OFF)};
                pg8::gemm_phase<true>(C.lds, C.tid, (const char*)(ws + WS_HB8), D, D, S, E);
                SEAM(base + 6);
            }
#endif
#if SITE(10)
            if (IN(base + 7)) {
                SITE_CTX;
                if (!IN(base + 6)) moe_tables(C, j, mtab);
                const int NP = __builtin_amdgcn_readfirstlane(mtab[16]); const TailGeom tg = tail_geom(NP, C.G);
                {
                pg8::MoeSched S; S.o.init(NP, D / 256, C.G, C.bid); S.o.lim = tg.Lmain; S.Bt = (const char*)(ws + WS_MW2) + (size_t)j * 8 * D * DFF; S.estepB = (size_t)D * DFF; S.tstepB = (size_t)256 * DFF;
                S.tab = mtab; S.tlist = nullptr; S.gather = false; S.rstd_tok = nullptr; S.tgate = (const float*)(ws + WS_MOE + MO_TGATE); S.baseL = (const LAS int*)(C.lds + BASE_OFF); S.rsbp = (const LAS unsigned*)(C.lds + RSB_OFF);
                pg8::EpiMoeOut E{(unsigned char*)P_YB, (const LAS float*)(C.lds + RSB_OFF)};
                pg8::gemm_phase<true>(C.lds, C.tid, (const char*)P_ACT, DFF, DFF, S, E);
                }
                if (tg.R > 0) {
                pg8::MoeTailSched S; S.o.init(NP, D / 256, C.G, C.bid); S.Bt = (const char*)(ws + WS_MW2) + (size_t)j * 8 * D * DFF; S.estepB = (size_t)D * DFF; S.tstepB = (size_t)256 * DFF;
                S.tab = mtab; S.tgate = (const float*)(ws + WS_MOE + MO_TGATE); S.baseL = (const LAS int*)(C.lds + BASE_OFF); S.Lmain = tg.Lmain; S.R = tg.R; S.S = tg.S; S.Kslice = DFF / tg.S;
                pg8::EpiMoeTail E{(bf16_t*)(ws + WS_YT) + (size_t)C.bid * 65536, (const LAS float*)(C.lds + RSB_OFF)};
                int tid2 = C.tid; asm volatile("" : "+v"(tid2));
                pg8::gemm_phase<true>(C.lds, tid2, (const char*)P_ACT, DFF / tg.S, DFF, S, E);
                }
                SEAM(base + 7);
            }
#endif
#if SITE(11)
            if (IN(base + 8)) {
                SITE_CTX;
                if (!IN(base + 6)) moe_tables(C, j, mtab);
                combine_phase(C, j, C.out, l == DEPTH - 1, mtab);
                SEAM(base + 8);
            }
#endif
        }
    }
#undef IN
#undef SEAM
}

extern "C" void kernel_launch(void* const* d_in, const int* in_sizes, int n_in, void* d_out, int out_size, void* d_ws, size_t ws_size, hipStream_t stream) {
    static int grid = 0;
    if (grid == 0) {
        if (n_in != 27 || in_sizes[0] != T * D || out_size != T * D || ws_size < WS_END) { fprintf(stderr, "kernel_launch: unexpected problem shape / workspace (%d inputs, ws %zu)\n", n_in, ws_size); grid = -1; return; }
        int dev = 0, cus = 0, per_cu = 0;
        if (hipGetDevice(&dev) != hipSuccess || hipDeviceGetAttribute(&cus, hipDeviceAttributeMultiprocessorCount, dev) != hipSuccess) { grid = -1; return; }
        if (hipFuncSetAttribute((const void*)fwd, hipFuncAttributeMaxDynamicSharedMemorySize, LDS_BYTES) != hipSuccess) { fprintf(stderr, "kernel_launch: hipFuncSetAttribute failed\n"); grid = -1; return; }
        if (hipOccupancyMaxActiveBlocksPerMultiprocessor(&per_cu, (const void*)fwd, 512, LDS_BYTES) != hipSuccess || per_cu < 1) fprintf(stderr, "kernel_launch: occupancy query reports %d\n", per_cu);
        (void)hipGetLastError();
        grid = cus;
    }
    if (grid < 0) return;
    if (hipMemsetAsync((char*)d_ws + WS_CTL + CW_BAR * 4, 0, XCD_BAR_WORDS * 4, stream) != hipSuccess) return;
    Args a{};
    for (int i = 0; i < 27; ++i) a.in[i] = (const float*)d_in[i];
    a.out = (float*)d_out; a.ws = (unsigned char*)d_ws;
#if MK_FUSED
    a.ph_lo = 0; a.ph_hi = N_PHASES;
    hipLaunchKernelGGL(fwd, dim3(grid), dim3(512), LDS_BYTES, stream, a);
#else
#ifndef MAXPH
#define MAXPH N_PHASES
#endif
    for (int ph = 0; ph < MAXPH; ++ph) {
        if (!phase_exists(ph)) continue;
        a.ph_lo = ph; a.ph_hi = ph + 1;
        hipLaunchKernelGGL(fwd, dim3(grid), dim3(512), LDS_BYTES, stream, a);
#ifdef REP_PH
        if (ph == REP_PH) for (int rr = 0; rr < REP_N; ++rr) hipLaunchKernelGGL(fwd, dim3(grid), dim3(512), LDS_BYTES, stream, a);
#endif
    }
#endif
}
```

```cpp
#include <hip/hip_runtime.h>
#include <cstdio>
#include <cstdint>

#ifndef MK_FUSED
#define MK_FUSED 1
#endif
#ifndef XREP_HGL
#define XREP_HGL 0
#endif
#ifndef XREP_S5A
#define XREP_S5A 0
#endif
#ifndef XREP_CONV
#define XREP_CONV 0
#endif
#ifndef XREP_HGF
#define XREP_HGF 0
#endif
#ifndef XREP_S5C
#define XREP_S5C 0
#endif
#ifndef FAST_HG
#define FAST_HG 1
#endif
#ifndef FAST_S5
#define FAST_S5 1
#endif

#ifndef PH_MASK
#define PH_MASK 0xFFFF
#endif
#define SITE(n) ((PH_MASK >> (n)) & 1)
#define LAS __attribute__((address_space(3)))
#define GAS __attribute__((address_space(1)))
typedef unsigned short bf16_t;
typedef short bf16x8 __attribute__((ext_vector_type(8)));
typedef float f32x4 __attribute__((ext_vector_type(4)));
typedef float f32x2 __attribute__((ext_vector_type(2)));
typedef unsigned u32x4 __attribute__((ext_vector_type(4)));
typedef unsigned u32x2 __attribute__((ext_vector_type(2)));
typedef int i32x4 __attribute__((ext_vector_type(4)));
typedef int i32x8 __attribute__((ext_vector_type(8)));

constexpr int T = 16384, D = 1024, DIN = 3072, DFF = 3584, NE = 8, DEPTH = 4;
constexpr int S5W = 256, S5G = 16, S5P = 64, CW = 256, HGW = 512, HGH = 4, HGD = 128;
constexpr int F8_FFN = 0x4;
constexpr int F8_IN = 0xC;
constexpr int ECAP = 16384;
constexpr int MAXP = 136;
constexpr float NORM_EPS = 1e-6f;
constexpr int PC_U = 0, PC_CB = 256, PC_CC = 512, PC_CV = 768, PC_Q = 1024, PC_F = 1536, PC_I = 2048, PC_G = 2560;

constexpr size_t MiB = 1u << 20;
constexpr size_t WS_CTL = 0, CTL_BYTES = 1 * MiB;
constexpr size_t WS_WIN = 1 * MiB;
constexpr size_t WS_WOUT = 25 * MiB;
constexpr size_t WS_W13 = 33 * MiB;
constexpr size_t WS_W2 = 61 * MiB;
constexpr size_t WS_MW13 = 75 * MiB;
constexpr size_t WS_HB8 = 187 * MiB;
constexpr size_t WS_MW2 = 299 * MiB;
constexpr size_t WS_GLU = 411 * MiB;
constexpr size_t WS_TAB = 412 * MiB;
constexpr size_t WS_HB = 413 * MiB;
constexpr size_t WS_SSQ = 445 * MiB;
constexpr size_t WS_MOE = 446 * MiB;
constexpr size_t WS_Y = 448 * MiB;
constexpr size_t WS_X = 516 * MiB;
constexpr size_t WS_PROJ = WS_X, WS_MIX = WS_X + 96 * MiB, WS_ACT = WS_X;
constexpr size_t WS_RL = WS_X;
constexpr size_t WS_SCR = 754 * MiB;
constexpr size_t WS_YT = WS_SCR;
constexpr size_t WS_VT = WS_SCR + 32 * MiB;
constexpr size_t WS_END = 896 * MiB;
constexpr int TB_LBC = 0;
constexpr int TB_LAMB = 2048;
constexpr int TB_BBAR = TB_LAMB + 4 * 16 * 64 * 2;
constexpr int TB_RG = TB_BBAR + 4 * 16 * 64 * 16 * 2;
constexpr int TB_END = TB_RG + 2 * 8 * 1024;
static_assert((size_t)TB_END * 4 <= MiB, "tables");
constexpr size_t MO_TOKE = 0;
constexpr size_t MO_TOKP = 128 * 1024;
constexpr size_t MO_RSTD = 256 * 1024;
constexpr size_t MO_TCNT = 384 * 1024;
constexpr size_t MO_TLIST = 512 * 1024;
constexpr size_t MO_TGATE = 1024 * 1024;
constexpr size_t SC_F = WS_SCR, SC_K = WS_SCR + 32 * MiB, SC_Q = WS_SCR + 64 * MiB, SC_O = WS_SCR + 96 * MiB;
constexpr size_t FS = WS_X + 128 * MiB;
constexpr size_t FS_OLOC = FS;
constexpr size_t FS_ASEG = FS + 16 * MiB;
constexpr size_t FS_SEND = FS + 32 * MiB;
constexpr size_t FS_SST = FS + 48 * MiB;
constexpr size_t FS_DSEG = FS + 56 * MiB;
constexpr size_t FS_XE = FS + 57 * MiB;
constexpr size_t FS_XIN = FS + 59 * MiB;
constexpr size_t FS_GATE = FS + 61 * MiB;
constexpr size_t WS_BB = WS_GLU + 512 * 1024;
constexpr size_t WS_CM = WS_GLU + 768 * 1024;
constexpr size_t SC_Y1 = WS_Y;
static_assert(SC_O + (size_t)T * 512 * 4 <= WS_END, "ws map");
constexpr int CW_BAR = 4096;
constexpr int CW_CNT = 16384;

constexpr int RING_BYTES = 131072;
constexpr int LDS_BYTES = 163840;
constexpr int MISC_OFF = LDS_BYTES - 4096;
constexpr int RSB_OFF = RING_BYTES;
constexpr int RSB_UNITS = (MISC_OFF - RSB_OFF) / 1024;
constexpr int BASE_OFF = RING_BYTES + 20480;

__device__ __forceinline__ unsigned f2bf(float f) { unsigned u = __builtin_bit_cast(unsigned, f); return (u + 0x7fffu + ((u >> 16) & 1u)) >> 16; }
__device__ __forceinline__ unsigned pk2(float lo, float hi) { unsigned r; asm("v_cvt_pk_bf16_f32 %0, %1, %2" : "=v"(r) : "v"(lo), "v"(hi)); return r; }
__device__ __forceinline__ unsigned pk4_f8(float a, float b, float c, float d) {
    a = __builtin_amdgcn_fmed3f(a, -448.f, 448.f); b = __builtin_amdgcn_fmed3f(b, -448.f, 448.f); c = __builtin_amdgcn_fmed3f(c, -448.f, 448.f); d = __builtin_amdgcn_fmed3f(d, -448.f, 448.f);
    int w = 0; w = __builtin_amdgcn_cvt_pk_fp8_f32(a, b, w, false); w = __builtin_amdgcn_cvt_pk_fp8_f32(c, d, w, true); return (unsigned)w; }
__device__ __forceinline__ float bf2f(unsigned short b) { return __builtin_bit_cast(float, (unsigned)b << 16); }
__device__ __forceinline__ float bflo(unsigned w) { return __builtin_bit_cast(float, w << 16); }
__device__ __forceinline__ float bfhi(unsigned w) { return __builtin_bit_cast(float, w & 0xffff0000u); }
__device__ __forceinline__ float shx(float v, int m, int lane) { return __builtin_bit_cast(float, __builtin_amdgcn_ds_bpermute((lane ^ m) << 2, __builtin_bit_cast(int, v))); }
__device__ __forceinline__ float wave_sum(float v, int lane) {
#pragma unroll
    for (int o = 1; o < 64; o <<= 1) v += shx(v, o, lane);
    return v;
}
__device__ __forceinline__ float sigmoidf_(float x) { return __builtin_amdgcn_rcpf(1.f + __expf(-x)); }
__device__ __forceinline__ float siluf_(float x) { return x * __builtin_amdgcn_rcpf(1.f + __expf(-x)); }
__device__ __forceinline__ float gelu_tanh(float x) { const float u2 = 1.5957691216057308f * (x + 0.044715f * x * x * x); return x * __builtin_amdgcn_rcpf(1.f + __expf(-u2)); }
__device__ __forceinline__ float rstd_from_ssq(const float* ssq, int row) {
    const f32x4* p = (const f32x4*)(ssq + (size_t)row * 16);
    const f32x4 a = p[0], b = p[1], c = p[2], d = p[3];
    const float s = ((a.x + a.y) + (a.z + a.w)) + ((b.x + b.y) + (b.z + b.w)) + ((c.x + c.y) + (c.z + c.w)) + ((d.x + d.y) + (d.z + d.w));
    return __builtin_amdgcn_rsqf(s * (1.f / D) + NORM_EPS);
}

__device__ __forceinline__ int slot_src(const LAS int* baseL, int e, int pos);
namespace pg8 {
constexpr int BM = 256, BK = 64, HALF = 128, HTB = HALF * BK * 2, STAGE_BYTES = 8 * HTB, NXCD = 8, WGM = 4;
__host__ __device__ __forceinline__ int lds_byte(int r, int c) { const int st = (r >> 4) * 2 + (c >> 5), rr = r & 15, cc = c & 31, ob = rr * 64 + cc * 2; return st * 1024 + (ob ^ (((ob >> 9) & 1) << 5)); }
__host__ __device__ __forceinline__ void stage_rc(int b, int& R, int& C) { const int st = b / 1024, sb = b % 1024, swz = sb ^ (((sb >> 9) & 1) << 5); R = (st >> 1) * 16 + swz / 64; C = (st & 1) * 32 + (swz % 64) / 2; }
__host__ __device__ __forceinline__ int perm32(int rho) { const int n = rho >> 4, i = rho & 15; return 8 * (i >> 2) + 4 * n + (i & 3); }

struct Unit { int pm, pn, e, lp, ord, ks; };

struct TileOrder {
    int nM, nN, nwg, G, c, lim;
    __device__ __forceinline__ void init(int nM_, int nN_, int G_, int c_) { nM = nM_; nN = nN_; nwg = nM * nN; G = G_; c = c_; lim = nwg; }
    __device__ __forceinline__ bool map(int i, int& pm, int& pn) const { const long L = (long)i * G + c; if (L >= lim) return false; return mapL(L, pm, pn); }
    __device__ __forceinline__ bool mapL(long L, int& pm, int& pn) const {
        if (L >= nwg) return false;
        int wgid = (int)L; { const int q = nwg / NXCD, r = nwg % NXCD, xcd = wgid % NXCD, off = wgid / NXCD; wgid = (xcd < r ? xcd * (q + 1) : r * (q + 1) + (xcd - r) * q) + off; }
        const int nig = WGM * nN, gid = wgid / nig, fm = gid * WGM, gsz = (nM - fm) < WGM ? (nM - fm) : WGM;
        pm = fm + ((wgid % nig) % gsz); pn = (wgid % nig) / gsz; return true;
    }
};

__device__ __forceinline__ unsigned cvt_pk_bf16(float lo, float hi) { unsigned r; asm("v_cvt_pk_bf16_f32 %0, %1, %2" : "=v"(r) : "v"(lo), "v"(hi)); return r; }

template <bool F8, class Epi, class Sched>
__device__ __forceinline__ void gemm_phase(LAS unsigned char* lds, const int tid, const char* Abase, const int Kb, const int ldb, const Sched& S, const Epi& E) {
    const int wid = __builtin_amdgcn_readfirstlane(tid >> 6), lane = tid & 63, wr = wid >> 2, wc = wid & 3, fr = lane & 15, fq = lane >> 4;
    const int nt = Kb / (BK * 2);
    unsigned voffB[2];
#pragma unroll
    for (int i = 0; i < 2; ++i) { int R, C; stage_rc(tid * 16 + i * 8192, R, C); const int Rb = Epi::PERM ? ((R & ~31) + perm32(R & 31)) : R; voffB[i] = (unsigned)(Rb * ldb + C * 2); }
    const size_t kstep = (size_t)(BK * 2);
    const size_t hstep = (size_t)HALF * ldb;
    int one8 = 0x7f7f7f7f; asm volatile("" : "+v"(one8));
    const unsigned ldsw = (unsigned)wid * 1024u;
    const int aoff = lds_byte(wr * 64 + fr, fq * 8), boff = lds_byte(wc * 32 + fr, fq * 8);
#define PG8_SA(b, h) (((b) * 2 + (h)) * HTB)
#define PG8_SB(b, h) ((4 + (b) * 2 + (h)) * HTB)
#define PG8_STAGE(bufoff, gbase, voff) do { _Pragma("unroll") for (int _i = 0; _i < 2; ++_i) \
        __builtin_amdgcn_global_load_lds((const unsigned*)((const char*)(gbase) + (voff)[_i]), (LAS unsigned*)(lds + (bufoff) + ldsw + _i * 8192), 16, 0, 0); } while (0)
#define PG8_STAGEA(bufoff, kb, o0, o1) do { \
        __builtin_amdgcn_global_load_lds((const unsigned*)(Abase + (kb) + (o0)), (LAS unsigned*)(lds + (bufoff) + ldsw), 16, 0, 0); \
        __builtin_amdgcn_global_load_lds((const unsigned*)(Abase + (kb) + (o1)), (LAS unsigned*)(lds + (bufoff) + ldsw + 8192), 16, 0, 0); } while (0)
#define PG8_LDA(dst, b, h) do { _Pragma("unroll") for (int m = 0; m < 4; ++m) _Pragma("unroll") for (int k = 0; k < 2; ++k) dst[m][k] = *(const LAS bf16x8*)(lds + PG8_SA(b, h) + aoff + m * 2048 + k * 1024); } while (0)
#define PG8_LDB(dst, b, h) do { _Pragma("unroll") for (int n = 0; n < 2; ++n) _Pragma("unroll") for (int k = 0; k < 2; ++k) dst[n][k] = *(const LAS bf16x8*)(lds + PG8_SB(b, h) + boff + n * 2048 + k * 1024); } while (0)
#define PG8_CAT8(x) __builtin_shufflevector(__builtin_bit_cast(i32x4, (x)[0]), __builtin_bit_cast(i32x4, (x)[1]), 0, 1, 2, 3, 4, 5, 6, 7)
#define PG8_MMA(ai, bj, At, Bt) do { __builtin_amdgcn_s_setprio(1); \
        if constexpr (F8) { _Pragma("unroll") for (int m = 0; m < 4; ++m) _Pragma("unroll") for (int n = 0; n < 2; ++n) \
            acc[ai][bj][m][n] = __builtin_amdgcn_mfma_scale_f32_16x16x128_f8f6f4(PG8_CAT8(Bt[n]), PG8_CAT8(At[m]), acc[ai][bj][m][n], 0, 0, 0, one8, 0, one8); } \
        else { _Pragma("unroll") for (int m = 0; m < 4; ++m) _Pragma("unroll") for (int n = 0; n < 2; ++n) _Pragma("unroll") for (int k = 0; k < 2; ++k) \
            acc[ai][bj][m][n] = __builtin_amdgcn_mfma_f32_16x16x32_bf16(Bt[n][k], At[m][k], acc[ai][bj][m][n], 0, 0, 0); } \
        __builtin_amdgcn_s_setprio(0); } while (0)
#define PG8_WAIT_V(n) asm volatile("s_waitcnt vmcnt(" #n ")" ::: "memory")
#define PG8_WAIT_L(n) asm volatile("s_waitcnt lgkmcnt(" #n ")" ::: "memory")
#define PG8_BAR __builtin_amdgcn_s_barrier()
#define PG8_SCHED __builtin_amdgcn_sched_barrier(0)
    Unit cur, nxt; int ui = 0;
    const bool any = S.next(0, cur);
    const char* cB = any ? S.b_base(cur) : nullptr;
    unsigned c00 = 0, c01 = 0, c10 = 0, c11 = 0, n00, n01, n10, n11;
    const bool aearly = any && S.a_early();
    if (any) { PG8_STAGE(PG8_SB(0, 0), cB, voffB); PG8_STAGE(PG8_SB(0, 1), cB + hstep, voffB);
        if (aearly) { S.a_off(cur, tid, ldb, c00, c01, c10, c11); PG8_STAGEA(PG8_SA(0, 0), 0, c00, c01); PG8_STAGEA(PG8_SA(0, 1), 0, c10, c11); } }
    S.stage((LAS unsigned*)(lds + RSB_OFF), tid);
    __syncthreads();
    if (!any) return;
    f32x4 acc[2][2][4][2];
    if constexpr (Epi::PRELOAD) E.preload(acc, cur, wr, wc, fr, fq);
    else {
#pragma unroll
    for (int a = 0; a < 2; ++a)
#pragma unroll
        for (int b = 0; b < 2; ++b)
#pragma unroll
            for (int m = 0; m < 4; ++m)
#pragma unroll
                for (int n = 0; n < 2; ++n) acc[a][b][m][n] = (f32x4){0.f, 0.f, 0.f, 0.f};
    }
    bf16x8 At[4][2], B0[2][2], B1[2][2];
    if (!aearly) { S.a_off(cur, tid, ldb, c00, c01, c10, c11); PG8_STAGEA(PG8_SA(0, 0), 0, c00, c01); PG8_STAGEA(PG8_SA(0, 1), 0, c10, c11); }
    if (wr == 1) PG8_BAR;
    PG8_WAIT_V(2); PG8_BAR;
    PG8_STAGE(PG8_SB(1, 0), cB + kstep, voffB); PG8_STAGEA(PG8_SA(1, 0), kstep, c00, c01); PG8_STAGE(PG8_SB(1, 1), cB + hstep + kstep, voffB);
    PG8_WAIT_V(6); PG8_BAR;
    for (;;) {
        const bool has_next = S.next(ui + 1, nxt);
        const char* nB = cB;
        n00 = c00; n01 = c01; n10 = c10; n11 = c11;
        if (has_next) { nB = S.b_base(nxt); S.a_off(nxt, tid, ldb, n00, n01, n10, n11); }
#define PG8_PAIR(FIN) do { \
            if constexpr (F8) asm volatile("" : "+v"(c00), "+v"(c01), "+v"(c10), "+v"(c11), "+v"(voffB[0]), "+v"(voffB[1]));     \
            const bool last = (t == nt - 2); \
            const size_t kb1 = (size_t)(t + 1) * kstep; \
            const size_t kb2 = last ? 0 : (size_t)(t + 2) * kstep; \
            const char* b2 = last ? nB : cB + (size_t)(t + 2) * kstep; \
            const char* b3 = b2 + kstep; \
              \
            PG8_LDB(B0, 0, 0); PG8_LDB(B1, 0, 1); PG8_SCHED; PG8_LDA(At, 0, 0); PG8_STAGEA(PG8_SA(1, 1), kb1, c10, c11); \
            if (last) { c00 = n00; c01 = n01; c10 = n10; c11 = n11; }     \
            if (FIN) PG8_WAIT_V(0); else PG8_WAIT_V(8); PG8_WAIT_L(0); PG8_BAR; PG8_MMA(0, 0, At, B0); PG8_MMA(0, 1, At, B1); PG8_BAR; PG8_SCHED; \
              \
            PG8_LDA(At, 0, 1); if (!(FIN)) { PG8_STAGE(PG8_SB(0, 0), b2, voffB); PG8_STAGE(PG8_SB(0, 1), b2 + hstep, voffB); PG8_STAGEA(PG8_SA(0, 0), kb2, c00, c01); } \
            if (FIN) PG8_WAIT_V(0); else PG8_WAIT_V(8); PG8_WAIT_L(0); PG8_BAR; PG8_MMA(1, 0, At, B0); PG8_MMA(1, 1, At, B1); PG8_BAR; PG8_SCHED; \
              \
            PG8_LDB(B0, 1, 0); PG8_LDB(B1, 1, 1); PG8_SCHED; PG8_LDA(At, 1, 0); if (!(FIN)) { PG8_STAGEA(PG8_SA(0, 1), kb2, c10, c11); } \
            if (FIN) PG8_WAIT_V(0); else PG8_WAIT_V(8); PG8_WAIT_L(0); PG8_BAR; PG8_MMA(0, 0, At, B0); PG8_MMA(0, 1, At, B1); PG8_BAR; PG8_SCHED; \
              \
            PG8_LDA(At, 1, 1); if (!(FIN)) { PG8_STAGE(PG8_SB(1, 0), b3, voffB); PG8_STAGE(PG8_SB(1, 1), b3 + hstep, voffB); PG8_STAGEA(PG8_SA(1, 0), kb2 + kstep, c00, c01); } \
            if (FIN) PG8_WAIT_V(0); else PG8_WAIT_V(8); PG8_WAIT_L(0); PG8_BAR; PG8_MMA(1, 0, At, B0); PG8_MMA(1, 1, At, B1); PG8_BAR; PG8_SCHED; \
        } while (0)
        {
            const int nt_main = (has_next || F8) ? nt : nt - 2;
            int t = 0;
            _Pragma("nounroll") for (; t < nt_main; t += 2) PG8_PAIR(false);
            if constexpr (!F8) { if (!has_next) PG8_PAIR(true); }
        }
#undef PG8_PAIR
        if (wr == 0) PG8_BAR;
        { int l2 = lane; asm volatile("" : "+v"(l2));
          E(acc, cur, wr, wc, l2 & 15, l2 >> 4); }
        if (!has_next) break;
        if constexpr (Epi::PRELOAD) E.preload(acc, nxt, wr, wc, fr, fq);
        else {
#pragma unroll
        for (int a = 0; a < 2; ++a)
#pragma unroll
            for (int b = 0; b < 2; ++b)
#pragma unroll
                for (int m = 0; m < 4; ++m)
#pragma unroll
                    for (int n = 0; n < 2; ++n) acc[a][b][m][n] = (f32x4){0.f, 0.f, 0.f, 0.f};
        }
        cur = nxt; cB = nB; ++ui;
        if (wr == 1) PG8_BAR;
    }
    PG8_WAIT_V(0);
    PG8_BAR;
#undef PG8_SA
#undef PG8_SB
#undef PG8_STAGE
#undef PG8_STAGEA
#undef PG8_LDA
#undef PG8_LDB
#undef PG8_MMA
#undef PG8_CAT8
#undef PG8_WAIT_V
#undef PG8_WAIT_L
#undef PG8_BAR
#undef PG8_SCHED
}

struct DenseSched {
    TileOrder o; const char* Bt; size_t tstepB; const float* ssq; const float* rgsrc;
    __device__ __forceinline__ bool next(int i, Unit& u) const { u.e = 0; u.lp = 0; u.ord = i; return o.map(i, u.pm, u.pn); }
    __device__ __forceinline__ bool a_early() const { return ssq != nullptr; }
    __device__ __forceinline__ void stage(LAS unsigned* rsb, int tid) const {
        if (rgsrc) {
#pragma unroll
            for (int i = 0; i < 3; ++i) { Unit u; if (next(i, u)) { const int idx = tid * 4, e = idx >> 8, c = idx & 255;
                *(LAS f32x4*)((LAS float*)rsb + i * 2048 + idx) = *(const f32x4*)(rgsrc + e * 1024 + u.pn * 256 + c); } }
        }
        if (!ssq) return;
        float v[4]; bool ok[4];
#pragma unroll
        for (int q = 0; q < 4; ++q) { Unit u; const int i = 2 * q + (tid >> 8); ok[q] = next(i, u); v[q] = rstd_from_ssq(ssq, (ok[q] ? u.pm : 0) * 256 + (tid & 255)); }
#pragma unroll
        for (int q = 0; q < 4; ++q) if (ok[q]) rsb[(2 * q + (tid >> 8)) * 256 + (tid & 255)] = __builtin_bit_cast(unsigned, v[q]);
    }
    __device__ __forceinline__ const char* b_base(const Unit& u) const { return Bt + (size_t)u.pn * tstepB; }
    __device__ __forceinline__ void a_off(const Unit& u, int tid, int ldb, unsigned& o00, unsigned& o01, unsigned& o10, unsigned& o11) const {
        int RA[2], CA[2]; stage_rc(tid * 16, RA[0], CA[0]); stage_rc(tid * 16 + 8192, RA[1], CA[1]);
        const int r0 = u.pm * 256;
        o00 = (unsigned)((r0 + RA[0]) * ldb + CA[0] * 2); o01 = (unsigned)((r0 + RA[1]) * ldb + CA[1] * 2);
        o10 = (unsigned)((r0 + 128 + RA[0]) * ldb + CA[0] * 2); o11 = (unsigned)((r0 + 128 + RA[1]) * ldb + CA[1] * 2);
    }
};
struct MoeSched {
    TileOrder o; const char* Bt; size_t estepB, tstepB; const LAS int* tab; const int* tlist; bool gather; const LAS unsigned* rsbp;
    const float* tgate; const LAS int* baseL; const float* rstd_tok;
    __device__ __forceinline__ bool a_early() const { return !gather; }
    __device__ __forceinline__ void stage(LAS unsigned* rsb, int tid) const {
        unsigned v[8]; bool ok[8], in[8];
#pragma unroll
        for (int q = 0; q < 8; ++q) { Unit u; const int i = 2 * q + (tid >> 8); ok[q] = next(i, u);
            const int e = ok[q] ? u.e : 0, cnt = tab[e], sl = (ok[q] ? u.lp : 0) * 256 + (tid & 255); in[q] = ok[q] && sl < cnt;
            const int src = in[q] ? slot_src(baseL, e, sl) : 0;
            v[q] = gather ? (unsigned)tlist[src] : __builtin_bit_cast(unsigned, tgate[src]); }
        if (gather) {
#pragma unroll
            for (int q = 0; q < 8; ++q) v[q] = (v[q] & 0xffffu) | (f2bf(rstd_tok[v[q] & 0x3fffu]) << 16);
        }
#pragma unroll
        for (int q = 0; q < 8; ++q) if (ok[q]) rsb[(2 * q + (tid >> 8)) * 256 + (tid & 255)] = in[q] ? v[q] : (gather ? 0x0000ffffu : 0u);
    }
    __device__ __forceinline__ bool next(int i, Unit& u) const {
        u.ord = i;
        if (!o.map(i, u.pm, u.pn)) return false;
        int e = 0;
#pragma unroll
        for (int j = 1; j < 8; ++j) e += (u.pm >= __builtin_amdgcn_readfirstlane(tab[8 + j])) ? 1 : 0;
        u.e = e; u.lp = u.pm - __builtin_amdgcn_readfirstlane(tab[8 + e]); return true;
    }
    __device__ __forceinline__ const char* b_base(const Unit& u) const { return Bt + (size_t)u.e * estepB + (size_t)u.pn * tstepB; }
    __device__ __forceinline__ void a_off(const Unit& u, int tid, int ldb, unsigned& o00, unsigned& o01, unsigned& o10, unsigned& o11) const {
        int RA[2], CA[2]; stage_rc(tid * 16, RA[0], CA[0]); stage_rc(tid * 16 + 8192, RA[1], CA[1]);
        if (gather) {
            const LAS int* tk = (const LAS int*)rsbp + u.ord * 256;
            int t00 = tk[RA[0]] & 0xffff, t01 = tk[RA[1]] & 0xffff, t10 = tk[128 + RA[0]] & 0xffff, t11 = tk[128 + RA[1]] & 0xffff;
            t00 = t00 == 0xffff ? 0 : t00; t01 = t01 == 0xffff ? 0 : t01; t10 = t10 == 0xffff ? 0 : t10; t11 = t11 == 0xffff ? 0 : t11;
            o00 = (unsigned)(t00 * ldb + CA[0] * 2); o01 = (unsigned)(t01 * ldb + CA[1] * 2); o10 = (unsigned)(t10 * ldb + CA[0] * 2); o11 = (unsigned)(t11 * ldb + CA[1] * 2);
        } else {
            const int r0 = u.pm * 256;
            o00 = (unsigned)((r0 + RA[0]) * ldb + CA[0] * 2); o01 = (unsigned)((r0 + RA[1]) * ldb + CA[1] * 2);
            o10 = (unsigned)((r0 + 128 + RA[0]) * ldb + CA[0] * 2); o11 = (unsigned)((r0 + 128 + RA[1]) * ldb + CA[1] * 2);
        }
    }
};

struct MoeTailSched {
    TileOrder o; const char* Bt; size_t estepB, tstepB; const LAS int* tab; const float* tgate; const LAS int* baseL; int Lmain, R, S, Kslice;
    __device__ __forceinline__ bool next(int i, Unit& u) const {
        u.ord = i;
        if (i != 0 || o.c >= R * S) return false;
        if (!o.mapL(Lmain + o.c / S, u.pm, u.pn)) return false;
        int e = 0;
#pragma unroll
        for (int j = 1; j < 8; ++j) e += (u.pm >= __builtin_amdgcn_readfirstlane(tab[8 + j])) ? 1 : 0;
        u.e = e; u.lp = u.pm - __builtin_amdgcn_readfirstlane(tab[8 + e]); u.ks = o.c % S; return true;
    }
    __device__ __forceinline__ bool a_early() const { return true; }
    __device__ __forceinline__ void stage(LAS unsigned* rsb, int tid) const {
        Unit u; if (!next(0, u)) return;
        if (tid < 256) { const int cnt = __builtin_amdgcn_readfirstlane(tab[u.e]), sl = u.lp * 256 + tid; rsb[tid] = (sl < cnt) ? __builtin_bit_cast(unsigned, tgate[slot_src(baseL, u.e, sl)]) : 0u; }
    }
    __device__ __forceinline__ const char* b_base(const Unit& u) const { return Bt + (size_t)u.e * estepB + (size_t)u.pn * tstepB + (size_t)u.ks * Kslice; }
    __device__ __forceinline__ void a_off(const Unit& u, int tid, int ldb, unsigned& o00, unsigned& o01, unsigned& o10, unsigned& o11) const {
        int RA[2], CA[2]; stage_rc(tid * 16, RA[0], CA[0]); stage_rc(tid * 16 + 8192, RA[1], CA[1]);
        const int r0 = u.pm * 256, kb = u.ks * Kslice;
        o00 = (unsigned)((r0 + RA[0]) * ldb + CA[0] * 2 + kb); o01 = (unsigned)((r0 + RA[1]) * ldb + CA[1] * 2 + kb);
        o10 = (unsigned)((r0 + 128 + RA[0]) * ldb + CA[0] * 2 + kb); o11 = (unsigned)((r0 + 128 + RA[1]) * ldb + CA[1] * 2 + kb);
    }
};

__device__ __forceinline__ u32x4 pair16(u32x2 a, u32x2 b) {
    auto rx = __builtin_amdgcn_permlane16_swap(a.x, b.x, false, false); auto ry = __builtin_amdgcn_permlane16_swap(a.y, b.y, false, false);
    return (u32x4){(unsigned)rx[0], (unsigned)ry[0], (unsigned)rx[1], (unsigned)ry[1]};
}
__device__ __forceinline__ void swiglu8f(const f32x4 a0, const f32x4 a1, const f32x4 b0, const f32x4 b1, const float rs, const float osc, f32x4& o0, f32x4& o1) {
    const float nl = -1.4426950408889634f * rs, r2 = rs * rs * osc;
    const f32x4 x0 = a0 * nl, x1 = a1 * nl;
    f32x4 e0, e1;
    e0.x = __builtin_amdgcn_exp2f(x0.x); e0.y = __builtin_amdgcn_exp2f(x0.y); e0.z = __builtin_amdgcn_exp2f(x0.z); e0.w = __builtin_amdgcn_exp2f(x0.w);
    e1.x = __builtin_amdgcn_exp2f(x1.x); e1.y = __builtin_amdgcn_exp2f(x1.y); e1.z = __builtin_amdgcn_exp2f(x1.z); e1.w = __builtin_amdgcn_exp2f(x1.w);
    const f32x4 d0 = e0 + 1.0f, d1 = e1 + 1.0f;
    f32x4 s0, s1;
    s0.x = __builtin_amdgcn_rcpf(d0.x); s0.y = __builtin_amdgcn_rcpf(d0.y); s0.z = __builtin_amdgcn_rcpf(d0.z); s0.w = __builtin_amdgcn_rcpf(d0.w);
    s1.x = __builtin_amdgcn_rcpf(d1.x); s1.y = __builtin_amdgcn_rcpf(d1.y); s1.z = __builtin_amdgcn_rcpf(d1.z); s1.w = __builtin_amdgcn_rcpf(d1.w);
    o0 = ((a0 * b0) * r2) * s0; o1 = ((a1 * b1) * r2) * s1;
}
__device__ __forceinline__ void swiglu8(const f32x4 a0, const f32x4 a1, const f32x4 b0, const f32x4 b1, const float rs, u32x4& w) {
    f32x4 o0, o1; swiglu8f(a0, a1, b0, b1, rs, 1.0f, o0, o1);
    w.x = cvt_pk_bf16(o0.x, o0.y); w.y = cvt_pk_bf16(o0.z, o0.w); w.z = cvt_pk_bf16(o1.x, o1.y); w.w = cvt_pk_bf16(o1.z, o1.w);
}
struct EpiProj {
    static constexpr bool PERM = true, PRELOAD = false;
    bf16_t* O; const LAS float* rsb; bf16_t* GT; float sc;
    __device__ __forceinline__ void operator()(const f32x4 (&acc)[2][2][4][2], const Unit& u, int wr, int wc, int fr, int fq) const {
        const int row0 = u.pm * BM + wr * 64 + fr, col0 = u.pn * BM + wc * 32 + 8 * fq;
        float rsv[2][4];
#pragma unroll
        for (int ai = 0; ai < 2; ++ai)
#pragma unroll
            for (int m = 0; m < 4; ++m) rsv[ai][m] = rsb[u.ord * 256 + wr * 64 + fr + ai * HALF + m * 16] * sc;
#pragma unroll
        for (int ai = 0; ai < 2; ++ai)
#pragma unroll
            for (int m = 0; m < 4; ++m) {
                const int r = row0 + ai * HALF + m * 16; const float rs = rsv[ai][m];
                bf16_t* rowp = O + (size_t)r * DIN + col0;
                if (u.pn >= PC_G / 256) {
#pragma unroll
                    for (int bj = 0; bj < 2; ++bj) { f32x4 v0 = acc[ai][bj][m][0] * rs, v1 = acc[ai][bj][m][1] * rs;
                        { const f32x4 x0 = v0 * -1.4426950408889634f, x1 = v1 * -1.4426950408889634f; f32x4 e0, e1, s0, s1;
                          e0.x = __builtin_amdgcn_exp2f(x0.x); e0.y = __builtin_amdgcn_exp2f(x0.y); e0.z = __builtin_amdgcn_exp2f(x0.z); e0.w = __builtin_amdgcn_exp2f(x0.w);
                          e1.x = __builtin_amdgcn_exp2f(x1.x); e1.y = __builtin_amdgcn_exp2f(x1.y); e1.z = __builtin_amdgcn_exp2f(x1.z); e1.w = __builtin_amdgcn_exp2f(x1.w);
                          const f32x4 d0 = e0 + 1.0f, d1 = e1 + 1.0f;
                          s0.x = __builtin_amdgcn_rcpf(d0.x); s0.y = __builtin_amdgcn_rcpf(d0.y); s0.z = __builtin_amdgcn_rcpf(d0.z); s0.w = __builtin_amdgcn_rcpf(d0.w);
                          s1.x = __builtin_amdgcn_rcpf(d1.x); s1.y = __builtin_amdgcn_rcpf(d1.y); s1.z = __builtin_amdgcn_rcpf(d1.z); s1.w = __builtin_amdgcn_rcpf(d1.w);
                          v0 = v0 * s0; v1 = v1 * s1; }
                        const int c = col0 - PC_G + bj * HALF, hd = c >> 7, vt = (c >> 5) & 3, g = (c >> 3) & 3;
                        u32x2* gp = (u32x2*)GT + ((size_t)((hd * 512 + (r >> 5)) * 16 + vt * 4 + g)) * 64 + (r & 31);
                        u32x2 w0; w0.x = cvt_pk_bf16(v0[0], v0[1]); w0.y = cvt_pk_bf16(v0[2], v0[3]); gp[0] = w0;
                        u32x2 w1; w1.x = cvt_pk_bf16(v1[0], v1[1]); w1.y = cvt_pk_bf16(v1[2], v1[3]); gp[32] = w1; }
                } else {
#pragma unroll
                for (int bj = 0; bj < 2; ++bj) { const f32x4 v0 = acc[ai][bj][m][0] * rs, v1 = acc[ai][bj][m][1] * rs;
                    u32x4 w; w.x = cvt_pk_bf16(v0[0], v0[1]); w.y = cvt_pk_bf16(v0[2], v0[3]); w.z = cvt_pk_bf16(v1[0], v1[1]); w.w = cvt_pk_bf16(v1[2], v1[3]);
                    *(u32x4*)(rowp + bj * HALF) = w; }
                }
            }
    }
};
template <bool F8S>
struct EpiResid {
    static constexpr bool PERM = true, PRELOAD = true;
    bf16_t* hb; float* ssq; unsigned char* hb8;
    __device__ __forceinline__ void preload(f32x4 (&acc)[2][2][4][2], const Unit& u, int wr, int wc, int fr, int fq) const {
        const int row0 = u.pm * BM + wr * 64 + fr, col0 = u.pn * BM + wc * 32 + 8 * fq;
#pragma unroll
        for (int ai = 0; ai < 2; ++ai)
#pragma unroll
            for (int m = 0; m < 4; ++m)
#pragma unroll
                for (int bj = 0; bj < 2; ++bj) { const u32x4 w = *(const u32x4*)(hb + (size_t)(row0 + ai * HALF + m * 16) * D + col0 + bj * HALF);
                    acc[ai][bj][m][0] = (f32x4){bflo(w.x), bfhi(w.x), bflo(w.y), bfhi(w.y)}; acc[ai][bj][m][1] = (f32x4){bflo(w.z), bfhi(w.z), bflo(w.w), bfhi(w.w)};
                    if constexpr (F8S) { acc[ai][bj][m][0] *= 256.0f; acc[ai][bj][m][1] *= 256.0f; } }
    }
    __device__ __forceinline__ void operator()(const f32x4 (&acc)[2][2][4][2], const Unit& u, int wr, int wc, int fr, int fq) const {
        const int row0 = u.pm * BM + wr * 64 + fr, col0 = u.pn * BM + wc * 32 + 8 * fq, ln_ = fq * 16 + fr;
#pragma unroll
        for (int ai = 0; ai < 2; ++ai) {
            u32x2 w8[4][2];
#pragma unroll
            for (int m = 0; m < 4; ++m) {
                const int r = row0 + ai * HALF + m * 16; const size_t ro = (size_t)r * D + col0; float ss = 0.f;
#pragma unroll
                for (int bj = 0; bj < 2; ++bj) { const size_t o = ro + bj * HALF;
                    const f32x4 h0 = F8S ? acc[ai][bj][m][0] * (1.0f / 256.0f) : acc[ai][bj][m][0], h1 = F8S ? acc[ai][bj][m][1] * (1.0f / 256.0f) : acc[ai][bj][m][1];
                    u32x4 w; w.x = cvt_pk_bf16(h0[0], h0[1]); w.y = cvt_pk_bf16(h0[2], h0[3]); w.z = cvt_pk_bf16(h1[0], h1[1]); w.w = cvt_pk_bf16(h1[2], h1[3]); *(u32x4*)(hb + o) = w;
                    if (hb8) { w8[m][bj].x = pk4_f8(h0[0], h0[1], h0[2], h0[3]); w8[m][bj].y = pk4_f8(h1[0], h1[1], h1[2], h1[3]); }
                    ss += ((h0[0] * h0[0] + h0[1] * h0[1]) + (h0[2] * h0[2] + h0[3] * h0[3])) + ((h1[0] * h1[0] + h1[1] * h1[1]) + (h1[2] * h1[2] + h1[3] * h1[3])); }
                ss += shx(ss, 16, ln_); ss += shx(ss, 32, ln_);
                if (fq == 0) ssq[(size_t)r * 16 + u.pn * 4 + wc] = ss;
            }
            if (hb8) {
#pragma unroll
                for (int p = 0; p < 2; ++p)
#pragma unroll
                    for (int bj = 0; bj < 2; ++bj) { const int r = row0 + ai * HALF + (2 * p + (fq & 1)) * 16;
                        *(u32x4*)(hb8 + (size_t)r * D + col0 - 8 * (fq & 1) + bj * HALF) = pair16(w8[2 * p][bj], w8[2 * p + 1][bj]); }
            }
        }
    }
};
template <bool F8O>
struct EpiSwiglu {
    static constexpr bool PERM = true, PRELOAD = false;
    unsigned char* O; const LAS float* rsb;
    __device__ __forceinline__ void operator()(const f32x4 (&acc)[2][2][4][2], const Unit& u, int wr, int wc, int fr, int fq) const {
        const int row0 = u.pm * BM + wr * 64 + fr, col0 = u.pn * HALF + wc * 32 + 8 * fq;
        float rsv[2][4];
#pragma unroll
        for (int ai = 0; ai < 2; ++ai)
#pragma unroll
            for (int m = 0; m < 4; ++m) rsv[ai][m] = rsb[u.ord * 256 + wr * 64 + fr + ai * HALF + m * 16] * (F8O ? 0.03125f : 1.0f);
#pragma unroll
        for (int ai = 0; ai < 2; ++ai) {
            if constexpr (F8O) {
                u32x2 w8[4];
#pragma unroll
                for (int m = 0; m < 4; ++m) {
                    f32x4 o0, o1; swiglu8f(acc[ai][0][m][0], acc[ai][0][m][1], acc[ai][1][m][0], acc[ai][1][m][1], rsv[ai][m], 4.0f, o0, o1);
                    w8[m].x = pk4_f8(o0.x, o0.y, o0.z, o0.w); w8[m].y = pk4_f8(o1.x, o1.y, o1.z, o1.w); }
#pragma unroll
                for (int p = 0; p < 2; ++p) { const int r = row0 + ai * HALF + (2 * p + (fq & 1)) * 16;
                    *(u32x4*)(O + (size_t)r * DFF + col0 - 8 * (fq & 1)) = pair16(w8[2 * p], w8[2 * p + 1]); }
            } else {
#pragma unroll
                for (int m = 0; m < 4; ++m) { const int r = row0 + ai * HALF + m * 16;
                    u32x4 w; swiglu8(acc[ai][0][m][0], acc[ai][0][m][1], acc[ai][1][m][0], acc[ai][1][m][1], rsv[ai][m], w);
                    *(u32x4*)((bf16_t*)O + (size_t)r * DFF + col0) = w; }
            }
        }
    }
};
struct EpiSwigluMoe {
    static constexpr bool PERM = true, PRELOAD = false;
    unsigned char* O; const float* rstd_tok; const LAS int* tkb;
    __device__ __forceinline__ void operator()(const f32x4 (&acc)[2][2][4][2], const Unit& u, int wr, int wc, int fr, int fq) const {
        const int trow0 = wr * 64 + fr, col0 = u.pn * HALF + wc * 32 + 8 * fq;
        float rsv[2][4];
#pragma unroll
        for (int ai = 0; ai < 2; ++ai)
#pragma unroll
            for (int m = 0; m < 4; ++m) rsv[ai][m] = bfhi((unsigned)tkb[u.ord * 256 + trow0 + ai * HALF + m * 16]) * 0.03125f;
#pragma unroll
        for (int ai = 0; ai < 2; ++ai) {
            u32x2 w[4];
#pragma unroll
            for (int m = 0; m < 4; ++m) {
                f32x4 o0, o1; swiglu8f(acc[ai][0][m][0], acc[ai][0][m][1], acc[ai][1][m][0], acc[ai][1][m][1], rsv[ai][m], 4.0f, o0, o1);
                w[m].x = pk4_f8(o0.x, o0.y, o0.z, o0.w); w[m].y = pk4_f8(o1.x, o1.y, o1.z, o1.w); }
#pragma unroll
            for (int p = 0; p < 2; ++p) { const int tr = trow0 + ai * HALF + (2 * p + (fq & 1)) * 16;
                *(u32x4*)(O + (size_t)(u.pm * BM + tr) * DFF + col0 - 8 * (fq & 1)) = pair16(w[2 * p], w[2 * p + 1]); }
        }
    }
};
struct EpiMoeOut {
    static constexpr bool PERM = true, PRELOAD = false;
    unsigned char* O; const LAS float* gb;
    __device__ __forceinline__ void operator()(const f32x4 (&acc)[2][2][4][2], const Unit& u, int wr, int wc, int fr, int fq) const {
        const int trow0 = wr * 64 + fr, col0 = u.pn * BM + wc * 32 + 8 * fq;
        float gv[2][4];
#pragma unroll
        for (int ai = 0; ai < 2; ++ai)
#pragma unroll
            for (int m = 0; m < 4; ++m) gv[ai][m] = gb[u.ord * 256 + trow0 + ai * HALF + m * 16] * (16.0f / 256.0f);
#pragma unroll
        for (int ai = 0; ai < 2; ++ai) {
            u32x2 w8[4][2];
#pragma unroll
            for (int m = 0; m < 4; ++m) { const float g = gv[ai][m];
#pragma unroll
                for (int bj = 0; bj < 2; ++bj) { const f32x4 v0 = acc[ai][bj][m][0] * g, v1 = acc[ai][bj][m][1] * g;
                    w8[m][bj].x = pk4_f8(v0[0], v0[1], v0[2], v0[3]); w8[m][bj].y = pk4_f8(v1[0], v1[1], v1[2], v1[3]); } }
#pragma unroll
            for (int p = 0; p < 2; ++p)
#pragma unroll
                for (int bj = 0; bj < 2; ++bj) { const int tr = trow0 + ai * HALF + (2 * p + (fq & 1)) * 16;
                    *(u32x4*)(O + (size_t)(u.pm * BM + tr) * D + col0 - 8 * (fq & 1) + bj * HALF) = pair16(w8[2 * p][bj], w8[2 * p + 1][bj]); }
        }
    }
};
struct EpiMoeTail {
    static constexpr bool PERM = true, PRELOAD = false;
    bf16_t* O; const LAS float* gb;
    __device__ __forceinline__ void operator()(const f32x4 (&acc)[2][2][4][2], const Unit& u, int wr, int wc, int fr, int fq) const {
        const int trow0 = wr * 64 + fr, col0 = wc * 32 + 8 * fq;
#pragma unroll
        for (int ai = 0; ai < 2; ++ai)
#pragma unroll
            for (int m = 0; m < 4; ++m) {
                const int tr = trow0 + ai * HALF + m * 16; const float g = gb[tr] * (1.0f / 256.0f);
                bf16_t* rowp = O + (size_t)tr * 256 + col0;
#pragma unroll
                for (int bj = 0; bj < 2; ++bj) { const f32x4 v0 = acc[ai][bj][m][0] * g, v1 = acc[ai][bj][m][1] * g;
                    u32x4 w; w.x = cvt_pk_bf16(v0[0], v0[1]); w.y = cvt_pk_bf16(v0[2], v0[3]); w.z = cvt_pk_bf16(v1[0], v1[1]); w.w = cvt_pk_bf16(v1[2], v1[3]);
                    *(u32x4*)(rowp + bj * HALF) = w; }
            }
    }
};
}

#define XB_TMO      128
#define XB_XCNT(j)  (256  + 64 * (j))
#define XB_XSUB(j)  (1280 + 64 * (j))
#define XB_XGEN(j)  (2304 + 64 * (j))
#define XB_TOP      3328
#define XB_TOPGEN   3392
#define XCD_BAR_WORDS 3456
#define XB_SPIN_CAP (1u << 18)
__device__ __forceinline__ unsigned xb_ld(unsigned* p)              { return __hip_atomic_load(p, __ATOMIC_RELAXED, __HIP_MEMORY_SCOPE_AGENT); }
__device__ __forceinline__ unsigned xb_add(unsigned* p, unsigned v) { return __hip_atomic_fetch_add(p, v, __ATOMIC_RELAXED, __HIP_MEMORY_SCOPE_AGENT); }
__device__ __forceinline__ unsigned xb_xcc_id() { return (unsigned)__builtin_amdgcn_s_getreg((3 << 11) | 20) & 0xFu; }
#define XB_SPIN(cond, bar) do { unsigned _sp = 0; while (cond) { __builtin_amdgcn_s_sleep(1); \
    if ((++_sp & 255u) == 0u) { if (xb_ld(&(bar)[XB_TMO])) break; if (_sp > XB_SPIN_CAP) { atomicAdd(&(bar)[XB_TMO], 1u); break; } } } } while (0)
struct XcdBarrier { unsigned* bar; unsigned x; volatile LAS unsigned* st; };
__device__ __forceinline__ XcdBarrier xcd_barrier_post(unsigned* bar, volatile LAS unsigned* st) {
    XcdBarrier b; b.bar = bar; b.x = xb_xcc_id(); b.st = st;
    if (threadIdx.x == 0) (void)xb_add(&bar[XB_XCNT(b.x)], 1u);
    return b;
}
__device__ __forceinline__ void xcd_barrier_complete(unsigned* bar, unsigned x, unsigned& nloc, unsigned& nx) {
    const unsigned G = gridDim.x * gridDim.y * gridDim.z;
    unsigned sum, cnt, mine, sp = 0u;
    for (;;) {
        sum = 0u; cnt = 0u; mine = 0u;
#pragma unroll
        for (unsigned j = 0; j < 16; ++j) { const unsigned c = xb_ld(&bar[XB_XCNT(j)]); sum += c; cnt += (c > 0u) ? 1u : 0u; }
        mine = xb_ld(&bar[XB_XCNT(x)]);
        if (sum == G) break;
        __builtin_amdgcn_s_sleep(1);
        if ((++sp & 255u) == 0u) { if (xb_ld(&bar[XB_TMO])) break; if (sp > XB_SPIN_CAP) { atomicAdd(&bar[XB_TMO], 1u); break; } }
    }
    nloc = mine > 0u ? mine : 1u; nx = cnt > 0u ? cnt : 1u;
}
__device__ __forceinline__ void xcd_barrier(const XcdBarrier& b) {
    asm volatile("s_waitcnt vmcnt(0)" ::: "memory");
    __syncthreads();
    if (threadIdx.x == 0) {
        unsigned* bar = b.bar;
        __builtin_amdgcn_s_waitcnt(0);
        unsigned nloc = b.st[0], nx = b.st[1];
        if (nloc == 0u) { xcd_barrier_complete(bar, b.x, nloc, nx); b.st[0] = nloc; b.st[1] = nx; }
        const unsigned old = xb_add(&bar[XB_XSUB(b.x)], 1u);
        const unsigned gen = old / nloc;
        if (old + 1u == (gen + 1u) * nloc) {
            __builtin_amdgcn_fence(__ATOMIC_RELEASE, "agent");
            asm volatile("s_waitcnt vmcnt(0)" ::: "memory");
            const unsigned og = xb_add(&bar[XB_TOP], 1u);
            const unsigned tgt = (og / nx + 1u) * nx;
            if (og + 1u != tgt) XB_SPIN(xb_ld(&bar[XB_TOP]) < tgt, bar);
            __builtin_amdgcn_fence(__ATOMIC_ACQUIRE, "agent");
            xb_add(&bar[XB_XGEN(b.x)], 1u);
            asm volatile("s_waitcnt vmcnt(0)" ::: "memory");
        } else {
            XB_SPIN(xb_ld(&bar[XB_XGEN(b.x)]) == gen, bar);
            __builtin_amdgcn_fence(__ATOMIC_ACQUIRE, "agent");
            asm volatile("s_waitcnt vmcnt(0)" ::: "memory");
        }
    }
    __syncthreads();
}

struct Args { const float* in[27]; float* out; unsigned char* ws; int ph_lo, ph_hi; };
static_assert(sizeof(Args) == 27 * 8 + 8 + 8 + 8, "Args has no padding");
enum { I_X = 0, I_ATTN_NORM, I_FFN_NORM, I_FINAL_NORM, I_W_IN, I_W_OUT, I_S5_LRE, I_S5_LIM, I_S5_LOGDT, I_S5_BRE, I_S5_BIM, I_S5_CRE, I_S5_CIM, I_S5_D, I_S5_GLU, I_S5_ONORM,
       I_CONV_W, I_CONV_ONORM, I_HG_LB, I_HG_ONORM, I_FFN_W1, I_FFN_W3, I_FFN_W2, I_MOE_ROUTER, I_MOE_W1, I_MOE_W3, I_MOE_W2 };

struct Ctx {
    LAS unsigned char* lds; int tid, lane, wave, G, bid;
    const float* const* in; float* out; unsigned char* ws;
};

struct P0Item { const float* W; bf16_t* WT; const float* gain; int K, N, map, item; float f8s; };
__device__ __forceinline__ void p0_resolve(const float* const* in, unsigned char* ws, int it, P0Item& d) {
    constexpr int IT_IN = 16 * 96, IT_OUT = 16 * 32, IT_GLU = 4 * 8, IT_FF = 16 * 112;
    constexpr int S0 = 4 * IT_IN, S1 = S0 + 4 * IT_OUT, S2 = S1 + 4 * IT_GLU, S3 = S2 + 2 * IT_FF, S4 = S3 + 2 * IT_FF, S5 = S4 + 2 * IT_FF, S6 = S5 + 16 * IT_FF, S7 = S6 + 16 * IT_FF;
    d.gain = nullptr; d.map = 0; d.f8s = 0.f;
    if (it < S0) { const int l = it / IT_IN; d.item = it % IT_IN; d.W = in[I_W_IN] + (size_t)l * D * DIN; d.K = D; d.N = DIN; d.WT = (bf16_t*)(ws + WS_WIN) + (size_t)l * DIN * D; d.gain = in[I_ATTN_NORM] + l * D; d.f8s = ((F8_IN >> l) & 1) ? 32.f : 0.f; }
    else if (it < S1) { const int q = it - S0, l = q / IT_OUT; d.item = q % IT_OUT; d.W = in[I_W_OUT] + (size_t)l * D * D; d.K = D; d.N = D; d.WT = (bf16_t*)(ws + WS_WOUT) + (size_t)l * D * D; }
    else if (it < S2) { const int q = it - S1, l = q / IT_GLU; d.item = q % IT_GLU; d.W = in[I_S5_GLU] + (size_t)l * 256 * 256; d.K = 256; d.N = 256; d.WT = (bf16_t*)(ws + WS_GLU) + (size_t)l * 256 * 256; }
    else if (it < S3) { const int q = it - S2, j = q / IT_FF; d.item = q % IT_FF; d.W = in[I_FFN_W1] + (size_t)j * D * DFF; d.K = D; d.N = DFF; d.WT = (bf16_t*)(ws + WS_W13 + (size_t)j * 2 * DFF * D * 2); d.map = 1; d.gain = in[I_FFN_NORM] + (2 * j) * D; d.f8s = ((F8_FFN >> (2 * j)) & 1) ? 32.f : 0.f; }
    else if (it < S4) { const int q = it - S3, j = q / IT_FF; d.item = q % IT_FF; d.W = in[I_FFN_W3] + (size_t)j * D * DFF; d.K = D; d.N = DFF; d.WT = (bf16_t*)(ws + WS_W13 + (size_t)j * 2 * DFF * D * 2); d.map = 2; d.gain = in[I_FFN_NORM] + (2 * j) * D; d.f8s = ((F8_FFN >> (2 * j)) & 1) ? 32.f : 0.f; }
    else if (it < S5) { const int q = it - S4, j = q / IT_FF; d.item = q % IT_FF; d.W = in[I_FFN_W2] + (size_t)j * DFF * D; d.K = DFF; d.N = D; d.WT = (bf16_t*)(ws + WS_W2 + (size_t)j * D * DFF * 2); d.f8s = ((F8_FFN >> (2 * j)) & 1) ? 64.f : 0.f; }
    else if (it < S6) { const int q = it - S5, je = q / IT_FF, j = je >> 3; d.item = q % IT_FF; d.W = in[I_MOE_W1] + (size_t)je * D * DFF; d.K = D; d.N = DFF; d.WT = (bf16_t*)(ws + WS_MW13 + (size_t)je * 2 * DFF * D); d.map = 1; d.gain = in[I_FFN_NORM] + (2 * j + 1) * D; d.f8s = 32.f; }
    else if (it < S7) { const int q = it - S6, je = q / IT_FF, j = je >> 3; d.item = q % IT_FF; d.W = in[I_MOE_W3] + (size_t)je * D * DFF; d.K = D; d.N = DFF; d.WT = (bf16_t*)(ws + WS_MW13 + (size_t)je * 2 * DFF * D); d.map = 2; d.gain = in[I_FFN_NORM] + (2 * j + 1) * D; d.f8s = 32.f; }
    else { const int q = it - S7, je = q / IT_FF; d.item = q % IT_FF; d.W = in[I_MOE_W2] + (size_t)je * DFF * D; d.K = DFF; d.N = D; d.WT = (bf16_t*)(ws + WS_MW2 + (size_t)je * D * DFF); d.f8s = 64.f; }
}
__device__ __forceinline__ void p0_load(const P0Item& d, float (&v)[32], int lane) {
    const int nblk = d.N / 32, kb = d.item / nblk, nb = d.item % nblk, k0 = 64 * kb, n0 = 32 * nb;
    const float* p = d.W + (size_t)(k0 + (lane >> 5)) * d.N + n0 + (lane & 31);
#pragma unroll
    for (int i = 0; i < 32; ++i) v[i] = p[(size_t)(2 * i) * d.N];
}
__device__ __forceinline__ void p0_store(const P0Item& d, const float (&v)[32], LAS float* scr, int lane) {
    const int nblk = d.N / 32, kb = d.item / nblk, nb = d.item % nblk, k0 = 64 * kb, n0 = 32 * nb;
    const float sc = (d.f8s != 0.f) ? d.f8s : 1.0f;
    if (d.gain) {
#pragma unroll
        for (int i = 0; i < 32; ++i) scr[(2 * i + (lane >> 5)) * 33 + (lane & 31)] = v[i] * (d.gain[k0 + 2 * i + (lane >> 5)] * sc);
    } else {
#pragma unroll
        for (int i = 0; i < 32; ++i) scr[(2 * i + (lane >> 5)) * 33 + (lane & 31)] = v[i] * sc;
    }
    asm volatile("s_waitcnt lgkmcnt(0)" ::: "memory");
    if (d.f8s != 0.f) {
        const int c = lane & 3;
#pragma unroll
        for (int j = 0; j < 2; ++j) { const int n = n0 + (lane >> 2) + 16 * j; const LAS float* s = scr + (16 * c) * 33 + (lane >> 2) + 16 * j;
            const int drow = (d.map == 0) ? n : ((n >> 7) * 256 + (n & 127) + (d.map == 2 ? 128 : 0));
            u32x4 o; o.x = pk4_f8(s[0 * 33], s[1 * 33], s[2 * 33], s[3 * 33]); o.y = pk4_f8(s[4 * 33], s[5 * 33], s[6 * 33], s[7 * 33]);
            o.z = pk4_f8(s[8 * 33], s[9 * 33], s[10 * 33], s[11 * 33]); o.w = pk4_f8(s[12 * 33], s[13 * 33], s[14 * 33], s[15 * 33]);
            *(u32x4*)((unsigned char*)d.WT + (size_t)drow * d.K + k0 + 16 * c) = o; }
        asm volatile("s_waitcnt lgkmcnt(0)" ::: "memory");
        return;
    }
    const int c = lane & 7;
#pragma unroll
    for (int j = 0; j < 4; ++j) { const int n = n0 + (lane >> 3) + 8 * j; const LAS float* s = scr + (8 * c) * 33 + (lane >> 3) + 8 * j;
        const int drow = (d.map == 0) ? n : ((n >> 7) * 256 + (n & 127) + (d.map == 2 ? 128 : 0));
        u32x4 o; o.x = pg8::cvt_pk_bf16(s[0 * 33], s[1 * 33]); o.y = pg8::cvt_pk_bf16(s[2 * 33], s[3 * 33]); o.z = pg8::cvt_pk_bf16(s[4 * 33], s[5 * 33]); o.w = pg8::cvt_pk_bf16(s[6 * 33], s[7 * 33]);
        *(u32x4*)(d.WT + (size_t)drow * d.K + k0 + 8 * c) = o; }
    asm volatile("s_waitcnt lgkmcnt(0)" ::: "memory");
}
__device__ __forceinline__ void p0_prologue(Ctx& F) {
    LAS float* scr = (LAS float*)(F.lds + F.wave * 16384);
    const int gw = F.bid * 8 + F.wave, NGW = F.G * 8;
    const float* const* in = F.in; unsigned char* ws = F.ws;
    constexpr int IT_IN = 16 * 96, IT_OUT = 16 * 32, IT_GLU = 4 * 8, IT_FF = 16 * 112;
    constexpr int S8 = 4 * IT_IN + 4 * IT_OUT + 4 * IT_GLU + 6 * IT_FF + 48 * IT_FF;
    {
        P0Item d0, d1; float v0[32], v1[32];
        int it = gw;
        if (it < S8) { p0_resolve(in, ws, it, d0); p0_load(d0, v0, F.lane); }
        for (; it < S8; it += 2 * NGW) {
            const int it1 = it + NGW, it2 = it + 2 * NGW;
            if (it1 < S8) { p0_resolve(in, ws, it1, d1); p0_load(d1, v1, F.lane); }
            p0_store(d0, v0, scr, F.lane);
            if (it1 < S8) {
                if (it2 < S8) { p0_resolve(in, ws, it2, d0); p0_load(d0, v0, F.lane); }
                p0_store(d1, v1, scr, F.lane);
            }
        }
    }
    bf16_t* hb = (bf16_t*)(ws + WS_HB); float* ssq = (float*)(ws + WS_SSQ);
    for (int mb = gw * 4; mb < T; mb += NGW * 4) {
        f32x4 v[4][4]; float sq[4];
#pragma unroll
        for (int k = 0; k < 4; ++k)
#pragma unroll
            for (int j = 0; j < 4; ++j) v[k][j] = *((const f32x4*)(in[I_X] + (size_t)(mb + k) * D) + F.lane + 64 * j);
#pragma unroll
        for (int k = 0; k < 4; ++k) { sq[k] = 0.f; u32x2* o8 = (u32x2*)(hb + (size_t)(mb + k) * D) + F.lane;
#pragma unroll
            for (int j = 0; j < 4; ++j) { const f32x4 x = v[k][j]; sq[k] += (x.x * x.x + x.y * x.y) + (x.z * x.z + x.w * x.w); u32x2 w; w.x = pk2(x.x, x.y); w.y = pk2(x.z, x.w); o8[64 * j] = w;
                if (F8_IN & 1) *((unsigned*)(ws + WS_HB8 + (size_t)(mb + k) * D) + F.lane + 64 * j) = pk4_f8(x.x, x.y, x.z, x.w); } }
#pragma unroll
        for (int o = 1; o < 64; o <<= 1) {
#pragma unroll
            for (int k = 0; k < 4; ++k) sq[k] += shx(sq[k], o, F.lane); }
#pragma unroll
        for (int k = 0; k < 4; ++k) if (F.lane < 16) ssq[(size_t)(mb + k) * 16 + F.lane] = (F.lane == 0) ? sq[k] : 0.f;
    }
    float* tab = (float*)(ws + WS_TAB);
    const int gt = F.bid * 512 + F.tid, NGT = F.G * 512;
    for (int i = gt; i < 512; i += NGT) {
        const float* lb = in[I_HG_LB]; const float a0 = lb[i], a1 = lb[512 + i], a2 = lb[1024 + i], a3 = lb[1536 + i];
        const float mx = fmaxf(fmaxf(a0, a1), fmaxf(a2, a3)); const float e0 = expf(a0 - mx), e1 = expf(a1 - mx), e2 = expf(a2 - mx), e3 = expf(a3 - mx);
        const float inv = 1.f / (((e0 + e1) + e2) + e3); const float s1 = e1 * inv, s2 = e2 * inv, s3 = e3 * inv;
        const float hi = 1.0f - 1e-6f;
        tab[TB_LBC + i] = 0.f; tab[TB_LBC + 512 + i] = fminf(fmaxf(s1, 0.f), hi); tab[TB_LBC + 1024 + i] = fminf(fmaxf(s1 + s2, 0.f), hi); tab[TB_LBC + 1536 + i] = fminf(fmaxf((s1 + s2) + s3, 0.f), hi);
    }
    for (int i = gt; i < 4 * 16 * 64; i += NGT) {
        const int lg = i >> 6;
        const float lre = in[I_S5_LRE][i], lim = in[I_S5_LIM][i], dt = expf(in[I_S5_LOGDT][lg]);
        const float er = expf(lre * dt), lbr = er * cosf(lim * dt), lbi = er * sinf(lim * dt);
        tab[TB_LAMB + 2 * i] = lbr; tab[TB_LAMB + 2 * i + 1] = lbi;
        const float den = 1.f / (lre * lre + lim * lim), nr = lbr - 1.f, ni = lbi;
        const float cr = (nr * lre + ni * lim) * den, ci = (ni * lre - nr * lim) * den;
        bf16_t* bbi = (bf16_t*)(ws + WS_BB); bf16_t* cmi = (bf16_t*)(ws + WS_CM); const int p = i & 63;
        for (int c = 0; c < 16; ++c) { const float br = in[I_S5_BRE][(size_t)i * 16 + c], bi = in[I_S5_BIM][(size_t)i * 16 + c];
            const float vr = cr * br - ci * bi, vi = cr * bi + ci * br;
            tab[TB_BBAR + ((size_t)i * 16 + c) * 2] = vr; tab[TB_BBAR + ((size_t)i * 16 + c) * 2 + 1] = vi;
            bbi[((size_t)lg * 128 + 2 * p) * 16 + c] = (bf16_t)f2bf(vr); bbi[((size_t)lg * 128 + 2 * p + 1) * 16 + c] = (bf16_t)f2bf(vi);
            cmi[((size_t)lg * 16 + c) * 128 + 2 * p] = (bf16_t)f2bf(in[I_S5_CRE][((size_t)lg * 16 + c) * 64 + p]);
            cmi[((size_t)lg * 16 + c) * 128 + 2 * p + 1] = (bf16_t)f2bf(-in[I_S5_CIM][((size_t)lg * 16 + c) * 64 + p]); }
    }
    for (int i = gt; i < 4 * 16 * 64 * 64; i += NGT) {
        const int sidx = i & 63, lgp = i >> 6, lg = lgp >> 6, p = lgp & 63;
        const float lre = in[I_S5_LRE][lgp], lim = in[I_S5_LIM][lgp], dt = expf(in[I_S5_LOGDT][lg]);
        const float er = expf(lre * dt), lbr = er * cosf(lim * dt), lbi = er * sinf(lim * dt);
        const float den = 1.f / (lre * lre + lim * lim), nr = lbr - 1.f, ni = lbi;
        const float cr = (nr * lre + ni * lim) * den, ci = (ni * lre - nr * lim) * den;
        const float tau = (float)(63 - sidx), pe = expf(tau * lre * dt), pr = pe * cosf(tau * lim * dt), pi = pe * sinf(tau * lim * dt);
        const float wr = pr * cr - pi * ci, wi = pr * ci + pi * cr;
        unsigned ore[8], oim[8];
#pragma unroll
        for (int c2 = 0; c2 < 8; ++c2) { const float b0r = in[I_S5_BRE][(size_t)lgp * 16 + 2 * c2], b0i = in[I_S5_BIM][(size_t)lgp * 16 + 2 * c2], b1r = in[I_S5_BRE][(size_t)lgp * 16 + 2 * c2 + 1], b1i = in[I_S5_BIM][(size_t)lgp * 16 + 2 * c2 + 1];
            ore[c2] = pk2(wr * b0r - wi * b0i, wr * b1r - wi * b1i); oim[c2] = pk2(wr * b0i + wi * b0r, wr * b1i + wi * b1r); }
        bf16_t* vt = (bf16_t*)(ws + WS_VT) + ((size_t)lg * 128 + 2 * p) * 1024 + sidx * 16;
        *(u32x4*)vt = (u32x4){ore[0], ore[1], ore[2], ore[3]}; *(u32x4*)(vt + 8) = (u32x4){ore[4], ore[5], ore[6], ore[7]};
        *(u32x4*)(vt + 1024) = (u32x4){oim[0], oim[1], oim[2], oim[3]}; *(u32x4*)(vt + 1024 + 8) = (u32x4){oim[4], oim[5], oim[6], oim[7]};
    }
    for (int i = gt; i < 2 * 8 * 1024; i += NGT) {
        const int j = i >> 13, e = (i >> 10) & 7, k = i & 1023;
        tab[TB_RG + i] = in[I_MOE_ROUTER][((size_t)j * D + k) * NE + e] * in[I_FFN_NORM][(2 * j + 1) * D + k];
    }
}

__device__ __forceinline__ void conv_phase(Ctx& F, int l) {
    const bf16_t* proj = (const bf16_t*)(F.ws + WS_PROJ); bf16_t* mix = (bf16_t*)(F.ws + WS_MIX);
    const float* cw = F.in[I_CONV_W] + l * 3 * CW; const float* gn = F.in[I_CONV_ONORM] + l * CW;
    const int c = 4 * F.lane;
    const f32x4 w0 = *(const f32x4*)(cw + c), w1 = *(const f32x4*)(cw + CW + c), w2 = *(const f32x4*)(cw + 2 * CW + c), g = *(const f32x4*)(gn + c);
    const int gw = F.bid * 8 + F.wave, NGW = F.G * 8;
    for (int tb = gw * 8; tb < T; tb += NGW * 8) {
        u32x2 ra[10], rb[10], rg[8];
#pragma unroll
        for (int j = 0; j < 10; ++j) { const int tt = tb - 2 + j; ra[j] = (u32x2){0u, 0u}; rb[j] = (u32x2){0u, 0u};
            if (tt >= 0) { const bf16_t* row = proj + (size_t)tt * DIN; ra[j] = *(const u32x2*)(row + PC_CC + c); rb[j] = *(const u32x2*)(row + PC_CV + c); } }
#pragma unroll
        for (int j = 0; j < 8; ++j) rg[j] = *(const u32x2*)(proj + (size_t)(tb + j) * DIN + PC_CB + c);
        f32x4 z[10];
#pragma unroll
        for (int j = 0; j < 10; ++j) z[j] = (f32x4){bflo(ra[j].x) * bflo(rb[j].x), bfhi(ra[j].x) * bfhi(rb[j].x), bflo(ra[j].y) * bflo(rb[j].y), bfhi(ra[j].y) * bfhi(rb[j].y)};
        f32x4 y[8]; float ss[8];
#pragma unroll
        for (int j = 0; j < 8; ++j) { y[j] = (z[j] * w0 + z[j + 1] * w1 + z[j + 2] * w2) * (f32x4){bflo(rg[j].x), bfhi(rg[j].x), bflo(rg[j].y), bfhi(rg[j].y)};
            ss[j] = (y[j].x * y[j].x + y[j].y * y[j].y) + (y[j].z * y[j].z + y[j].w * y[j].w); }
#pragma unroll
        for (int o = 1; o < 64; o <<= 1) {
#pragma unroll
            for (int j = 0; j < 8; ++j) ss[j] += shx(ss[j], o, F.lane); }
#pragma unroll
        for (int j = 0; j < 8; ++j) { const float rs = __builtin_amdgcn_rsqf(ss[j] * (1.f / CW) + NORM_EPS); const f32x4 v = y[j] * rs * g;
            u32x2 o; o.x = pk2(v.x, v.y); o.y = pk2(v.z, v.w); *(u32x2*)(mix + (size_t)(tb + j) * D + 256 + c) = o; }
    }
}

#if 1
__device__ __forceinline__ void ref_hg_prep(Ctx& F, int l) {
    const bf16_t* proj = (const bf16_t*)(F.ws + WS_PROJ); const float* lbc = (const float*)(F.ws + WS_TAB) + TB_LBC + l * 512;
    float* fv = (float*)(F.ws + SC_F); float* kv = (float*)(F.ws + SC_K); float* qv = (float*)(F.ws + SC_Q);
    const size_t gt = (size_t)F.bid * 512 + F.tid, NGT = (size_t)F.G * 512;
    for (size_t i = gt; i < (size_t)T * 512; i += NGT) {
        const int t = (int)(i >> 9), c = (int)(i & 511);
        const float fp = bf2f(proj[(size_t)t * DIN + PC_F + c]), q = bf2f(proj[(size_t)t * DIN + PC_Q + c]), lb = lbc[c];
        const float sg = 1.f / (1.f + expf(-fp));
        fv[i] = lb + (1.f - lb) * sg; kv[i] = (1.f - lb) * (1.f - sg); qv[i] = q / (1.f + expf(-q));
    }
}
__device__ __forceinline__ void ref_hg_scan(Ctx& F, int unit) {
    const bf16_t* proj = (const bf16_t*)(F.ws + WS_PROJ);
    const float* fv = (const float*)(F.ws + SC_F); const float* kv = (const float*)(F.ws + SC_K); const float* qv = (const float*)(F.ws + SC_Q); float* ov = (float*)(F.ws + SC_O);
    const int head = unit >> 1, v = (unit & 1) * 64 + F.lane;
    float S[128];
#pragma unroll
    for (int k = 0; k < 128; ++k) S[k] = 0.f;
    for (int t = 0; t < T; ++t) {
        const float iv = bf2f(proj[(size_t)t * DIN + PC_I + head * 128 + v]);
        const float* f = fv + (size_t)t * 512 + head * 128; const float* kk = kv + (size_t)t * 512 + head * 128; const float* q = qv + (size_t)t * 512 + head * 128;
        float acc = 0.f;
#pragma unroll
        for (int k = 0; k < 128; ++k) { S[k] = f[k] * S[k] + kk[k] * iv; acc += S[k] * q[k]; }
        ov[(size_t)t * 512 + head * 128 + v] = acc;
    }
}
__device__ __forceinline__ void ref_s5_scan(Ctx& F, int l, int g) {
    const bf16_t* proj = (const bf16_t*)(F.ws + WS_PROJ); const float* tab = (const float*)(F.ws + WS_TAB);
    float* y1 = (float*)(F.ws + SC_Y1);
    const int p = F.lane, lgp = (l * 16 + g) * 64 + p;
    const float lbr = tab[TB_LAMB + 2 * lgp], lbi = tab[TB_LAMB + 2 * lgp + 1];
    float Br[16], Bi[16], Cr[16], Ci[16];
#pragma unroll
    for (int c = 0; c < 16; ++c) { Br[c] = tab[TB_BBAR + ((size_t)lgp * 16 + c) * 2]; Bi[c] = tab[TB_BBAR + ((size_t)lgp * 16 + c) * 2 + 1];
        Cr[c] = F.in[I_S5_CRE][((size_t)(l * 16 + g) * 16 + c) * 64 + p]; Ci[c] = F.in[I_S5_CIM][((size_t)(l * 16 + g) * 16 + c) * 64 + p]; }
    const float dl = (F.lane < 16) ? F.in[I_S5_D][l * S5W + g * 16 + F.lane] : 0.f;
    float xr = 0.f, xi = 0.f;
    for (int t = 0; t < T; ++t) {
        const u32x4* up = (const u32x4*)(proj + (size_t)t * DIN + PC_U + g * 16); const u32x4 ua = up[0], ub = up[1];
        float u[16];
        u[0] = bflo(ua.x); u[1] = bfhi(ua.x); u[2] = bflo(ua.y); u[3] = bfhi(ua.y); u[4] = bflo(ua.z); u[5] = bfhi(ua.z); u[6] = bflo(ua.w); u[7] = bfhi(ua.w);
        u[8] = bflo(ub.x); u[9] = bfhi(ub.x); u[10] = bflo(ub.y); u[11] = bfhi(ub.y); u[12] = bflo(ub.z); u[13] = bfhi(ub.z); u[14] = bflo(ub.w); u[15] = bfhi(ub.w);
        float bur = 0.f, bui = 0.f;
#pragma unroll
        for (int c = 0; c < 16; ++c) { bur += Br[c] * u[c]; bui += Bi[c] * u[c]; }
        const float nxr = lbr * xr - lbi * xi + bur, nxi = lbr * xi + lbi * xr + bui; xr = nxr; xi = nxi;
        float my = 0.f, myu = 0.f;
#pragma unroll
        for (int c = 0; c < 16; ++c) { const float s = wave_sum(Cr[c] * xr - Ci[c] * xi, F.lane); if (F.lane == c) { my = s; myu = u[c]; } }
        if (F.lane < 16) y1[(size_t)t * S5W + g * 16 + F.lane] = gelu_tanh(my + dl * myu);
    }
}
__device__ __forceinline__ void ref_finalize_s5(Ctx& F, int l) {
    bf16_t* mix = (bf16_t*)(F.ws + WS_MIX);
    const float* y1 = (const float*)(F.ws + SC_Y1);
    const float* wg = F.in[I_S5_GLU] + (size_t)l * 256 * 256; const float* gs = F.in[I_S5_ONORM] + l * 256;
    const int gw = F.bid * 8 + F.wave, NGW = F.G * 8;
    for (int t = gw; t < T; t += NGW) {
        const float* yr = y1 + (size_t)t * 256; f32x4 z = (f32x4){0.f, 0.f, 0.f, 0.f};
        for (int i = 0; i < 256; ++i) { const float a = yr[i]; const f32x4 w = *(const f32x4*)(wg + (size_t)i * 256 + 4 * F.lane); z += w * a; }
        const f32x4 yv = *(const f32x4*)(yr + 4 * F.lane);
        f32x4 y2 = (f32x4){yv.x * sigmoidf_(z.x), yv.y * sigmoidf_(z.y), yv.z * sigmoidf_(z.z), yv.w * sigmoidf_(z.w)};
        const float ss = wave_sum((y2.x * y2.x + y2.y * y2.y) + (y2.z * y2.z + y2.w * y2.w), F.lane);
        const float rs = __builtin_amdgcn_rsqf(ss * (1.f / 256.f) + NORM_EPS);
        const f32x4 g = *(const f32x4*)(gs + 4 * F.lane); y2 = y2 * rs * g;
        u32x2 o; o.x = pk2(y2.x, y2.y); o.y = pk2(y2.z, y2.w); *(u32x2*)(mix + (size_t)t * D + 4 * F.lane) = o;
    }
}
__device__ __forceinline__ void ref_finalize_hg(Ctx& F, int l) {
    const bf16_t* proj = (const bf16_t*)(F.ws + WS_PROJ); bf16_t* mix = (bf16_t*)(F.ws + WS_MIX);
    const float* ov = (const float*)(F.ws + SC_O); const float* gh = F.in[I_HG_ONORM] + l * 512;
    const int gw = F.bid * 8 + F.wave, NGW = F.G * 8;
    for (int t = gw; t < T; t += NGW) {
        const int c = 8 * F.lane; const f32x4 a = *(const f32x4*)(ov + (size_t)t * 512 + c), b = *(const f32x4*)(ov + (size_t)t * 512 + c + 4);
        float ss = ((a.x * a.x + a.y * a.y) + (a.z * a.z + a.w * a.w)) + ((b.x * b.x + b.y * b.y) + (b.z * b.z + b.w * b.w));
        ss += shx(ss, 1, F.lane); ss += shx(ss, 2, F.lane); ss += shx(ss, 4, F.lane); ss += shx(ss, 8, F.lane);
        const float rs = __builtin_amdgcn_rsqf(ss * (1.f / 128.f) + NORM_EPS);
        const f32x4 g0 = *(const f32x4*)(gh + c), g1 = *(const f32x4*)(gh + c + 4);
        const u32x4 gt = *(const u32x4*)(proj + (size_t)t * DIN + PC_G + c);
        float o[8];
        o[0] = a.x * rs * g0.x * siluf_(bflo(gt.x)); o[1] = a.y * rs * g0.y * siluf_(bfhi(gt.x)); o[2] = a.z * rs * g0.z * siluf_(bflo(gt.y)); o[3] = a.w * rs * g0.w * siluf_(bfhi(gt.y));
        o[4] = b.x * rs * g1.x * siluf_(bflo(gt.z)); o[5] = b.y * rs * g1.y * siluf_(bfhi(gt.z)); o[6] = b.z * rs * g1.z * siluf_(bflo(gt.w)); o[7] = b.w * rs * g1.w * siluf_(bfhi(gt.w));
        u32x4 w; w.x = pk2(o[0], o[1]); w.y = pk2(o[2], o[3]); w.z = pk2(o[4], o[5]); w.w = pk2(o[6], o[7]);
        *(u32x4*)(mix + (size_t)t * D + 512 + c) = w;
    }
}
#endif


typedef float f32x16 __attribute__((ext_vector_type(16)));
template <class V> __device__ __forceinline__ void mfma_settle(V& v) { asm volatile("s_nop 15\n\ts_nop 7" : "+v"(v)); }
template <int KSTEPS>
__device__ __forceinline__ void mma32(f32x16& acc, const LAS unsigned char* A, int lda, const LAS unsigned char* Bt, int ldb, int lane) {
    const LAS unsigned char* pa = A + (lane & 31) * lda + (lane >> 5) * 16;
    const LAS unsigned char* pb = Bt + (lane & 31) * ldb + (lane >> 5) * 16;
    bf16x8 a[KSTEPS], b[KSTEPS];
#pragma unroll
    for (int s = 0; s < KSTEPS; ++s) { a[s] = *(const LAS bf16x8*)(pa + s * 32); b[s] = *(const LAS bf16x8*)(pb + s * 32); }
    __builtin_amdgcn_sched_barrier(0);
#pragma unroll
    for (int s = 0; s < KSTEPS; ++s) acc = __builtin_amdgcn_mfma_f32_32x32x16_bf16(a[s], b[s], acc, 0, 0, 0);
    mfma_settle(acc);
}
__device__ __forceinline__ u32x2 pack4(float a, float b, float c, float d) { u32x2 w; w.x = pg8::cvt_pk_bf16(a, b); w.y = pg8::cvt_pk_bf16(c, d); return w; }

constexpr int HS128 = 272, HS64 = 144;
constexpr int HL_QP = 0, HL_KP = HL_QP + 64 * HS128, HL_AQ = HL_KP + 64 * HS128, HL_KDT = HL_AQ + 64 * HS128, HL_VT = HL_KDT + 128 * HS64,
              HL_P = HL_VT + 128 * HS64, HL_ST = HL_P + 64 * HS64, HL_TOT = HL_ST + 128 * HS128, HL_DV = HL_TOT + 4096, HL_END = HL_DV + 512;
static_assert(HL_END <= MISC_OFF, "HGRN2 LDS map");
__device__ __forceinline__ void hg_local(Ctx& F, int l, int unit) {
    const int hd = unit & 3, sg = unit >> 2;
    const bf16_t* proj = (const bf16_t*)(F.ws + WS_PROJ);
    bf16_t* oloc = (bf16_t*)(F.ws + FS_OLOC); bf16_t* aseg = (bf16_t*)(F.ws + FS_ASEG);
    float* send = (float*)(F.ws + FS_SEND); float* dseg = (float*)(F.ws + FS_DSEG);
    LAS unsigned char* L = F.lds;
    LAS float* tot = (LAS float*)(L + HL_TOT); LAS float* dv = (LAS float*)(L + HL_DV);
    const int tid = F.tid, lane = F.lane, w = F.wave, r = lane & 31, h = lane >> 5;
    const int kp = tid & 63, oc = tid >> 6, k0 = 2 * kp;
    const float lbA = ((const float*)(F.ws + WS_TAB))[TB_LBC + l * 512 + hd * 128 + k0], lbB = ((const float*)(F.ws + WS_TAB))[TB_LBC + l * 512 + hd * 128 + k0 + 1];
    const float omA = 1.f - lbA, omB = 1.f - lbB;
    float BsegA = 0.f, BsegB = 0.f;
    f32x16 S0, S1;
#pragma unroll
    for (int i = 0; i < 16; ++i) { S0[i] = 0.f; S1[i] = 0.f; }
    { unsigned zz = 0u; asm volatile("" : "+v"(zz)); for (int i = tid; i < 128 * HS128 / 16; i += 512) ((LAS u32x4*)(L + HL_ST))[i] = (u32x4){zz, zz, zz, zz}; }
    const int kt0 = (2 * w) >> 2, vt0 = (2 * w) & 3, kt1 = (2 * w + 1) >> 2, vt1 = (2 * w + 1) & 3;
#define HG_BAR() do { asm volatile("s_waitcnt lgkmcnt(0)" ::: "memory"); __builtin_amdgcn_s_barrier(); asm volatile("" ::: "memory"); } while (0)
    unsigned rq[8], rf[8], ri[8];
    {
        const unsigned* p0 = (const unsigned*)(proj + (size_t)(sg * 256 + oc * 8) * DIN + PC_Q + hd * 128 + k0);
#pragma unroll
        for (int i = 0; i < 8; ++i) { rq[i] = p0[(size_t)i * (DIN / 2)]; rf[i] = p0[(size_t)i * (DIN / 2) + (PC_F - PC_Q) / 2]; ri[i] = p0[(size_t)i * (DIN / 2) + (PC_I - PC_Q) / 2]; }
    }
    for (int c = 0; c < 4; ++c) {
        const int tc = sg * 256 + c * 64, t0 = tc + oc * 8;
        float lfA[8], lfB[8], qsA[8], qsB[8], kkA[8], kkB[8]; unsigned ivw[8];
        {
            float ef[16], eq[16];
#pragma unroll
            for (int i = 0; i < 8; ++i) { ivw[i] = ri[i];
                ef[2 * i] = __builtin_amdgcn_exp2f(bflo(rf[i]) * -1.4426950408889634f); ef[2 * i + 1] = __builtin_amdgcn_exp2f(bfhi(rf[i]) * -1.4426950408889634f);
                eq[2 * i] = __builtin_amdgcn_exp2f(bflo(rq[i]) * -1.4426950408889634f); eq[2 * i + 1] = __builtin_amdgcn_exp2f(bfhi(rq[i]) * -1.4426950408889634f); }
#pragma unroll
            for (int i = 0; i < 16; ++i) { ef[i] = __builtin_amdgcn_rcpf(1.f + ef[i]); eq[i] = __builtin_amdgcn_rcpf(1.f + eq[i]); }
#pragma unroll
            for (int i = 0; i < 8; ++i) {
                lfA[i] = __builtin_amdgcn_logf(fmaxf(lbA, 1e-30f) + omA * ef[2 * i]) * 0.6931471805599453f; lfB[i] = __builtin_amdgcn_logf(fmaxf(lbB, 1e-30f) + omB * ef[2 * i + 1]) * 0.6931471805599453f;
                kkA[i] = omA * (1.f - ef[2 * i]); kkB[i] = omB * (1.f - ef[2 * i + 1]);
                qsA[i] = bflo(rq[i]) * eq[2 * i]; qsB[i] = bfhi(rq[i]) * eq[2 * i + 1]; }
        }
#pragma unroll
        for (int i = 1; i < 8; ++i) { lfA[i] += lfA[i - 1]; lfB[i] += lfB[i - 1]; }
        *(LAS f32x2*)(tot + oc * 128 + k0) = (f32x2){lfA[7], lfB[7]};
        HG_BAR();
        float preA = 0.f, preB = 0.f, midA = 0.f, midB = 0.f, lastA = 0.f, lastB = 0.f;
#pragma unroll
        for (int o2 = 0; o2 < 8; ++o2) { const f32x2 tv = *(const LAS f32x2*)(tot + o2 * 128 + k0);
            if (o2 < oc) { preA += tv.x; preB += tv.y; } if (o2 < 4) { midA += tv.x; midB += tv.y; } lastA += tv.x; lastB += tv.y; }
        const float EmA = __expf(midA), EmB = __expf(midB), EsA = __expf(midA + BsegA), EsB = __expf(midB + BsegB), ElA = __expf(lastA - midA), ElB = __expf(lastB - midB);
        unsigned kdA[4], kdB[4], ivA[4], ivB[4];
        float e1[16], r1[16];
#pragma unroll
        for (int i = 0; i < 8; ++i) { e1[2 * i] = __builtin_amdgcn_exp2f((preA + lfA[i] - midA) * 1.4426950408889634f); e1[2 * i + 1] = __builtin_amdgcn_exp2f((preB + lfB[i] - midB) * 1.4426950408889634f); }
#pragma unroll
        for (int i = 0; i < 16; ++i) { e1[i] = fminf(fmaxf(e1[i], 1e-30f), 1e30f); r1[i] = __builtin_amdgcn_rcpf(e1[i]); }
#pragma unroll
        for (int i = 0; i < 8; ++i) {
            const int tl = oc * 8 + i;
            const float e1A = e1[2 * i], e1B = e1[2 * i + 1], r1A = r1[2 * i], r1B = r1[2 * i + 1];
            const float qpA = qsA[i] * e1A, qpB = qsB[i] * e1B, kpA = kkA[i] * r1A, kpB = kkB[i] * r1B;
            *(LAS unsigned*)(L + HL_QP + tl * HS128 + k0 * 2) = pk2(qpA, qpB);
            *(LAS unsigned*)(L + HL_KP + tl * HS128 + k0 * 2) = pk2(kpA, kpB);
            *(LAS unsigned*)(L + HL_AQ + tl * HS128 + k0 * 2) = pk2(qpA * EmA, qpB * EmB);
            *(unsigned*)(aseg + (size_t)(t0 + i) * 512 + hd * 128 + k0) = pk2(qpA * EsA, qpB * EsB);
            const unsigned kdab = pk2(kpA * ElA, kpB * ElB), va = ivw[i] & 0xffffu, vb = ivw[i] >> 16;
            if (i & 1) { kdA[i >> 1] |= kdab << 16; kdB[i >> 1] |= kdab & 0xffff0000u; ivA[i >> 1] |= va << 16; ivB[i >> 1] |= vb << 16; }
            else { kdA[i >> 1] = kdab & 0xffffu; kdB[i >> 1] = kdab >> 16; ivA[i >> 1] = va; ivB[i >> 1] = vb; }
        }
        *(LAS u32x4*)(L + HL_KDT + k0 * HS64 + oc * 16) = (u32x4){kdA[0], kdA[1], kdA[2], kdA[3]};
        *(LAS u32x4*)(L + HL_KDT + (k0 + 1) * HS64 + oc * 16) = (u32x4){kdB[0], kdB[1], kdB[2], kdB[3]};
        *(LAS u32x4*)(L + HL_VT + k0 * HS64 + oc * 16) = (u32x4){ivA[0], ivA[1], ivA[2], ivA[3]};
        *(LAS u32x4*)(L + HL_VT + (k0 + 1) * HS64 + oc * 16) = (u32x4){ivB[0], ivB[1], ivB[2], ivB[3]};
        if (oc == 0) *(LAS f32x2*)(dv + k0) = (f32x2){__expf(lastA), __expf(lastB)};
        BsegA += lastA; BsegB += lastB;
        if (c < 3) {
            const unsigned* p0 = (const unsigned*)(proj + (size_t)(tc + 64 + oc * 8) * DIN + PC_Q + hd * 128 + k0);
#pragma unroll
            for (int i = 0; i < 8; ++i) { rq[i] = p0[(size_t)i * (DIN / 2)]; rf[i] = p0[(size_t)i * (DIN / 2) + (PC_F - PC_Q) / 2]; ri[i] = p0[(size_t)i * (DIN / 2) + (PC_I - PC_Q) / 2]; }
        }
        HG_BAR();
        if (w < 4) {
            const int a = w & 1, b = w >> 1;
            f32x16 acc;
#pragma unroll
            for (int i = 0; i < 16; ++i) acc[i] = 0.f;
            if (!(a == 1 && b == 0)) {
                mma32<8>(acc, L + HL_KP + a * 32 * HS128, HS128, L + HL_QP + b * 32 * HS128, HS128, lane);
                if (a == b) {
#pragma unroll
                    for (int i = 0; i < 16; ++i) { const int sl = (i & 3) + 8 * (i >> 2) + 4 * h; acc[i] = (sl <= r) ? acc[i] : 0.f; }
                }
            }
#pragma unroll
            for (int g = 0; g < 4; ++g) *(LAS u32x2*)(L + HL_P + (b * 32 + r) * HS64 + (a * 32 + 8 * g + 4 * h) * 2) = pack4(acc[4 * g], acc[4 * g + 1], acc[4 * g + 2], acc[4 * g + 3]);
        }
        HG_BAR();
        {
            const int vt = w & 3, tt = w >> 2;
            f32x16 acc;
#pragma unroll
            for (int i = 0; i < 16; ++i) acc[i] = 0.f;
            mma32<4>(acc, L + HL_VT + vt * 32 * HS64, HS64, L + HL_P + tt * 32 * HS64, HS64, lane);
            mma32<8>(acc, L + HL_ST + vt * 32 * HS128, HS128, L + HL_AQ + tt * 32 * HS128, HS128, lane);
            u32x2* otile = (u32x2*)oloc + ((size_t)((hd * 512 + (tc >> 5) + tt) * 16 + vt * 4)) * 64 + lane;
#pragma unroll
            for (int g = 0; g < 4; ++g) otile[g * 64] = pack4(acc[4 * g], acc[4 * g + 1], acc[4 * g + 2], acc[4 * g + 3]);
        }
#pragma unroll
        for (int i = 0; i < 16; ++i) { const int ko = (i & 3) + 8 * (i >> 2) + 4 * h; S0[i] *= dv[kt0 * 32 + ko]; S1[i] *= dv[kt1 * 32 + ko]; }
        mma32<4>(S0, L + HL_KDT + kt0 * 32 * HS64, HS64, L + HL_VT + vt0 * 32 * HS64, HS64, lane);
        mma32<4>(S1, L + HL_KDT + kt1 * 32 * HS64, HS64, L + HL_VT + vt1 * 32 * HS64, HS64, lane);
        HG_BAR();
#pragma unroll
        for (int g = 0; g < 4; ++g) {
            *(LAS u32x2*)(L + HL_ST + (vt0 * 32 + r) * HS128 + (kt0 * 32 + 8 * g + 4 * h) * 2) = pack4(S0[4 * g], S0[4 * g + 1], S0[4 * g + 2], S0[4 * g + 3]);
            *(LAS u32x2*)(L + HL_ST + (vt1 * 32 + r) * HS128 + (kt1 * 32 + 8 * g + 4 * h) * 2) = pack4(S1[4 * g], S1[4 * g + 1], S1[4 * g + 2], S1[4 * g + 3]);
        }
    }
    float* se = send + ((size_t)(sg * 4 + hd) * 128) * 128;
#pragma unroll
    for (int g = 0; g < 4; ++g) {
        *(f32x4*)(se + (size_t)(vt0 * 32 + r) * 128 + kt0 * 32 + 8 * g + 4 * h) = (f32x4){S0[4 * g], S0[4 * g + 1], S0[4 * g + 2], S0[4 * g + 3]};
        *(f32x4*)(se + (size_t)(vt1 * 32 + r) * 128 + kt1 * 32 + 8 * g + 4 * h) = (f32x4){S1[4 * g], S1[4 * g + 1], S1[4 * g + 2], S1[4 * g + 3]};
    }
    if (oc == 0) { dseg[sg * 512 + hd * 128 + k0] = __expf(BsegA); dseg[sg * 512 + hd * 128 + k0 + 1] = __expf(BsegB); }
    __syncthreads();
#undef HG_BAR
}
__device__ __forceinline__ void hg_carry(Ctx& F, int bu) {
    const float* send = (const float*)(F.ws + FS_SEND); const float* dseg = (const float*)(F.ws + FS_DSEG); bf16_t* sst = (bf16_t*)(F.ws + FS_SST);
    LAS float* gP = (LAS float*)F.lds; LAS float* gL = gP + 512;
    const int el = F.tid & 63, grp = F.tid >> 6, e = bu * 64 + el, hd = e >> 14, k = e & 127;
    float locA[8], PA[8]; float loc = 0.f, P = 1.f;
#pragma unroll
    for (int i = 0; i < 8; ++i) { const int sgi = grp * 8 + i; const float d = dseg[sgi * 512 + hd * 128 + k], x = send[(size_t)sgi * 65536 + e]; loc = d * loc + x; P *= d; locA[i] = loc; PA[i] = P; }
    gP[grp * 64 + el] = P; gL[grp * 64 + el] = loc;
    __syncthreads();
    float X = 0.f;
    for (int g2 = 0; g2 < grp; ++g2) X = gP[g2 * 64 + el] * X + gL[g2 * 64 + el];
#pragma unroll
    for (int i = 0; i < 8; ++i) { const float v = (i == 0) ? X : (PA[i - 1 < 0 ? 0 : i - 1] * X + locA[i - 1 < 0 ? 0 : i - 1]); sst[(size_t)(grp * 8 + i) * 65536 + e] = (bf16_t)f2bf(v); }
    __syncthreads();
}
constexpr int HF_ST = 0, HF_AS = 128 * HS128, HF_END = HF_AS + 256 * HS128;
static_assert(HF_END <= MISC_OFF, "HGRN2 fix-up LDS map");
__device__ __forceinline__ void hg_fix(Ctx& F, int l, int unit) {
    const int hd = unit & 3, sg = unit >> 2;
    bf16_t* mix = (bf16_t*)(F.ws + WS_MIX);
    const bf16_t* oloc = (const bf16_t*)(F.ws + FS_OLOC); const bf16_t* aseg = (const bf16_t*)(F.ws + FS_ASEG); const bf16_t* sst = (const bf16_t*)(F.ws + FS_SST);
    const float* gh = F.in[I_HG_ONORM] + l * 512 + hd * 128;
    LAS unsigned char* L = F.lds;
    const int tid = F.tid, lane = F.lane, w = F.wave, r = lane & 31, h = lane >> 5;
    f32x16 acc[4];
#pragma unroll
    for (int v = 0; v < 4; ++v)
#pragma unroll
        for (int i = 0; i < 16; ++i) acc[v][i] = 0.f;
    const int t32 = sg * 8 + w;
    const u32x2* otile = (const u32x2*)oloc + ((size_t)((hd * 512 + t32) * 16)) * 64 + lane;
    const u32x2* gtile = (const u32x2*)(F.ws + FS_GATE) + ((size_t)((hd * 512 + t32) * 16)) * 64 + lane;
    u32x2 opre[16], gpre[16];
#pragma unroll
    for (int i = 0; i < 16; ++i) { opre[i] = otile[i * 64]; gpre[i] = gtile[i * 64]; }
    if (sg > 0) {
        const bf16_t* ss = sst + ((size_t)(sg * 4 + hd) * 128) * 128;
        for (int i = tid; i < 128 * 16; i += 512) { const int row = i >> 4, ch = i & 15; *(LAS u32x4*)(L + HF_ST + row * HS128 + ch * 16) = *(const u32x4*)(ss + (size_t)row * 128 + ch * 8); }
        for (int i = tid; i < 256 * 16; i += 512) { const int row = i >> 4, ch = i & 15; *(LAS u32x4*)(L + HF_AS + row * HS128 + ch * 16) = *(const u32x4*)(aseg + (size_t)(sg * 256 + row) * 512 + hd * 128 + ch * 8); }
        __syncthreads();
#pragma unroll
        for (int v = 0; v < 4; ++v) mma32<8>(acc[v], L + HF_ST + v * 32 * HS128, HS128, L + HF_AS + w * 32 * HS128, HS128, lane);
    }
    float ssum = 0.f;
#pragma unroll
    for (int v = 0; v < 4; ++v)
#pragma unroll
        for (int g = 0; g < 4; ++g) { const u32x2 o = opre[v * 4 + g];
            acc[v][4 * g] += bflo(o.x); acc[v][4 * g + 1] += bfhi(o.x); acc[v][4 * g + 2] += bflo(o.y); acc[v][4 * g + 3] += bfhi(o.y);
            ssum += (acc[v][4 * g] * acc[v][4 * g] + acc[v][4 * g + 1] * acc[v][4 * g + 1]) + (acc[v][4 * g + 2] * acc[v][4 * g + 2] + acc[v][4 * g + 3] * acc[v][4 * g + 3]); }
    ssum += shx(ssum, 32, lane);
    const float rs = __builtin_amdgcn_rsqf(ssum * (1.f / 128.f) + NORM_EPS);
    __syncthreads();
    LAS unsigned char* ost = L + w * 32 * HS128;
#pragma unroll
    for (int v = 0; v < 4; ++v)
#pragma unroll
        for (int g = 0; g < 4; ++g) { const int vo = v * 32 + 8 * g + 4 * h; const u32x2 gt = gpre[v * 4 + g]; const f32x4 gn = *(const f32x4*)(gh + vo);
            *(LAS u32x2*)(ost + r * HS128 + vo * 2) = pack4(acc[v][4 * g] * rs * gn.x * bflo(gt.x), acc[v][4 * g + 1] * rs * gn.y * bfhi(gt.x),
                                                            acc[v][4 * g + 2] * rs * gn.z * bflo(gt.y), acc[v][4 * g + 3] * rs * gn.w * bfhi(gt.y)); }
    __syncthreads();
    {
        const int t0 = sg * 256 + w * 32;
#pragma unroll
        for (int it = 0; it < 8; ++it) { const int row = it * 4 + (lane >> 4), ch = lane & 15;
            *(u32x4*)(mix + (size_t)(t0 + row) * D + 512 + hd * 128 + ch * 8) = *(const LAS u32x4*)(ost + row * HS128 + ch * 16); }
    }
    __syncthreads();
}

constexpr int S5_XS = 272, S5_Y1S = 528;
constexpr int S5L_X = 0, S5L_Y1 = S5L_X + 8 * 32 * S5_XS, S5L_PART = S5L_Y1 + 64 * S5_Y1S, S5L_END = S5L_PART + 64 * 4 * 4;
static_assert(S5L_END <= MISC_OFF, "S5 LDS map");
template <bool FULL>
__device__ __forceinline__ void s5_pass(Ctx& F, int l, int cidx) {
    const bf16_t* proj = (const bf16_t*)(F.ws + WS_PROJ); const float* tab = (const float*)(F.ws + WS_TAB);
    float* xe = (float*)(F.ws + FS_XE); const float* xin = (const float*)(F.ws + FS_XIN);
    const bf16_t* bbi = (const bf16_t*)(F.ws + WS_BB); const bf16_t* cmi = (const bf16_t*)(F.ws + WS_CM);
    LAS unsigned char* L = F.lds;
    const int lane = F.lane, w = F.wave, r = lane & 31, h = lane >> 5;
    LAS unsigned char* X = L + S5L_X + w * 32 * S5_XS;
    const int tc = cidx * 64;
#define S5_BAR() do { asm volatile("s_waitcnt lgkmcnt(0)" ::: "memory"); __builtin_amdgcn_s_barrier(); asm volatile("" ::: "memory"); } while (0)
    for (int gi = 0; gi < 2; ++gi) {
        const int g = 2 * w + gi, lg = l * 16 + g, st = g * 64 + lane;
        const float lbr = tab[TB_LAMB + 2 * (lg * 64 + lane)], lbi = tab[TB_LAMB + 2 * (lg * 64 + lane) + 1];
        bf16x8 Bf[4];
#pragma unroll
        for (int nt = 0; nt < 4; ++nt) Bf[nt] = *(const bf16x8*)(bbi + ((size_t)lg * 128 + nt * 32 + r) * 16 + h * 8);
        bf16x8 Cf[8];
        if (FULL) {
#pragma unroll
            for (int s2 = 0; s2 < 8; ++s2) { Cf[s2] = (bf16x8){0, 0, 0, 0, 0, 0, 0, 0}; if (r < 16) Cf[s2] = *(const bf16x8*)(cmi + ((size_t)lg * 16 + r) * 128 + s2 * 16 + h * 8); }
        }
        float xr = 0.f, xi = 0.f;
        if (FULL) { xr = xin[((size_t)cidx * 1024 + st) * 2]; xi = xin[((size_t)cidx * 1024 + st) * 2 + 1]; }
        bf16x8 Af2[2];
#pragma unroll
        for (int hf = 0; hf < 2; ++hf) Af2[hf] = *(const bf16x8*)(proj + (size_t)(tc + hf * 32 + r) * DIN + PC_U + g * 16 + h * 8);
        bf16x8 Df = (bf16x8){0, 0, 0, 0, 0, 0, 0, 0};
        if (FULL) { const short db = (short)f2bf(F.in[I_S5_D][l * S5W + g * 16 + (r & 15)]);
#pragma unroll
            for (int j = 0; j < 8; ++j) Df[j] = (r < 16 && r - 8 * h == j) ? db : (short)0; }
        for (int half = 0; half < 2; ++half) {
            const bf16x8 Af = Af2[half];
            f32x16 acc4[4];
#pragma unroll
            for (int nt = 0; nt < 4; ++nt) {
#pragma unroll
                for (int i = 0; i < 16; ++i) acc4[nt][i] = 0.f;
                acc4[nt] = __builtin_amdgcn_mfma_f32_32x32x16_bf16(Bf[nt], Af, acc4[nt], 0, 0, 0);
            }
            asm volatile("s_nop 15\n\ts_nop 7" : "+v"(acc4[0]), "+v"(acc4[1]), "+v"(acc4[2]), "+v"(acc4[3]));
#pragma unroll
            for (int nt = 0; nt < 4; ++nt)
#pragma unroll
                for (int g4 = 0; g4 < 4; ++g4) *(LAS u32x2*)(X + r * S5_XS + (nt * 32 + 8 * g4 + 4 * h) * 2) = pack4(acc4[nt][4 * g4], acc4[nt][4 * g4 + 1], acc4[nt][4 * g4 + 2], acc4[nt][4 * g4 + 3]);
            S5_BAR();
            unsigned bwv[32];
#pragma unroll
            for (int i = 0; i < 32; ++i) bwv[i] = *(const LAS unsigned*)(X + i * S5_XS + lane * 4);
            __builtin_amdgcn_sched_barrier(0);
#pragma unroll
            for (int i = 0; i < 32; ++i) {
                const unsigned bw = bwv[i];
                const float nr = lbr * xr - lbi * xi + bflo(bw), ni = lbr * xi + lbi * xr + bfhi(bw); xr = nr; xi = ni;
                if (FULL) *(LAS unsigned*)(X + i * S5_XS + lane * 4) = pk2(xr, xi);
            }
            S5_BAR();
            if (FULL) {
                f32x16 ya;
#pragma unroll
                for (int i = 0; i < 16; ++i) ya[i] = 0.f;
                bf16x8 xav[8];
#pragma unroll
                for (int s2 = 0; s2 < 8; ++s2) xav[s2] = *(const LAS bf16x8*)(X + r * S5_XS + s2 * 32 + h * 16);
                __builtin_amdgcn_sched_barrier(0);
#pragma unroll
                for (int s2 = 0; s2 < 8; ++s2) ya = __builtin_amdgcn_mfma_f32_32x32x16_bf16(Cf[s2], xav[s2], ya, 0, 0, 0);
                ya = __builtin_amdgcn_mfma_f32_32x32x16_bf16(Df, Af, ya, 0, 0, 0);
                mfma_settle(ya);
#pragma unroll
                for (int g2 = 0; g2 < 2; ++g2) *(LAS u32x2*)(L + S5L_Y1 + (half * 32 + r) * S5_Y1S + (g * 16 + 8 * g2 + 4 * h) * 2) =
                    pack4(gelu_tanh(ya[4 * g2]), gelu_tanh(ya[4 * g2 + 1]), gelu_tanh(ya[4 * g2 + 2]), gelu_tanh(ya[4 * g2 + 3]));
            }
            S5_BAR();
        }
        if (!FULL) { xe[((size_t)cidx * 1024 + st) * 2] = xr; xe[((size_t)cidx * 1024 + st) * 2 + 1] = xi; }
    }
    if (FULL) {
        __syncthreads();
        const bf16_t* wgt = (const bf16_t*)(F.ws + WS_GLU) + (size_t)l * 256 * 256;
        const float* gs = F.in[I_S5_ONORM] + l * 256; bf16_t* mix = (bf16_t*)(F.ws + WS_MIX);
        LAS float* part = (LAS float*)(L + S5L_PART);
        const int r = lane & 31, h = lane >> 5, tt = w & 1, jg = w >> 1;
        f32x16 z[2];
#pragma unroll
        for (int jt = 0; jt < 2; ++jt) {
#pragma unroll
            for (int i = 0; i < 16; ++i) z[jt][i] = 0.f;
            const bf16_t* wa = wgt + (size_t)((jg * 2 + jt) * 32 + r) * 256 + h * 8;
            const LAS unsigned char* pb = L + S5L_Y1 + (tt * 32 + r) * S5_Y1S + h * 16;
#pragma unroll
#ifndef EXP_NOGLU
            for (int s2 = 0; s2 < 16; ++s2) { const bf16x8 a = *(const bf16x8*)(wa + s2 * 16), b = *(const LAS bf16x8*)(pb + s2 * 32); z[jt] = __builtin_amdgcn_mfma_f32_32x32x16_bf16(a, b, z[jt], 0, 0, 0); }
#else
            for (int s2 = 0; s2 < 1; ++s2) { (void)wa; (void)pb; }
#endif
            mfma_settle(z[jt]);
        }
        float ssum = 0.f;
#pragma unroll
        for (int jt = 0; jt < 2; ++jt)
#pragma unroll
            for (int g4 = 0; g4 < 4; ++g4) { const int j0 = (jg * 2 + jt) * 32 + 8 * g4 + 4 * h; const u32x2 yv = *(const LAS u32x2*)(L + S5L_Y1 + (tt * 32 + r) * S5_Y1S + j0 * 2);
                const float y0 = bflo(yv.x) * sigmoidf_(z[jt][4 * g4]), y1v = bfhi(yv.x) * sigmoidf_(z[jt][4 * g4 + 1]), y2 = bflo(yv.y) * sigmoidf_(z[jt][4 * g4 + 2]), y3 = bfhi(yv.y) * sigmoidf_(z[jt][4 * g4 + 3]);
                z[jt][4 * g4] = y0; z[jt][4 * g4 + 1] = y1v; z[jt][4 * g4 + 2] = y2; z[jt][4 * g4 + 3] = y3; ssum += (y0 * y0 + y1v * y1v) + (y2 * y2 + y3 * y3); }
        ssum += shx(ssum, 32, lane);
        if (h == 0) part[(tt * 32 + r) * 4 + jg] = ssum;
        __syncthreads();
        const f32x4 pp = *(const LAS f32x4*)(part + (tt * 32 + r) * 4);
        const float rs = __builtin_amdgcn_rsqf(((pp.x + pp.y) + (pp.z + pp.w)) * (1.f / 256.f) + NORM_EPS);
#pragma unroll
        for (int jt = 0; jt < 2; ++jt)
#pragma unroll
            for (int g4 = 0; g4 < 4; ++g4) { const int j0 = (jg * 2 + jt) * 32 + 8 * g4 + 4 * h; const f32x4 gn = *(const f32x4*)(gs + j0);
                *(LAS u32x2*)(L + S5L_Y1 + (tt * 32 + r) * S5_Y1S + j0 * 2) = pack4(z[jt][4 * g4] * rs * gn.x, z[jt][4 * g4 + 1] * rs * gn.y, z[jt][4 * g4 + 2] * rs * gn.z, z[jt][4 * g4 + 3] * rs * gn.w); }
        __syncthreads();
#pragma unroll
        for (int it = 0; it < 4; ++it) { const int row = it * 16 + (F.tid >> 5), ch = F.tid & 31;
            *(u32x4*)(mix + (size_t)(tc + row) * D + ch * 8) = *(const LAS u32x4*)(L + S5L_Y1 + row * S5_Y1S + ch * 16); }
    }
    __syncthreads();
}
__device__ __forceinline__ void s5_endstates(Ctx& F, int l, int bu) {
    const bf16_t* proj = (const bf16_t*)(F.ws + WS_PROJ); const bf16_t* vt = (const bf16_t*)(F.ws + WS_VT); float* xe = (float*)(F.ws + FS_XE);
    const int w = F.wave, wu = bu * 2 + (w >> 2), kq = w & 3;
    const int g = wu >> 5, ct = (wu >> 2) & 7, nt = wu & 3, lane = F.lane, r = lane & 31, h = lane >> 5;
    const bf16_t* pa = proj + (size_t)((ct * 32 + r) * 64 + kq * 16) * DIN + PC_U + g * 16 + h * 8;
    const bf16_t* pb = vt + ((size_t)(l * 16 + g) * 128 + nt * 32 + r) * 1024 + kq * 256 + h * 8;
    f32x16 acc;
#pragma unroll
    for (int i = 0; i < 16; ++i) acc[i] = 0.f;
#pragma unroll
    for (int st = 0; st < 16; ++st) { const bf16x8 a = *(const bf16x8*)(pa + (size_t)st * DIN), b = *(const bf16x8*)(pb + st * 16); acc = __builtin_amdgcn_mfma_f32_32x32x16_bf16(a, b, acc, 0, 0, 0); }
    mfma_settle(acc);
    LAS float* part = (LAS float*)F.lds + (w * 16) * 64 + lane;
#pragma unroll
    for (int i = 0; i < 16; ++i) part[i * 64] = acc[i];
    __syncthreads();
    if (kq == 0) {
        float* xo = xe + (size_t)(ct * 32) * 2048 + g * 128 + nt * 32 + r;
#pragma unroll
        for (int i = 0; i < 16; ++i) { const float v = (part[i * 64] + part[(16 + i) * 64]) + (part[(32 + i) * 64] + part[(48 + i) * 64]);
            xo[(size_t)((i & 3) + 8 * (i >> 2) + 4 * h) * 2048] = v; }
    }
    __syncthreads();
}
__device__ __forceinline__ void s5_carry(Ctx& F, int l, int bu) {
    const float* tab = (const float*)(F.ws + WS_TAB); const float* xe = (const float*)(F.ws + FS_XE); float* xin = (float*)(F.ws + FS_XIN);
    LAS float* gL = (LAS float*)(F.lds + 8192);
    const int sl = F.tid & 31, grp = F.tid >> 5, st = bu * 32 + sl;
    float ar = tab[TB_LAMB + 2 * (l * 1024 + st)], ai = tab[TB_LAMB + 2 * (l * 1024 + st) + 1];
#pragma unroll
    for (int i = 0; i < 6; ++i) { const float nr = ar * ar - ai * ai, ni = 2.f * ar * ai; ar = nr; ai = ni; }
    float lr[16], li[16], pr[16], pi[16]; float cr = 0.f, ci = 0.f, qr = 1.f, qi = 0.f;
#pragma unroll
    for (int i = 0; i < 16; ++i) { const int c = grp * 16 + i; const f32x2 x = *(const f32x2*)(xe + ((size_t)c * 1024 + st) * 2);
        const float nr = ar * cr - ai * ci + x.x, ni = ar * ci + ai * cr + x.y; cr = nr; ci = ni; lr[i] = cr; li[i] = ci;
        const float mr = ar * qr - ai * qi, mi = ar * qi + ai * qr; qr = mr; qi = mi; pr[i] = qr; pi[i] = qi; }
    gL[(grp * 32 + sl) * 2] = cr; gL[(grp * 32 + sl) * 2 + 1] = ci;
    __syncthreads();
    float Xr = 0.f, Xi = 0.f;
    for (int g2 = 0; g2 < grp; ++g2) { const float er = gL[(g2 * 32 + sl) * 2], ei = gL[(g2 * 32 + sl) * 2 + 1]; const float nr = qr * Xr - qi * Xi + er, ni = qr * Xi + qi * Xr + ei; Xr = nr; Xi = ni; }
#pragma unroll
    for (int i = 0; i < 16; ++i) { const int c = grp * 16 + i; float vr = Xr, vi = Xi;
        if (i > 0) { vr = pr[i - 1] * Xr - pi[i - 1] * Xi + lr[i - 1]; vi = pr[i - 1] * Xi + pi[i - 1] * Xr + li[i - 1]; }
        *(f32x2*)(xin + ((size_t)c * 1024 + st) * 2) = (f32x2){vr, vi}; }
    __syncthreads();
}

__device__ __forceinline__ void router_phase(Ctx& F, int j) {
    const float* ssq = (const float*)(F.ws + WS_SSQ); const bf16_t* hb = (const bf16_t*)(F.ws + WS_HB);
    LAS float* lgs = (LAS float*)F.lds;
    LAS float* rgL = (LAS float*)(F.lds + 65536);
    { const f32x4* src = (const f32x4*)((const float*)(F.ws + WS_TAB) + TB_RG + j * 8 * 1024);
#pragma unroll
      for (int i = 0; i < 4; ++i) { const int idx = F.tid + 512 * i, e = idx >> 8, c4 = idx & 255; *(LAS f32x4*)(rgL + e * 1028 + c4 * 4) = src[idx]; } }
    __syncthreads();
    LAS int* sel = (LAS int*)(F.lds + 32768);
    LAS float* selg = (LAS float*)(F.lds + 32768 + 512);
    int* tok_e = (int*)(F.ws + WS_MOE + MO_TOKE); int* tok_p = (int*)(F.ws + WS_MOE + MO_TOKP); float* rstd_tok = (float*)(F.ws + WS_MOE + MO_RSTD);
    int* tcnt = (int*)(F.ws + WS_MOE + MO_TCNT); int* tlist = (int*)(F.ws + WS_MOE + MO_TLIST); float* tgate = (float*)(F.ws + WS_MOE + MO_TGATE);
    for (int tile = F.bid; tile < T / 64; tile += F.G) {
        {
            const int tl = F.tid >> 3, e = F.tid & 7, t = tile * 64 + tl;
            const u32x4* hp = (const u32x4*)(hb + (size_t)t * D); const LAS float* rp = rgL + e * 1028;
            f32x2 a2 = (f32x2){0.f, 0.f}, b2 = (f32x2){0.f, 0.f};
#pragma unroll 8
            for (int k8 = 0; k8 < 128; ++k8) { const u32x4 hw = hp[k8]; const f32x4 r0 = *(const LAS f32x4*)(rp + k8 * 8), r1 = *(const LAS f32x4*)(rp + k8 * 8 + 4);
                a2 += (f32x2){bflo(hw.x), bfhi(hw.x)} * (f32x2){r0.x, r0.y}; b2 += (f32x2){bflo(hw.y), bfhi(hw.y)} * (f32x2){r0.z, r0.w};
                a2 += (f32x2){bflo(hw.z), bfhi(hw.z)} * (f32x2){r1.x, r1.y}; b2 += (f32x2){bflo(hw.w), bfhi(hw.w)} * (f32x2){r1.z, r1.w}; }
            const float a = (a2.x + a2.y) + (b2.x + b2.y);
            float ss = ssq[(size_t)t * 16 + e] + ssq[(size_t)t * 16 + 8 + e];
            ss += shx(ss, 1, F.lane); ss += shx(ss, 2, F.lane); ss += shx(ss, 4, F.lane);
            const float rs = __builtin_amdgcn_rsqf(ss * (1.f / D) + NORM_EPS);
            lgs[tl * 8 + e] = a * rs;
            if (e == 0) rstd_tok[t] = rs;
        }
        __syncthreads();
        if (F.tid < 64) {
            const int tl = F.tid; float lg[8];
#pragma unroll
            for (int e = 0; e < 8; ++e) lg[e] = lgs[tl * 8 + e];
            int i1 = 0; float v1 = lg[0];
#pragma unroll
            for (int e = 1; e < 8; ++e) if (lg[e] > v1) { v1 = lg[e]; i1 = e; }
            int i2 = -1; float v2 = -3.0e38f;
#pragma unroll
            for (int e = 0; e < 8; ++e) if (e != i1 && lg[e] > v2) { v2 = lg[e]; i2 = e; }
            const float g1 = 1.f / (1.f + expf(v2 - v1)), g2 = 1.f - g1;
            sel[tl * 2] = i1; sel[tl * 2 + 1] = i2; selg[tl * 2] = g1; selg[tl * 2 + 1] = g2;
        }
        __syncthreads();
        if (F.tid < 8) {
            const int e = F.tid; int n = 0;
            for (int q = 0; q < 128; ++q) n += (sel[q] == e) ? 1 : 0;
            tcnt[tile * 8 + e] = n;
            int pos = 0;
            for (int q = 0; q < 128; ++q) if (sel[q] == e) { const int t = tile * 64 + (q >> 1);
                tok_e[t * 2 + (q & 1)] = e; tok_p[t * 2 + (q & 1)] = pos; tlist[(tile * 8 + e) * 64 + pos] = t; tgate[(tile * 8 + e) * 64 + pos] = selg[q]; ++pos; }
        }
        __syncthreads();
    }
}
__device__ __forceinline__ void moe_tables(Ctx& F, int j, LAS int* tab) {
    const int* tcnt = (const int*)(F.ws + WS_MOE + MO_TCNT); LAS int* baseL = (LAS int*)(F.lds + BASE_OFF);
    for (int i = F.tid; i < 2048; i += 512) baseL[i] = tcnt[i];
    __syncthreads();
    {
        const int e = F.wave, l4 = F.lane * 4;
        const int c0 = baseL[(l4 + 0) * 8 + e], c1 = baseL[(l4 + 1) * 8 + e], c2 = baseL[(l4 + 2) * 8 + e], c3 = baseL[(l4 + 3) * 8 + e];
        int inc = (c0 + c1) + (c2 + c3);
#pragma unroll
        for (int d = 1; d < 64; d <<= 1) { const int up = __builtin_amdgcn_ds_bpermute(((F.lane - d) & 63) << 2, inc); if (F.lane >= d) inc += up; }
        const int ex = inc - ((c0 + c1) + (c2 + c3));
        baseL[(l4 + 0) * 8 + e] = ex; baseL[(l4 + 1) * 8 + e] = ex + c0; baseL[(l4 + 2) * 8 + e] = ex + c0 + c1; baseL[(l4 + 3) * 8 + e] = ex + c0 + c1 + c2;
        if (F.lane == 63) tab[e] = inc;
    }
    __syncthreads();
    if (F.tid == 0) { int pp = 0; for (int e = 0; e < 8; ++e) { tab[8 + e] = pp; pp += (tab[e] + 255) >> 8; } tab[16] = pp; }
    __syncthreads();
}
__device__ __forceinline__ int slot_src(const LAS int* baseL, int e, int pos) {
    int lo = 0;
#pragma unroll
    for (int st = 128; st >= 1; st >>= 1) { const int m = lo + st; if (m < 256 && baseL[m * 8 + e] <= pos) lo = m; }
    return (lo * 8 + e) * 64 + (pos - baseL[lo * 8 + e]);
}
struct TailGeom { int nwg, Lmain, R, S; };
__device__ __forceinline__ TailGeom tail_geom(int NP, int G) {
    TailGeom t; t.nwg = NP * 4; t.Lmain = (t.nwg / G) * G; t.R = t.nwg - t.Lmain;
    t.S = 1; if (t.R > 0) { if (t.R * 14 <= G) t.S = 14; else if (t.R * 7 <= G) t.S = 7; else if (t.R * 2 <= G) t.S = 2; }
    return t;
}
__device__ __forceinline__ void combine_phase(Ctx& F, int j, float* out, bool last, LAS int* tab) {
    const unsigned char* y = (const unsigned char*)(F.ws + WS_Y); bf16_t* hb = (bf16_t*)(F.ws + WS_HB); float* ssq = (float*)(F.ws + WS_SSQ);
    const bf16_t* yt = (const bf16_t*)(F.ws + WS_YT);
    LAS int* tt = tab + 64;
    const int NP = __builtin_amdgcn_readfirstlane(tab[16]); const TailGeom tg = tail_geom(NP, F.G);
    for (int i = F.tid; i < NP * 4; i += 512) tt[i] = -1;
    __syncthreads();
    if (F.tid < tg.R) { pg8::TileOrder o; o.init(NP, 4, F.G, 0); int pm, pn; if (o.mapL(tg.Lmain + F.tid, pm, pn)) tt[pm * 4 + pn] = F.tid; }
    __syncthreads();
    const int* tok_e = (const int*)(F.ws + WS_MOE + MO_TOKE); const int* tok_p = (const int*)(F.ws + WS_MOE + MO_TOKP);
    const float* fn = F.in[I_FINAL_NORM];
    const int gw = F.bid * 8 + F.wave, NGW = F.G * 8;
    const LAS int* baseL = (const LAS int*)(F.lds + BASE_OFF);
    for (int tb = gw * 4; tb < T; tb += NGW * 4) {
        size_t s1[4], s2[4];
#pragma unroll
        for (int k = 0; k < 4; ++k) { const int t = tb + k, e1 = tok_e[2 * t], e2 = tok_e[2 * t + 1], tl6 = t >> 6;
            s1[k] = (size_t)tab[8 + e1] * 256 + baseL[tl6 * 8 + e1] + tok_p[2 * t]; s2[k] = (size_t)tab[8 + e2] * 256 + baseL[tl6 * 8 + e2] + tok_p[2 * t + 1]; }
        u32x2 hw[4][4]; unsigned ya[4][4], yb[4][4]; int t1[4][4], t2[4][4];
#pragma unroll
        for (int k = 0; k < 4; ++k)
#pragma unroll
            for (int q = 0; q < 4; ++q) {
                t1[k][q] = __builtin_amdgcn_readfirstlane(tt[(int)(s1[k] >> 8) * 4 + q]); t2[k][q] = __builtin_amdgcn_readfirstlane(tt[(int)(s2[k] >> 8) * 4 + q]);
                hw[k][q] = *((const u32x2*)(hb + (size_t)(tb + k) * D) + F.lane + 64 * q);
                ya[k][q] = *((const unsigned*)(y + s1[k] * D) + F.lane + 64 * q);
                yb[k][q] = *((const unsigned*)(y + s2[k] * D) + F.lane + 64 * q); }
        f32x4 v[4][4]; float ss[4];
#pragma unroll
        for (int k = 0; k < 4; ++k) { ss[k] = 0.f;
#pragma unroll
            for (int q = 0; q < 4; ++q) {
                const f32x2 a01 = __builtin_amdgcn_cvt_pk_f32_fp8((int)ya[k][q], false), a23 = __builtin_amdgcn_cvt_pk_f32_fp8((int)ya[k][q], true),
                            b01 = __builtin_amdgcn_cvt_pk_f32_fp8((int)yb[k][q], false), b23 = __builtin_amdgcn_cvt_pk_f32_fp8((int)yb[k][q], true);
                f32x4 fa = (f32x4){a01.x, a01.y, a23.x, a23.y} * 0.0625f, fb = (f32x4){b01.x, b01.y, b23.x, b23.y} * 0.0625f;
                if (t1[k][q] >= 0) { fa = (f32x4){0.f, 0.f, 0.f, 0.f}; const int r1 = (int)(s1[k] & 255);
                    for (int sl = 0; sl < tg.S; ++sl) { const u32x2 a = *((const u32x2*)(yt + ((size_t)(t1[k][q] * tg.S + sl) * 256 + r1) * 256) + F.lane); fa += (f32x4){bflo(a.x), bfhi(a.x), bflo(a.y), bfhi(a.y)}; } }
                if (t2[k][q] >= 0) { fb = (f32x4){0.f, 0.f, 0.f, 0.f}; const int r2 = (int)(s2[k] & 255);
                    for (int sl = 0; sl < tg.S; ++sl) { const u32x2 a = *((const u32x2*)(yt + ((size_t)(t2[k][q] * tg.S + sl) * 256 + r2) * 256) + F.lane); fb += (f32x4){bflo(a.x), bfhi(a.x), bflo(a.y), bfhi(a.y)}; } }
                f32x4 x = (f32x4){bflo(hw[k][q].x), bfhi(hw[k][q].x), bflo(hw[k][q].y), bfhi(hw[k][q].y)}; x = (x + fa) + fb;
                v[k][q] = x; ss[k] += (x.x * x.x + x.y * x.y) + (x.z * x.z + x.w * x.w); } }
#pragma unroll
        for (int o = 1; o < 64; o <<= 1) {
#pragma unroll
            for (int k = 0; k < 4; ++k) ss[k] += shx(ss[k], o, F.lane); }
#pragma unroll
        for (int k = 0; k < 4; ++k) { const int t = tb + k;
            if (last) { const float rs = __builtin_amdgcn_rsqf(ss[k] * (1.f / D) + NORM_EPS); f32x4* orow = (f32x4*)(out + (size_t)t * D) + F.lane;
#pragma unroll
                for (int q = 0; q < 4; ++q) { const f32x4 g = *((const f32x4*)fn + F.lane + 64 * q); orow[64 * q] = v[k][q] * rs * g; }
            } else {
                u32x2* o8 = (u32x2*)(hb + (size_t)t * D) + F.lane;
#pragma unroll
                for (int q = 0; q < 4; ++q) { u32x2 w; w.x = pk2(v[k][q].x, v[k][q].y); w.y = pk2(v[k][q].z, v[k][q].w); o8[64 * q] = w;
                    if (F8_IN & 0x4) *((unsigned*)(F.ws + WS_HB8 + (size_t)t * D) + F.lane + 64 * q) = pk4_f8(v[k][q].x, v[k][q].y, v[k][q].z, v[k][q].w); }
                if (F.lane < 16) ssq[(size_t)t * 16 + F.lane] = (F.lane == 0) ? ss[k] : 0.f;
            } }
    }
}

constexpr int PH_PER_LAYER = 10, N_PHASES = 1 + DEPTH * PH_PER_LAYER;
__host__ __device__ constexpr bool phase_exists(int ph) {
    if (ph == 0) return true;
    const int l = (ph - 1) / PH_PER_LAYER, k = (ph - 1) % PH_PER_LAYER;
    if (k <= 6) return true;
    if (k <= 8) return (l & 1) != 0;
    return false;
}

__global__ void __launch_bounds__(512, 2) fwd(Args args) {
    extern __shared__ __attribute__((aligned(16))) unsigned char lds_raw[];
    Ctx F;
    F.lds = (LAS unsigned char*)lds_raw; F.tid = 0; F.lane = 0; F.wave = __builtin_amdgcn_readfirstlane((int)threadIdx.x >> 6);
    F.G = gridDim.x; F.bid = blockIdx.x; F.in = args.in; F.out = args.out; F.ws = args.ws;
    volatile LAS unsigned* MISC = (volatile LAS unsigned*)(F.lds + MISC_OFF);
    LAS int* mtab = (LAS int*)(F.lds + MISC_OFF + 256);
    const int lo = args.ph_lo, hi = args.ph_hi;
    const bool fused = (hi - lo) > 1;
    XcdBarrier bar; bar.bar = (unsigned*)(F.ws + WS_CTL) + CW_BAR; bar.x = 0; bar.st = nullptr;
    if (fused) {
        if (threadIdx.x < 64) MISC[threadIdx.x] = 0u;
        __syncthreads();
        bar = xcd_barrier_post((unsigned*)(F.ws + WS_CTL) + CW_BAR, MISC + 8);
    }
#define IN(k) (lo <= (k) && (k) < hi)
#define SEAM(k) do { if (fused && (k) + 1 < hi) xcd_barrier(bar); else __syncthreads(); } while (0)
#define SITE_CTX int z_ = 0, zv_; asm volatile("" : "+s"(z_)); Ctx C = F; C.ws = F.ws + z_; C.in = F.in + z_; C.out = F.out + z_; \
    C.wave = F.wave + z_; asm volatile("v_mbcnt_lo_u32_b32 %0, -1, 0\n\tv_mbcnt_hi_u32_b32 %0, -1, %0" : "=v"(zv_)); C.lane = zv_; C.tid = C.wave * 64 + C.lane; C.G = (int)gridDim.x + z_; C.bid = (int)blockIdx.x + z_; unsigned char* ws = C.ws; (void)ws
#define P_HB ((bf16_t*)(ws + WS_HB))
#define P_SSQ ((float*)(ws + WS_SSQ))
#define P_PROJ ((bf16_t*)(ws + WS_PROJ))
#define P_MIX ((bf16_t*)(ws + WS_MIX))
#define P_ACT ((bf16_t*)(ws + WS_ACT))
#define P_YB ((bf16_t*)(ws + WS_Y))
#if SITE(0)
    if (IN(0)) { SITE_CTX; p0_prologue(C); SEAM(0); }
#endif

    for (int l = 0; l < DEPTH; ++l) {
        const int base = 1 + l * PH_PER_LAYER, j = l >> 1;
#if SITE(1)
        if (IN(base + 0)) {
            SITE_CTX;
            pg8::DenseSched S; S.o.init(T / 256, DIN / 256, C.G, C.bid); S.Bt = (const char*)(ws + WS_WIN) + (size_t)l * DIN * D * 2; S.tstepB = (size_t)256 * D * 2; S.ssq = P_SSQ; S.rgsrc = nullptr;
            if ((F8_IN >> l) & 1) { S.tstepB = (size_t)256 * D;
                pg8::EpiProj E{P_PROJ, (const LAS float*)(C.lds + RSB_OFF), (bf16_t*)(ws + FS_GATE), 0.03125f};
                pg8::gemm_phase<true>(C.lds, C.tid, (const char*)(ws + WS_HB8), D, D, S, E);
            } else {
                pg8::EpiProj E{P_PROJ, (const LAS float*)(C.lds + RSB_OFF), (bf16_t*)(ws + FS_GATE), 1.0f};
                pg8::gemm_phase<false>(C.lds, C.tid, (const char*)P_HB, 2 * D, 2 * D, S, E);
            }
            SEAM(base + 0);
        }
#endif
#if SITE(2)
        if (IN(base + 1)) {
            SITE_CTX;
            for (int rr = 0; rr < 1 + XREP_CONV; ++rr) conv_phase(C, l);
#if FAST_HG
            __syncthreads();
            for (int rr = 0; rr < 1 + XREP_HGL; ++rr) for (int u = C.bid; u < 256; u += C.G) hg_local(C, l, u);
#else
            ref_hg_prep(C, l);
#endif
#if FAST_S5
            __syncthreads();
            for (int rr = 0; rr < 1 + XREP_S5A; ++rr) for (int u = C.bid; u < 256; u += C.G) s5_endstates(C, l, u);
#else
            if (C.bid < 16 && C.wave == 0) ref_s5_scan(C, l, C.bid);
#endif
            SEAM(base + 1);
        }
#endif
#if SITE(3)
        if (IN(base + 2)) {
            SITE_CTX;
#if FAST_HG
            for (int u = C.bid; u < 1024; u += C.G) hg_carry(C, u);
#else
            if (C.bid < 8 && C.wave == 0) ref_hg_scan(C, C.bid);
#endif
#if FAST_S5
            for (int u = C.G - 1 - C.bid; u < 32; u += C.G) s5_carry(C, l, u);
#endif
            SEAM(base + 2);
        }
#endif
#if SITE(4)
        if (IN(base + 3)) {
            SITE_CTX;
#if FAST_HG
            for (int rr = 0; rr < 1 + XREP_HGF; ++rr) for (int u = C.bid; u < 256; u += C.G) hg_fix(C, l, u);
#else
            ref_finalize_hg(C, l);
#endif
#if FAST_S5
            __syncthreads();
            for (int rr = 0; rr < 1 + XREP_S5C; ++rr) for (int u = C.bid; u < 256; u += C.G) s5_pass<true>(C, l, u);
#else
            ref_finalize_s5(C, l);
#endif
            SEAM(base + 3);
        }
#endif
#if SITE(5)
        if (IN(base + 4)) {
            SITE_CTX;
            pg8::DenseSched S; S.o.init(T / 256, D / 256, C.G, C.bid); S.Bt = (const char*)(ws + WS_WOUT) + (size_t)l * D * D * 2; S.tstepB = (size_t)256 * D * 2; S.ssq = nullptr; S.rgsrc = nullptr;
            pg8::EpiResid<false> E{P_HB, P_SSQ, ((l & 1) || ((F8_FFN >> l) & 1)) ? (unsigned char*)(ws + WS_HB8) : nullptr};
            pg8::gemm_phase<false>(C.lds, C.tid, (const char*)P_MIX, 2 * D, 2 * D, S, E);
            SEAM(base + 4);
        }
#endif
        if ((l & 1) == 0) {
#if SITE(6)
            if (IN(base + 5)) {
                SITE_CTX;
                pg8::DenseSched S; S.o.init(T / 256, 2 * DFF / 256, C.G, C.bid); S.Bt = (const char*)(ws + WS_W13) + (size_t)j * 2 * DFF * D * 2; S.ssq = P_SSQ; S.rgsrc = nullptr;
                if ((F8_FFN >> l) & 1) { S.tstepB = (size_t)256 * D;
                    pg8::EpiSwiglu<true> E{(unsigned char*)P_ACT, (const LAS float*)(C.lds + RSB_OFF)};
                    pg8::gemm_phase<true>(C.lds, C.tid, (const char*)(ws + WS_HB8), D, D, S, E);
                } else { S.tstepB = (size_t)256 * D * 2;
                    pg8::EpiSwiglu<false> E{(unsigned char*)P_ACT, (const LAS float*)(C.lds + RSB_OFF)};
                    pg8::gemm_phase<false>(C.lds, C.tid, (const char*)P_HB, 2 * D, 2 * D, S, E);
                }
                SEAM(base + 5);
            }
#endif
#if SITE(7)
            if (IN(base + 6)) {
                SITE_CTX;
                pg8::DenseSched S; S.o.init(T / 256, D / 256, C.G, C.bid); S.Bt = (const char*)(ws + WS_W2) + (size_t)j * D * DFF * 2; S.ssq = nullptr; S.rgsrc = nullptr;
                if ((F8_FFN >> l) & 1) { S.tstepB = (size_t)256 * DFF;
                    pg8::EpiResid<true> E{P_HB, P_SSQ, ((F8_IN >> (l + 1)) & 1) ? (unsigned char*)(ws + WS_HB8) : nullptr};
                    pg8::gemm_phase<true>(C.lds, C.tid, (const char*)P_ACT, DFF, DFF, S, E);
                } else { S.tstepB = (size_t)256 * DFF * 2;
                    pg8::EpiResid<false> E{P_HB, P_SSQ, ((F8_IN >> (l + 1)) & 1) ? (unsigned char*)(ws + WS_HB8) : nullptr};
                    pg8::gemm_phase<false>(C.lds, C.tid, (const char*)P_ACT, 2 * DFF, 2 * DFF, S, E);
                }
                SEAM(base + 6);
            }
#endif
        } else {
#if SITE(8)
            if (IN(base + 5)) { SITE_CTX; router_phase(C, j); SEAM(base + 5); }
#endif
#if SITE(9)
            if (IN(base + 6)) {
                SITE_CTX;
                moe_tables(C, j, mtab);
                pg8::MoeSched S; S.o.init(__builtin_amdgcn_readfirstlane(mtab[16]), 2 * DFF / 256, C.G, C.bid); S.Bt = (const char*)(ws + WS_MW13) + (size_t)j * 8 * 2 * DFF * D; S.estepB = (size_t)2 * DFF * D; S.tstepB = (size_t)256 * D;
                S.tab = mtab; S.tlist = (const int*)(ws + WS_MOE + MO_TLIST); S.gather = true; S.tgate = nullptr; S.rstd_tok = (const float*)(ws + WS_MOE + MO_RSTD); S.baseL = (const LAS int*)(C.lds + BASE_OFF); S.rsbp = (const LAS unsigned*)(C.lds + RSB_OFF);
                pg8::EpiSwigluMoe E{(unsigned char*)P_ACT, (const float*)(ws + WS_MOE + MO_RSTD), (const LAS int*)(C.lds + RSB_OFF)};
                pg8::gemm_phase<true>(C.lds, C.tid, (const char*)(ws + WS_HB8), D, D, S, E);
                SEAM(base + 6);
            }
#endif
#if SITE(10)
            if (IN(base + 7)) {
                SITE_CTX;
                if (!IN(base + 6)) moe_tables(C, j, mtab);
                const int NP = __builtin_amdgcn_readfirstlane(mtab[16]); const TailGeom tg = tail_geom(NP, C.G);
                {
                pg8::MoeSched S; S.o.init(NP, D / 256, C.G, C.bid); S.o.lim = tg.Lmain; S.Bt = (const char*)(ws + WS_MW2) + (size_t)j * 8 * D * DFF; S.estepB = (size_t)D * DFF; S.tstepB = (size_t)256 * DFF;
                S.tab = mtab; S.tlist = nullptr; S.gather = false; S.rstd_tok = nullptr; S.tgate = (const float*)(ws + WS_MOE + MO_TGATE); S.baseL = (const LAS int*)(C.lds + BASE_OFF); S.rsbp = (const LAS unsigned*)(C.lds + RSB_OFF);
                pg8::EpiMoeOut E{(unsigned char*)P_YB, (const LAS float*)(C.lds + RSB_OFF)};
                pg8::gemm_phase<true>(C.lds, C.tid, (const char*)P_ACT, DFF, DFF, S, E);
                }
                if (tg.R > 0) {
                pg8::MoeTailSched S; S.o.init(NP, D / 256, C.G, C.bid); S.Bt = (const char*)(ws + WS_MW2) + (size_t)j * 8 * D * DFF; S.estepB = (size_t)D * DFF; S.tstepB = (size_t)256 * DFF;
                S.tab = mtab; S.tgate = (const float*)(ws + WS_MOE + MO_TGATE); S.baseL = (const LAS int*)(C.lds + BASE_OFF); S.Lmain = tg.Lmain; S.R = tg.R; S.S = tg.S; S.Kslice = DFF / tg.S;
                pg8::EpiMoeTail E{(bf16_t*)(ws + WS_YT) + (size_t)C.bid * 65536, (const LAS float*)(C.lds + RSB_OFF)};
                int tid2 = C.tid; asm volatile("" : "+v"(tid2));
                pg8::gemm_phase<true>(C.lds, tid2, (const char*)P_ACT, DFF / tg.S, DFF, S, E);
                }
                SEAM(base + 7);
            }
#endif
#if SITE(11)
            if (IN(base + 8)) {
                SITE_CTX;
                if (!IN(base + 6)) moe_tables(C, j, mtab);
                combine_phase(C, j, C.out, l == DEPTH - 1, mtab);
                SEAM(base + 8);
            }
#endif
        }
    }
#undef IN
#undef SEAM
}

extern "C" void kernel_launch(void* const* d_in, const int* in_sizes, int n_in, void* d_out, int out_size, void* d_ws, size_t ws_size, hipStream_t stream) {
    static int grid = 0;
    if (grid == 0) {
        if (n_in != 27 || in_sizes[0] != T * D || out_size != T * D || ws_size < WS_END) { fprintf(stderr, "kernel_launch: unexpected problem shape / workspace (%d inputs, ws %zu)\n", n_in, ws_size); grid = -1; return; }
        int dev = 0, cus = 0, per_cu = 0;
        if (hipGetDevice(&dev) != hipSuccess || hipDeviceGetAttribute(&cus, hipDeviceAttributeMultiprocessorCount, dev) != hipSuccess) { grid = -1; return; }
        if (hipFuncSetAttribute((const void*)fwd, hipFuncAttributeMaxDynamicSharedMemorySize, LDS_BYTES) != hipSuccess) { fprintf(stderr, "kernel_launch: hipFuncSetAttribute failed\n"); grid = -1; return; }
        if (hipOccupancyMaxActiveBlocksPerMultiprocessor(&per_cu, (const void*)fwd, 512, LDS_BYTES) != hipSuccess || per_cu < 1) fprintf(stderr, "kernel_launch: occupancy query reports %d\n", per_cu);
        (void)hipGetLastError();
        grid = cus;
    }
    if (grid < 0) return;
    if (hipMemsetAsync((char*)d_ws + WS_CTL + CW_BAR * 4, 0, XCD_BAR_WORDS * 4, stream) != hipSuccess) return;
    Args a{};
    for (int i = 0; i < 27; ++i) a.in[i] = (const float*)d_in[i];
    a.out = (float*)d_out; a.ws = (unsigned char*)d_ws;
#if MK_FUSED
    a.ph_lo = 0; a.ph_hi = N_PHASES;
    hipLaunchKernelGGL(fwd, dim3(grid), dim3(512), LDS_BYTES, stream, a);
#else
#ifndef MAXPH
#define MAXPH N_PHASES
#endif
    for (int ph = 0; ph < MAXPH; ++ph) {
        if (!phase_exists(ph)) continue;
        a.ph_lo = ph; a.ph_hi = ph + 1;
        hipLaunchKernelGGL(fwd, dim3(grid), dim3(512), LDS_BYTES, stream, a);
#ifdef REP_PH
        if (ph == REP_PH) for (int rr = 0; rr < REP_N; ++rr) hipLaunchKernelGGL(fwd, dim3(grid), dim3(512), LDS_BYTES, stream, a);
#endif
    }
#endif
}
```

```cpp
#include <hip/hip_runtime.h>
#include <cstdio>
#include <cstdint>

#ifndef MK_FUSED
#define MK_FUSED 1
#endif
#ifndef XREP_HGL
#define XREP_HGL 0
#endif
#ifndef XREP_S5A
#define XREP_S5A 0
#endif
#ifndef XREP_CONV
#define XREP_CONV 0
#endif
#ifndef XREP_HGF
#define XREP_HGF 0
#endif
#ifndef XREP_S5C
#define XREP_S5C 0
#endif
#ifndef FAST_HG
#define FAST_HG 1
#endif
#ifndef FAST_S5
#define FAST_S5 1
#endif

#ifndef PH_MASK
#define PH_MASK 0xFFFF
#endif
#define SITE(n) ((PH_MASK >> (n)) & 1)
#define LAS __attribute__((address_space(3)))
#define GAS __attribute__((address_space(1)))
typedef unsigned short bf16_t;
typedef short bf16x8 __attribute__((ext_vector_type(8)));
typedef float f32x4 __attribute__((ext_vector_type(4)));
typedef float f32x2 __attribute__((ext_vector_type(2)));
typedef unsigned u32x4 __attribute__((ext_vector_type(4)));
typedef unsigned u32x2 __attribute__((ext_vector_type(2)));
typedef int i32x4 __attribute__((ext_vector_type(4)));
typedef int i32x8 __attribute__((ext_vector_type(8)));

constexpr int T = 16384, D = 1024, DIN = 3072, DFF = 3584, NE = 8, DEPTH = 4;
constexpr int S5W = 256, S5G = 16, S5P = 64, CW = 256, HGW = 512, HGH = 4, HGD = 128;
constexpr int F8_FFN = 0x4;
constexpr int F8_IN = 0xC;
constexpr int ECAP = 16384;
constexpr int MAXP = 136;
constexpr float NORM_EPS = 1e-6f;
constexpr int PC_U = 0, PC_CB = 256, PC_CC = 512, PC_CV = 768, PC_Q = 1024, PC_F = 1536, PC_I = 2048, PC_G = 2560;

constexpr size_t MiB = 1u << 20;
constexpr size_t WS_CTL = 0, CTL_BYTES = 1 * MiB;
constexpr size_t WS_WIN = 1 * MiB;
constexpr size_t WS_WOUT = 25 * MiB;
constexpr size_t WS_W13 = 33 * MiB;
constexpr size_t WS_W2 = 61 * MiB;
constexpr size_t WS_MW13 = 75 * MiB;
constexpr size_t WS_HB8 = 187 * MiB;
constexpr size_t WS_MW2 = 299 * MiB;
constexpr size_t WS_GLU = 411 * MiB;
constexpr size_t WS_TAB = 412 * MiB;
constexpr size_t WS_HB = 413 * MiB;
constexpr size_t WS_SSQ = 445 * MiB;
constexpr size_t WS_MOE = 446 * MiB;
constexpr size_t WS_Y = 448 * MiB;
constexpr size_t WS_X = 516 * MiB;
constexpr size_t WS_PROJ = WS_X, WS_MIX = WS_X + 96 * MiB, WS_ACT = WS_X;
constexpr size_t WS_RL = WS_X;
constexpr size_t WS_SCR = 754 * MiB;
constexpr size_t WS_YT = WS_SCR;
constexpr size_t WS_VT = WS_SCR + 32 * MiB;
constexpr size_t WS_END = 896 * MiB;
constexpr int TB_LBC = 0;
constexpr int TB_LAMB = 2048;
constexpr int TB_BBAR = TB_LAMB + 4 * 16 * 64 * 2;
constexpr int TB_RG = TB_BBAR + 4 * 16 * 64 * 16 * 2;
constexpr int TB_END = TB_RG + 2 * 8 * 1024;
static_assert((size_t)TB_END * 4 <= MiB, "tables");
constexpr size_t MO_TOKE = 0;
constexpr size_t MO_TOKP = 128 * 1024;
constexpr size_t MO_RSTD = 256 * 1024;
constexpr size_t MO_TCNT = 384 * 1024;
constexpr size_t MO_TLIST = 512 * 1024;
constexpr size_t MO_TGATE = 1024 * 1024;
constexpr size_t SC_F = WS_SCR, SC_K = WS_SCR + 32 * MiB, SC_Q = WS_SCR + 64 * MiB, SC_O = WS_SCR + 96 * MiB;
constexpr size_t FS = WS_X + 128 * MiB;
constexpr size_t FS_OLOC = FS;
constexpr size_t FS_ASEG = FS + 16 * MiB;
constexpr size_t FS_SEND = FS + 32 * MiB;
constexpr size_t FS_SST = FS + 48 * MiB;
constexpr size_t FS_DSEG = FS + 56 * MiB;
constexpr size_t FS_XE = FS + 57 * MiB;
constexpr size_t FS_XIN = FS + 59 * MiB;
constexpr size_t FS_GATE = FS + 61 * MiB;
constexpr size_t WS_BB = WS_GLU + 512 * 1024;
constexpr size_t WS_CM = WS_GLU + 768 * 1024;
constexpr size_t SC_Y1 = WS_Y;
static_assert(SC_O + (size_t)T * 512 * 4 <= WS_END, "ws map");
constexpr int CW_BAR = 4096;
constexpr int CW_CNT = 16384;

constexpr int RING_BYTES = 131072;
constexpr int LDS_BYTES = 163840;
constexpr int MISC_OFF = LDS_BYTES - 4096;
constexpr int RSB_OFF = RING_BYTES;
constexpr int RSB_UNITS = (MISC_OFF - RSB_OFF) / 1024;
constexpr int BASE_OFF = RING_BYTES + 20480;

__device__ __forceinline__ unsigned f2bf(float f) { unsigned u = __builtin_bit_cast(unsigned, f); return (u + 0x7fffu + ((u >> 16) & 1u)) >> 16; }
__device__ __forceinline__ unsigned pk2(float lo, float hi) { unsigned r; asm("v_cvt_pk_bf16_f32 %0, %1, %2" : "=v"(r) : "v"(lo), "v"(hi)); return r; }
__device__ __forceinline__ unsigned pk4_f8(float a, float b, float c, float d) {
    a = __builtin_amdgcn_fmed3f(a, -448.f, 448.f); b = __builtin_amdgcn_fmed3f(b, -448.f, 448.f); c = __builtin_amdgcn_fmed3f(c, -448.f, 448.f); d = __builtin_amdgcn_fmed3f(d, -448.f, 448.f);
    int w = 0; w = __builtin_amdgcn_cvt_pk_fp8_f32(a, b, w, false); w = __builtin_amdgcn_cvt_pk_fp8_f32(c, d, w, true); return (unsigned)w; }
__device__ __forceinline__ float bf2f(unsigned short b) { return __builtin_bit_cast(float, (unsigned)b << 16); }
__device__ __forceinline__ float bflo(unsigned w) { return __builtin_bit_cast(float, w << 16); }
__device__ __forceinline__ float bfhi(unsigned w) { return __builtin_bit_cast(float, w & 0xffff0000u); }
__device__ __forceinline__ float shx(float v, int m, int lane) { return __builtin_bit_cast(float, __builtin_amdgcn_ds_bpermute((lane ^ m) << 2, __builtin_bit_cast(int, v))); }
__device__ __forceinline__ float wave_sum(float v, int lane) {
#pragma unroll
    for (int o = 1; o < 64; o <<= 1) v += shx(v, o, lane);
    return v;
}
__device__ __forceinline__ float sigmoidf_(float x) { return __builtin_amdgcn_rcpf(1.f + __expf(-x)); }
__device__ __forceinline__ float siluf_(float x) { return x * __builtin_amdgcn_rcpf(1.f + __expf(-x)); }
__device__ __forceinline__ float gelu_tanh(float x) { const float u2 = 1.5957691216057308f * (x + 0.044715f * x * x * x); return x * __builtin_amdgcn_rcpf(1.f + __expf(-u2)); }
__device__ __forceinline__ float rstd_from_ssq(const float* ssq, int row) {
    const f32x4* p = (const f32x4*)(ssq + (size_t)row * 16);
    const f32x4 a = p[0], b = p[1], c = p[2], d = p[3];
    const float s = ((a.x + a.y) + (a.z + a.w)) + ((b.x + b.y) + (b.z + b.w)) + ((c.x + c.y) + (c.z + c.w)) + ((d.x + d.y) + (d.z + d.w));
    return __builtin_amdgcn_rsqf(s * (1.f / D) + NORM_EPS);
}

__device__ __forceinline__ int slot_src(const LAS int* baseL, int e, int pos);
namespace pg8 {
constexpr int BM = 256, BK = 64, HALF = 128, HTB = HALF * BK * 2, STAGE_BYTES = 8 * HTB, NXCD = 8, WGM = 4;
__host__ __device__ __forceinline__ int lds_byte(int r, int c) { const int st = (r >> 4) * 2 + (c >> 5), rr = r & 15, cc = c & 31, ob = rr * 64 + cc * 2; return st * 1024 + (ob ^ (((ob >> 9) & 1) << 5)); }
__host__ __device__ __forceinline__ void stage_rc(int b, int& R, int& C) { const int st = b / 1024, sb = b % 1024, swz = sb ^ (((sb >> 9) & 1) << 5); R = (st >> 1) * 16 + swz / 64; C = (st & 1) * 32 + (swz % 64) / 2; }
__host__ __device__ __forceinline__ int perm32(int rho) { const int n = rho >> 4, i = rho & 15; return 8 * (i >> 2) + 4 * n + (i & 3); }

struct Unit { int pm, pn, e, lp, ord, ks; };

struct TileOrder {
    int nM, nN, nwg, G, c, lim;
    __device__ __forceinline__ void init(int nM_, int nN_, int G_, int c_) { nM = nM_; nN = nN_; nwg = nM * nN; G = G_; c = c_; lim = nwg; }
    __device__ __forceinline__ bool map(int i, int& pm, int& pn) const { const long L = (long)i * G + c; if (L >= lim) return false; return mapL(L, pm, pn); }
    __device__ __forceinline__ bool mapL(long L, int& pm, int& pn) const {
        if (L >= nwg) return false;
        int wgid = (int)L; { const int q = nwg / NXCD, r = nwg % NXCD, xcd = wgid % NXCD, off = wgid / NXCD; wgid = (xcd < r ? xcd * (q + 1) : r * (q + 1) + (xcd - r) * q) + off; }
        const int nig = WGM * nN, gid = wgid / nig, fm = gid * WGM, gsz = (nM - fm) < WGM ? (nM - fm) : WGM;
        pm = fm + ((wgid % nig) % gsz); pn = (wgid % nig) / gsz; return true;
    }
};

__device__ __forceinline__ unsigned cvt_pk_bf16(float lo, float hi) { unsigned r; asm("v_cvt_pk_bf16_f32 %0, %1, %2" : "=v"(r) : "v"(lo), "v"(hi)); return r; }

template <bool F8, class Epi, class Sched>
__device__ __forceinline__ void gemm_phase(LAS unsigned char* lds, const int tid, const char* Abase, const int Kb, const int ldb, const Sched& S, const Epi& E) {
    const int wid = __builtin_amdgcn_readfirstlane(tid >> 6), lane = tid & 63, wr = wid >> 2, wc = wid & 3, fr = lane & 15, fq = lane >> 4;
    const int nt = Kb / (BK * 2);
    unsigned voffB[2];
#pragma unroll
    for (int i = 0; i < 2; ++i) { int R, C; stage_rc(tid * 16 + i * 8192, R, C); const int Rb = Epi::PERM ? ((R & ~31) + perm32(R & 31)) : R; voffB[i] = (unsigned)(Rb * ldb + C * 2); }
    const size_t kstep = (size_t)(BK * 2);
    const size_t hstep = (size_t)HALF * ldb;
    int one8 = 0x7f7f7f7f; asm volatile("" : "+v"(one8));
    const unsigned ldsw = (unsigned)wid * 1024u;
    const int aoff = lds_byte(wr * 64 + fr, fq * 8), boff = lds_byte(wc * 32 + fr, fq * 8);
#define PG8_SA(b, h) (((b) * 2 + (h)) * HTB)
#define PG8_SB(b, h) ((4 + (b) * 2 + (h)) * HTB)
#define PG8_STAGE(bufoff, gbase, voff) do { _Pragma("unroll") for (int _i = 0; _i < 2; ++_i) \
        __builtin_amdgcn_global_load_lds((const unsigned*)((const char*)(gbase) + (voff)[_i]), (LAS unsigned*)(lds + (bufoff) + ldsw + _i * 8192), 16, 0, 0); } while (0)
#define PG8_STAGEA(bufoff, kb, o0, o1) do { \
        __builtin_amdgcn_global_load_lds((const unsigned*)(Abase + (kb) + (o0)), (LAS unsigned*)(lds + (bufoff) + ldsw), 16, 0, 0); \
        __builtin_amdgcn_global_load_lds((const unsigned*)(Abase + (kb) + (o1)), (LAS unsigned*)(lds + (bufoff) + ldsw + 8192), 16, 0, 0); } while (0)
#define PG8_LDA(dst, b, h) do { _Pragma("unroll") for (int m = 0; m < 4; ++m) _Pragma("unroll") for (int k = 0; k < 2; ++k) dst[m][k] = *(const LAS bf16x8*)(lds + PG8_SA(b, h) + aoff + m * 2048 + k * 1024); } while (0)
#define PG8_LDB(dst, b, h) do { _Pragma("unroll") for (int n = 0; n < 2; ++n) _Pragma("unroll") for (int k = 0; k < 2; ++k) dst[n][k] = *(const LAS bf16x8*)(lds + PG8_SB(b, h) + boff + n * 2048 + k * 1024); } while (0)
#define PG8_CAT8(x) __builtin_shufflevector(__builtin_bit_cast(i32x4, (x)[0]), __builtin_bit_cast(i32x4, (x)[1]), 0, 1, 2, 3, 4, 5, 6, 7)
#define PG8_MMA(ai, bj, At, Bt) do { __builtin_amdgcn_s_setprio(1); \
        if constexpr (F8) { _Pragma("unroll") for (int m = 0; m < 4; ++m) _Pragma("unroll") for (int n = 0; n < 2; ++n) \
            acc[ai][bj][m][n] = __builtin_amdgcn_mfma_scale_f32_16x16x128_f8f6f4(PG8_CAT8(Bt[n]), PG8_CAT8(At[m]), acc[ai][bj][m][n], 0, 0, 0, one8, 0, one8); } \
        else { _Pragma("unroll") for (int m = 0; m < 4; ++m) _Pragma("unroll") for (int n = 0; n < 2; ++n) _Pragma("unroll") for (int k = 0; k < 2; ++k) \
            acc[ai][bj][m][n] = __builtin_amdgcn_mfma_f32_16x16x32_bf16(Bt[n][k], At[m][k], acc[ai][bj][m][n], 0, 0, 0); } \
        __builtin_amdgcn_s_setprio(0); } while (0)
#define PG8_WAIT_V(n) asm volatile("s_waitcnt vmcnt(" #n ")" ::: "memory")
#define PG8_WAIT_L(n) asm volatile("s_waitcnt lgkmcnt(" #n ")" ::: "memory")
#define PG8_BAR __builtin_amdgcn_s_barrier()
#define PG8_SCHED __builtin_amdgcn_sched_barrier(0)
    Unit cur, nxt; int ui = 0;
    const bool any = S.next(0, cur);
    const char* cB = any ? S.b_base(cur) : nullptr;
    unsigned c00 = 0, c01 = 0, c10 = 0, c11 = 0, n00, n01, n10, n11;
    const bool aearly = any && S.a_early();
    if (any) { PG8_STAGE(PG8_SB(0, 0), cB, voffB); PG8_STAGE(PG8_SB(0, 1), cB + hstep, voffB);
        if (aearly) { S.a_off(cur, tid, ldb, c00, c01, c10, c11); PG8_STAGEA(PG8_SA(0, 0), 0, c00, c01); PG8_STAGEA(PG8_SA(0, 1), 0, c10, c11); } }
    S.stage((LAS unsigned*)(lds + RSB_OFF), tid);
    __syncthreads();
    if (!any) return;
    f32x4 acc[2][2][4][2];
    if constexpr (Epi::PRELOAD) E.preload(acc, cur, wr, wc, fr, fq);
    else {
#pragma unroll
    for (int a = 0; a < 2; ++a)
#pragma unroll
        for (int b = 0; b < 2; ++b)
#pragma unroll
            for (int m = 0; m < 4; ++m)
#pragma unroll
                for (int n = 0; n < 2; ++n) acc[a][b][m][n] = (f32x4){0.f, 0.f, 0.f, 0.f};
    }
    bf16x8 At[4][2], B0[2][2], B1[2][2];
    if (!aearly) { S.a_off(cur, tid, ldb, c00, c01, c10, c11); PG8_STAGEA(PG8_SA(0, 0), 0, c00, c01); PG8_STAGEA(PG8_SA(0, 1), 0, c10, c11); }
    if (wr == 1) PG8_BAR;
    PG8_WAIT_V(2); PG8_BAR;
    PG8_STAGE(PG8_SB(1, 0), cB + kstep, voffB); PG8_STAGEA(PG8_SA(1, 0), kstep, c00, c01); PG8_STAGE(PG8_SB(1, 1), cB + hstep + kstep, voffB);
    PG8_WAIT_V(6); PG8_BAR;
    for (;;) {
        const bool has_next = S.next(ui + 1, nxt);
        const char* nB = cB;
        n00 = c00; n01 = c01; n10 = c10; n11 = c11;
        if (has_next) { nB = S.b_base(nxt); S.a_off(nxt, tid, ldb, n00, n01, n10, n11); }
#define PG8_PAIR(FIN) do { \
            if constexpr (F8) asm volatile("" : "+v"(c00), "+v"(c01), "+v"(c10), "+v"(c11), "+v"(voffB[0]), "+v"(voffB[1]));     \
            const bool last = (t == nt - 2); \
            const size_t kb1 = (size_t)(t + 1) * kstep; \
            const size_t kb2 = last ? 0 : (size_t)(t + 2) * kstep; \
            const char* b2 = last ? nB : cB + (size_t)(t + 2) * kstep; \
            const char* b3 = b2 + kstep; \
              \
            PG8_LDB(B0, 0, 0); PG8_LDB(B1, 0, 1); PG8_SCHED; PG8_LDA(At, 0, 0); PG8_STAGEA(PG8_SA(1, 1), kb1, c10, c11); \
            if (last) { c00 = n00; c01 = n01; c10 = n10; c11 = n11; }     \
            if (FIN) PG8_WAIT_V(0); else PG8_WAIT_V(8); PG8_WAIT_L(0); PG8_BAR; PG8_MMA(0, 0, At, B0); PG8_MMA(0, 1, At, B1); PG8_BAR; PG8_SCHED; \
              \
            PG8_LDA(At, 0, 1); if (!(FIN)) { PG8_STAGE(PG8_SB(0, 0), b2, voffB); PG8_STAGE(PG8_SB(0, 1), b2 + hstep, voffB); PG8_STAGEA(PG8_SA(0, 0), kb2, c00, c01); } \
            if (FIN) PG8_WAIT_V(0); else PG8_WAIT_V(8); PG8_WAIT_L(0); PG8_BAR; PG8_MMA(1, 0, At, B0); PG8_MMA(1, 1, At, B1); PG8_BAR; PG8_SCHED; \
              \
            PG8_LDB(B0, 1, 0); PG8_LDB(B1, 1, 1); PG8_SCHED; PG8_LDA(At, 1, 0); if (!(FIN)) { PG8_STAGEA(PG8_SA(0, 1), kb2, c10, c11); } \
            if (FIN) PG8_WAIT_V(0); else PG8_WAIT_V(8); PG8_WAIT_L(0); PG8_BAR; PG8_MMA(0, 0, At, B0); PG8_MMA(0, 1, At, B1); PG8_BAR; PG8_SCHED; \
              \
            PG8_LDA(At, 1, 1); if (!(FIN)) { PG8_STAGE(PG8_SB(1, 0), b3, voffB); PG8_STAGE(PG8_SB(1, 1), b3 + hstep, voffB); PG8_STAGEA(PG8_SA(1, 0), kb2 + kstep, c00, c01); } \
            if (FIN) PG8_WAIT_V(0); else PG8_WAIT_V(8); PG8_WAIT_L(0); PG8_BAR; PG8_MMA(1, 0, At, B0); PG8_MMA(1, 1, At, B1); PG8_BAR; PG8_SCHED; \
        } while (0)
        {
            const int nt_main = (has_next || F8) ? nt : nt - 2;
            int t = 0;
            _Pragma("nounroll") for (; t < nt_main; t += 2) PG8_PAIR(false);
            if constexpr (!F8) { if (!has_next) PG8_PAIR(true); }
        }
#undef PG8_PAIR
        if (wr == 0) PG8_BAR;
        { int l2 = lane; asm volatile("" : "+v"(l2));
          E(acc, cur, wr, wc, l2 & 15, l2 >> 4); }
        if (!has_next) break;
        if constexpr (Epi::PRELOAD) E.preload(acc, nxt, wr, wc, fr, fq);
        else {
#pragma unroll
        for (int a = 0; a < 2; ++a)
#pragma unroll
            for (int b = 0; b < 2; ++b)
#pragma unroll
                for (int m = 0; m < 4; ++m)
#pragma unroll
                    for (int n = 0; n < 2; ++n) acc[a][b][m][n] = (f32x4){0.f, 0.f, 0.f, 0.f};
        }
        cur = nxt; cB = nB; ++ui;
        if (wr == 1) PG8_BAR;
    }
    PG8_WAIT_V(0);
    PG8_BAR;
#undef PG8_SA
#undef PG8_SB
#undef PG8_STAGE
#undef PG8_STAGEA
#undef PG8_LDA
#undef PG8_LDB
#undef PG8_MMA
#undef PG8_CAT8
#undef PG8_WAIT_V
#undef PG8_WAIT_L
#undef PG8_BAR
#undef PG8_SCHED
}

struct DenseSched {
    TileOrder o; const char* Bt; size_t tstepB; const float* ssq; const float* rgsrc;
    __device__ __forceinline__ bool next(int i, Unit& u) const { u.e = 0; u.lp = 0; u.ord = i; return o.map(i, u.pm, u.pn); }
    __device__ __forceinline__ bool a_early() const { return ssq != nullptr; }
    __device__ __forceinline__ void stage(LAS unsigned* rsb, int tid) const {
        if (rgsrc) {
#pragma unroll
            for (int i = 0; i < 3; ++i) { Unit u; if (next(i, u)) { const int idx = tid * 4, e = idx >> 8, c = idx & 255;
                *(LAS f32x4*)((LAS float*)rsb + i * 2048 + idx) = *(const f32x4*)(rgsrc + e * 1024 + u.pn * 256 + c); } }
        }
        if (!ssq) return;
        float v[4]; bool ok[4];
#pragma unroll
        for (int q = 0; q < 4; ++q) { Unit u; const int i = 2 * q + (tid >> 8); ok[q] = next(i, u); v[q] = rstd_from_ssq(ssq, (ok[q] ? u.pm : 0) * 256 + (tid & 255)); }
#pragma unroll
        for (int q = 0; q < 4; ++q) if (ok[q]) rsb[(2 * q + (tid >> 8)) * 256 + (tid & 255)] = __builtin_bit_cast(unsigned, v[q]);
    }
    __device__ __forceinline__ const char* b_base(const Unit& u) const { return Bt + (size_t)u.pn * tstepB; }
    __device__ __forceinline__ void a_off(const Unit& u, int tid, int ldb, unsigned& o00, unsigned& o01, unsigned& o10, unsigned& o11) const {
        int RA[2], CA[2]; stage_rc(tid * 16, RA[0], CA[0]); stage_rc(tid * 16 + 8192, RA[1], CA[1]);
        const int r0 = u.pm * 256;
        o00 = (unsigned)((r0 + RA[0]) * ldb + CA[0] * 2); o01 = (unsigned)((r0 + RA[1]) * ldb + CA[1] * 2);
        o10 = (unsigned)((r0 + 128 + RA[0]) * ldb + CA[0] * 2); o11 = (unsigned)((r0 + 128 + RA[1]) * ldb + CA[1] * 2);
    }
};
struct MoeSched {
    TileOrder o; const char* Bt; size_t estepB, tstepB; const LAS int* tab; const int* tlist; bool gather; const LAS unsigned* rsbp;
    const float* tgate; const LAS int* baseL; const float* rstd_tok;
    __device__ __forceinline__ bool a_early() const { return !gather; }
    __device__ __forceinline__ void stage(LAS unsigned* rsb, int tid) const {
        unsigned v[8]; bool ok[8], in[8];
#pragma unroll
        for (int q = 0; q < 8; ++q) { Unit u; const int i = 2 * q + (tid >> 8); ok[q] = next(i, u);
            const int e = ok[q] ? u.e : 0, cnt = tab[e], sl = (ok[q] ? u.lp : 0) * 256 + (tid & 255); in[q] = ok[q] && sl < cnt;
            const int src = in[q] ? slot_src(baseL, e, sl) : 0;
            v[q] = gather ? (unsigned)tlist[src] : __builtin_bit_cast(unsigned, tgate[src]); }
        if (gather) {
#pragma unroll
            for (int q = 0; q < 8; ++q) v[q] = (v[q] & 0xffffu) | (f2bf(rstd_tok[v[q] & 0x3fffu]) << 16);
        }
#pragma unroll
        for (int q = 0; q < 8; ++q) if (ok[q]) rsb[(2 * q + (tid >> 8)) * 256 + (tid & 255)] = in[q] ? v[q] : (gather ? 0x0000ffffu : 0u);
    }
    __device__ __forceinline__ bool next(int i, Unit& u) const {
        u.ord = i;
        if (!o.map(i, u.pm, u.pn)) return false;
        int e = 0;
#pragma unroll
        for (int j = 1; j < 8; ++j) e += (u.pm >= __builtin_amdgcn_readfirstlane(tab[8 + j])) ? 1 : 0;
        u.e = e; u.lp = u.pm - __builtin_amdgcn_readfirstlane(tab[8 + e]); return true;
    }
    __device__ __forceinline__ const char* b_base(const Unit& u) const { return Bt + (size_t)u.e * estepB + (size_t)u.pn * tstepB; }
    __device__ __forceinline__ void a_off(const Unit& u, int tid, int ldb, unsigned& o00, unsigned& o01, unsigned& o10, unsigned& o11) const {
        int RA[2], CA[2]; stage_rc(tid * 16, RA[0], CA[0]); stage_rc(tid * 16 + 8192, RA[1], CA[1]);
        if (gather) {
            const LAS int* tk = (const LAS int*)rsbp + u.ord * 256;
            int t00 = tk[RA[0]] & 0xffff, t01 = tk[RA[1]] & 0xffff, t10 = tk[128 + RA[0]] & 0xffff, t11 = tk[128 + RA[1]] & 0xffff;
            t00 = t00 == 0xffff ? 0 : t00; t01 = t01 == 0xffff ? 0 : t01; t10 = t10 == 0xffff ? 0 : t10; t11 = t11 == 0xffff ? 0 : t11;
            o00 = (unsigned)(t00 * ldb + CA[0] * 2); o01 = (unsigned)(t01 * ldb + CA[1] * 2); o10 = (unsigned)(t10 * ldb + CA[0] * 2); o11 = (unsigned)(t11 * ldb + CA[1] * 2);
        } else {
            const int r0 = u.pm * 256;
            o00 = (unsigned)((r0 + RA[0]) * ldb + CA[0] * 2); o01 = (unsigned)((r0 + RA[1]) * ldb + CA[1] * 2);
            o10 = (unsigned)((r0 + 128 + RA[0]) * ldb + CA[0] * 2); o11 = (unsigned)((r0 + 128 + RA[1]) * ldb + CA[1] * 2);
        }
    }
};

struct MoeTailSched {
    TileOrder o; const char* Bt; size_t estepB, tstepB; const LAS int* tab; const float* tgate; const LAS int* baseL; int Lmain, R, S, Kslice;
    __device__ __forceinline__ bool next(int i, Unit& u) const {
        u.ord = i;
        if (i != 0 || o.c >= R * S) return false;
        if (!o.mapL(Lmain + o.c / S, u.pm, u.pn)) return false;
        int e = 0;
#pragma unroll
        for (int j = 1; j < 8; ++j) e += (u.pm >= __builtin_amdgcn_readfirstlane(tab[8 + j])) ? 1 : 0;
        u.e = e; u.lp = u.pm - __builtin_amdgcn_readfirstlane(tab[8 + e]); u.ks = o.c % S; return true;
    }
    __device__ __forceinline__ bool a_early() const { return true; }
    __device__ __forceinline__ void stage(LAS unsigned* rsb, int tid) const {
        Unit u; if (!next(0, u)) return;
        if (tid < 256) { const int cnt = __builtin_amdgcn_readfirstlane(tab[u.e]), sl = u.lp * 256 + tid; rsb[tid] = (sl < cnt) ? __builtin_bit_cast(unsigned, tgate[slot_src(baseL, u.e, sl)]) : 0u; }
    }
    __device__ __forceinline__ const char* b_base(const Unit& u) const { return Bt + (size_t)u.e * estepB + (size_t)u.pn * tstepB + (size_t)u.ks * Kslice; }
    __device__ __forceinline__ void a_off(const Unit& u, int tid, int ldb, unsigned& o00, unsigned& o01, unsigned& o10, unsigned& o11) const {
        int RA[2], CA[2]; stage_rc(tid * 16, RA[0], CA[0]); stage_rc(tid * 16 + 8192, RA[1], CA[1]);
        const int r0 = u.pm * 256, kb = u.ks * Kslice;
        o00 = (unsigned)((r0 + RA[0]) * ldb + CA[0] * 2 + kb); o01 = (unsigned)((r0 + RA[1]) * ldb + CA[1] * 2 + kb);
        o10 = (unsigned)((r0 + 128 + RA[0]) * ldb + CA[0] * 2 + kb); o11 = (unsigned)((r0 + 128 + RA[1]) * ldb + CA[1] * 2 + kb);
    }
};

__device__ __forceinline__ u32x4 pair16(u32x2 a, u32x2 b) {
    auto rx = __builtin_amdgcn_permlane16_swap(a.x, b.x, false, false); auto ry = __builtin_amdgcn_permlane16_swap(a.y, b.y, false, false);
    return (u32x4){(unsigned)rx[0], (unsigned)ry[0], (unsigned)rx[1], (unsigned)ry[1]};
}
__device__ __forceinline__ void swiglu8f(const f32x4 a0, const f32x4 a1, const f32x4 b0, const f32x4 b1, const float rs, const float osc, f32x4& o0, f32x4& o1) {
    const float nl = -1.4426950408889634f * rs, r2 = rs * rs * osc;
    const f32x4 x0 = a0 * nl, x1 = a1 * nl;
    f32x4 e0, e1;
    e0.x = __builtin_amdgcn_exp2f(x0.x); e0.y = __builtin_amdgcn_exp2f(x0.y); e0.z = __builtin_amdgcn_exp2f(x0.z); e0.w = __builtin_amdgcn_exp2f(x0.w);
    e1.x = __builtin_amdgcn_exp2f(x1.x); e1.y = __builtin_amdgcn_exp2f(x1.y); e1.z = __builtin_amdgcn_exp2f(x1.z); e1.w = __builtin_amdgcn_exp2f(x1.w);
    const f32x4 d0 = e0 + 1.0f, d1 = e1 + 1.0f;
    f32x4 s0, s1;
    s0.x = __builtin_amdgcn_rcpf(d0.x); s0.y = __builtin_amdgcn_rcpf(d0.y); s0.z = __builtin_amdgcn_rcpf(d0.z); s0.w = __builtin_amdgcn_rcpf(d0.w);
    s1.x = __builtin_amdgcn_rcpf(d1.x); s1.y = __builtin_amdgcn_rcpf(d1.y); s1.z = __builtin_amdgcn_rcpf(d1.z); s1.w = __builtin_amdgcn_rcpf(d1.w);
    o0 = ((a0 * b0) * r2) * s0; o1 = ((a1 * b1) * r2) * s1;
}
__device__ __forceinline__ void swiglu8(const f32x4 a0, const f32x4 a1, const f32x4 b0, const f32x4 b1, const float rs, u32x4& w) {
    f32x4 o0, o1; swiglu8f(a0, a1, b0, b1, rs, 1.0f, o0, o1);
    w.x = cvt_pk_bf16(o0.x, o0.y); w.y = cvt_pk_bf16(o0.z, o0.w); w.z = cvt_pk_bf16(o1.x, o1.y); w.w = cvt_pk_bf16(o1.z, o1.w);
}
struct EpiProj {
    static constexpr bool PERM = true, PRELOAD = false;
    bf16_t* O; const LAS float* rsb; bf16_t* GT; float sc;
    __device__ __forceinline__ void operator()(const f32x4 (&acc)[2][2][4][2], const Unit& u, int wr, int wc, int fr, int fq) const {
        const int row0 = u.pm * BM + wr * 64 + fr, col0 = u.pn * BM + wc * 32 + 8 * fq;
        float rsv[2][4];
#pragma unroll
        for (int ai = 0; ai < 2; ++ai)
#pragma unroll
            for (int m = 0; m < 4; ++m) rsv[ai][m] = rsb[u.ord * 256 + wr * 64 + fr + ai * HALF + m * 16] * sc;
#pragma unroll
        for (int ai = 0; ai < 2; ++ai)
#pragma unroll
            for (int m = 0; m < 4; ++m) {
                const int r = row0 + ai * HALF + m * 16; const float rs = rsv[ai][m];
                bf16_t* rowp = O + (size_t)r * DIN + col0;
                if (u.pn >= PC_G / 256) {
#pragma unroll
                    for (int bj = 0; bj < 2; ++bj) { f32x4 v0 = acc[ai][bj][m][0] * rs, v1 = acc[ai][bj][m][1] * rs;
                        { const f32x4 x0 = v0 * -1.4426950408889634f, x1 = v1 * -1.4426950408889634f; f32x4 e0, e1, s0, s1;
                          e0.x = __builtin_amdgcn_exp2f(x0.x); e0.y = __builtin_amdgcn_exp2f(x0.y); e0.z = __builtin_amdgcn_exp2f(x0.z); e0.w = __builtin_amdgcn_exp2f(x0.w);
                          e1.x = __builtin_amdgcn_exp2f(x1.x); e1.y = __builtin_amdgcn_exp2f(x1.y); e1.z = __builtin_amdgcn_exp2f(x1.z); e1.w = __builtin_amdgcn_exp2f(x1.w);
                          const f32x4 d0 = e0 + 1.0f, d1 = e1 + 1.0f;
                          s0.x = __builtin_amdgcn_rcpf(d0.x); s0.y = __builtin_amdgcn_rcpf(d0.y); s0.z = __builtin_amdgcn_rcpf(d0.z); s0.w = __builtin_amdgcn_rcpf(d0.w);
                          s1.x = __builtin_amdgcn_rcpf(d1.x); s1.y = __builtin_amdgcn_rcpf(d1.y); s1.z = __builtin_amdgcn_rcpf(d1.z); s1.w = __builtin_amdgcn_rcpf(d1.w);
                          v0 = v0 * s0; v1 = v1 * s1; }
                        const int c = col0 - PC_G + bj * HALF, hd = c >> 7, vt = (c >> 5) & 3, g = (c >> 3) & 3;
                        u32x2* gp = (u32x2*)GT + ((size_t)((hd * 512 + (r >> 5)) * 16 + vt * 4 + g)) * 64 + (r & 31);
                        u32x2 w0; w0.x = cvt_pk_bf16(v0[0], v0[1]); w0.y = cvt_pk_bf16(v0[2], v0[3]); gp[0] = w0;
                        u32x2 w1; w1.x = cvt_pk_bf16(v1[0], v1[1]); w1.y = cvt_pk_bf16(v1[2], v1[3]); gp[32] = w1; }
                } else {
#pragma unroll
                for (int bj = 0; bj < 2; ++bj) { const f32x4 v0 = acc[ai][bj][m][0] * rs, v1 = acc[ai][bj][m][1] * rs;
                    u32x4 w; w.x = cvt_pk_bf16(v0[0], v0[1]); w.y = cvt_pk_bf16(v0[2], v0[3]); w.z = cvt_pk_bf16(v1[0], v1[1]); w.w = cvt_pk_bf16(v1[2], v1[3]);
                    *(u32x4*)(rowp + bj * HALF) = w; }
                }
            }
    }
};
template <bool F8S>
struct EpiResid {
    static constexpr bool PERM = true, PRELOAD = true;
    bf16_t* hb; float* ssq; unsigned char* hb8;
    __device__ __forceinline__ void preload(f32x4 (&acc)[2][2][4][2], const Unit& u, int wr, int wc, int fr, int fq) const {
        const int row0 = u.pm * BM + wr * 64 + fr, col0 = u.pn * BM + wc * 32 + 8 * fq;
#pragma unroll
        for (int ai = 0; ai < 2; ++ai)
#pragma unroll
            for (int m = 0; m < 4; ++m)
#pragma unroll
                for (int bj = 0; bj < 2; ++bj) { const u32x4 w = *(const u32x4*)(hb + (size_t)(row0 + ai * HALF + m * 16) * D + col0 + bj * HALF);
                    acc[ai][bj][m][0] = (f32x4){bflo(w.x), bfhi(w.x), bflo(w.y), bfhi(w.y)}; acc[ai][bj][m][1] = (f32x4){bflo(w.z), bfhi(w.z), bflo(w.w), bfhi(w.w)};
                    if constexpr (F8S) { acc[ai][bj][m][0] *= 256.0f; acc[ai][bj][m][1] *= 256.0f; } }
    }
    __device__ __forceinline__ void operator()(const f32x4 (&acc)[2][2][4][2], const Unit& u, int wr, int wc, int fr, int fq) const {
        const int row0 = u.pm * BM + wr * 64 + fr, col0 = u.pn * BM + wc * 32 + 8 * fq, ln_ = fq * 16 + fr;
#pragma unroll
        for (int ai = 0; ai < 2; ++ai) {
            u32x2 w8[4][2];
#pragma unroll
            for (int m = 0; m < 4; ++m) {
                const int r = row0 + ai * HALF + m * 16; const size_t ro = (size_t)r * D + col0; float ss = 0.f;
#pragma unroll
                for (int bj = 0; bj < 2; ++bj) { const size_t o = ro + bj * HALF;
                    const f32x4 h0 = F8S ? acc[ai][bj][m][0] * (1.0f / 256.0f) : acc[ai][bj][m][0], h1 = F8S ? acc[ai][bj][m][1] * (1.0f / 256.0f) : acc[ai][bj][m][1];
                    u32x4 w; w.x = cvt_pk_bf16(h0[0], h0[1]); w.y = cvt_pk_bf16(h0[2], h0[3]); w.z = cvt_pk_bf16(h1[0], h1[1]); w.w = cvt_pk_bf16(h1[2], h1[3]); *(u32x4*)(hb + o) = w;
                    if (hb8) { w8[m][bj].x = pk4_f8(h0[0], h0[1], h0[2], h0[3]); w8[m][bj].y = pk4_f8(h1[0], h1[1], h1[2], h1[3]); }
                    ss += ((h0[0] * h0[0] + h0[1] * h0[1]) + (h0[2] * h0[2] + h0[3] * h0[3])) + ((h1[0] * h1[0] + h1[1] * h1[1]) + (h1[2] * h1[2] + h1[3] * h1[3])); }
                ss += shx(ss, 16, ln_); ss += shx(ss, 32, ln_);
                if (fq == 0) ssq[(size_t)r * 16 + u.pn * 4 + wc] = ss;
            }
            if (hb8) {
#pragma unroll
                for (int p = 0; p < 2; ++p)
#pragma unroll
                    for (int bj = 0; bj < 2; ++bj) { const int r = row0 + ai * HALF + (2 * p + (fq & 1)) * 16;
                        *(u32x4*)(hb8 + (size_t)r * D + col0 - 8 * (fq & 1) + bj * HALF) = pair16(w8[2 * p][bj], w8[2 * p + 1][bj]); }
            }
        }
    }
};
template <bool F8O>
struct EpiSwiglu {
    static constexpr bool PERM = true, PRELOAD = false;
    unsigned char* O; const LAS float* rsb;
    __device__ __forceinline__ void operator()(const f32x4 (&acc)[2][2][4][2], const Unit& u, int wr, int wc, int fr, int fq) const {
        const int row0 = u.pm * BM + wr * 64 + fr, col0 = u.pn * HALF + wc * 32 + 8 * fq;
        float rsv[2][4];
#pragma unroll
        for (int ai = 0; ai < 2; ++ai)
#pragma unroll
            for (int m = 0; m < 4; ++m) rsv[ai][m] = rsb[u.ord * 256 + wr * 64 + fr + ai * HALF + m * 16] * (F8O ? 0.03125f : 1.0f);
#pragma unroll
        for (int ai = 0; ai < 2; ++ai) {
            if constexpr (F8O) {
                u32x2 w8[4];
#pragma unroll
                for (int m = 0; m < 4; ++m) {
                    f32x4 o0, o1; swiglu8f(acc[ai][0][m][0], acc[ai][0][m][1], acc[ai][1][m][0], acc[ai][1][m][1], rsv[ai][m], 4.0f, o0, o1);
                    w8[m].x = pk4_f8(o0.x, o0.y, o0.z, o0.w); w8[m].y = pk4_f8(o1.x, o1.y, o1.z, o1.w); }
#pragma unroll
                for (int p = 0; p < 2; ++p) { const int r = row0 + ai * HALF + (2 * p + (fq & 1)) * 16;
                    *(u32x4*)(O + (size_t)r * DFF + col0 - 8 * (fq & 1)) = pair16(w8[2 * p], w8[2 * p + 1]); }
            } else {
#pragma unroll
                for (int m = 0; m < 4; ++m) { const int r = row0 + ai * HALF + m * 16;
                    u32x4 w; swiglu8(acc[ai][0][m][0], acc[ai][0][m][1], acc[ai][1][m][0], acc[ai][1][m][1], rsv[ai][m], w);
                    *(u32x4*)((bf16_t*)O + (size_t)r * DFF + col0) = w; }
            }
        }
    }
};
struct EpiSwigluMoe {
    static constexpr bool PERM = true, PRELOAD = false;
    unsigned char* O; const float* rstd_tok; const LAS int* tkb;
    __device__ __forceinline__ void operator()(const f32x4 (&acc)[2][2][4][2], const Unit& u, int wr, int wc, int fr, int fq) const {
        const int trow0 = wr * 64 + fr, col0 = u.pn * HALF + wc * 32 + 8 * fq;
        float rsv[2][4];
#pragma unroll
        for (int ai = 0; ai < 2; ++ai)
#pragma unroll
            for (int m = 0; m < 4; ++m) rsv[ai][m] = bfhi((unsigned)tkb[u.ord * 256 + trow0 + ai * HALF + m * 16]) * 0.03125f;
#pragma unroll
        for (int ai = 0; ai < 2; ++ai) {
            u32x2 w[4];
#pragma unroll
            for (int m = 0; m < 4; ++m) {
                f32x4 o0, o1; swiglu8f(acc[ai][0][m][0], acc[ai][0][m][1], acc[ai][1][m][0], acc[ai][1][m][1], rsv[ai][m], 4.0f, o0, o1);
                w[m].x = pk4_f8(o0.x, o0.y, o0.z, o0.w); w[m].y = pk4_f8(o1.x, o1.y, o1.z, o1.w); }
#pragma unroll
            for (int p = 0; p < 2; ++p) { const int tr = trow0 + ai * HALF + (2 * p + (fq & 1)) * 16;
                *(u32x4*)(O + (size_t)(u.pm * BM + tr) * DFF + col0 - 8 * (fq & 1)) = pair16(w[2 * p], w[2 * p + 1]); }
        }
    }
};
struct EpiMoeOut {
    static constexpr bool PERM = true, PRELOAD = false;
    unsigned char* O; const LAS float* gb;
    __device__ __forceinline__ void operator()(const f32x4 (&acc)[2][2][4][2], const Unit& u, int wr, int wc, int fr, int fq) const {
        const int trow0 = wr * 64 + fr, col0 = u.pn * BM + wc * 32 + 8 * fq;
        float gv[2][4];
#pragma unroll
        for (int ai = 0; ai < 2; ++ai)
#pragma unroll
            for (int m = 0; m < 4; ++m) gv[ai][m] = gb[u.ord * 256 + trow0 + ai * HALF + m * 16] * (16.0f / 256.0f);
#pragma unroll
        for (int ai = 0; ai < 2; ++ai) {
            u32x2 w8[4][2];
#pragma unroll
            for (int m = 0; m < 4; ++m) { const float g = gv[ai][m];
#pragma unroll
                for (int bj = 0; bj < 2; ++bj) { const f32x4 v0 = acc[ai][bj][m][0] * g, v1 = acc[ai][bj][m][1] * g;
                    w8[m][bj].x = pk4_f8(v0[0], v0[1], v0[2], v0[3]); w8[m][bj].y = pk4_f8(v1[0], v1[1], v1[2], v1[3]); } }
#pragma unroll
            for (int p = 0; p < 2; ++p)
#pragma unroll
                for (int bj = 0; bj < 2; ++bj) { const int tr = trow0 + ai * HALF + (2 * p + (fq & 1)) * 16;
                    *(u32x4*)(O + (size_t)(u.pm * BM + tr) * D + col0 - 8 * (fq & 1) + bj * HALF) = pair16(w8[2 * p][bj], w8[2 * p + 1][bj]); }
        }
    }
};
struct EpiMoeTail {
    static constexpr bool PERM = true, PRELOAD = false;
    bf16_t* O; const LAS float* gb;
    __device__ __forceinline__ void operator()(const f32x4 (&acc)[2][2][4][2], const Unit& u, int wr, int wc, int fr, int fq) const {
        const int trow0 = wr * 64 + fr, col0 = wc * 32 + 8 * fq;
#pragma unroll
        for (int ai = 0; ai < 2; ++ai)
#pragma unroll
            for (int m = 0; m < 4; ++m) {
                const int tr = trow0 + ai * HALF + m * 16; const float g = gb[tr] * (1.0f / 256.0f);
                bf16_t* rowp = O + (size_t)tr * 256 + col0;
#pragma unroll
                for (int bj = 0; bj < 2; ++bj) { const f32x4 v0 = acc[ai][bj][m][0] * g, v1 = acc[ai][bj][m][1] * g;
                    u32x4 w; w.x = cvt_pk_bf16(v0[0], v0[1]); w.y = cvt_pk_bf16(v0[2], v0[3]); w.z = cvt_pk_bf16(v1[0], v1[1]); w.w = cvt_pk_bf16(v1[2], v1[3]);
                    *(u32x4*)(rowp + bj * HALF) = w; }
            }
    }
};
}

#define XB_TMO      128
#define XB_XCNT(j)  (256  + 64 * (j))
#define XB_XSUB(j)  (1280 + 64 * (j))
#define XB_XGEN(j)  (2304 + 64 * (j))
#define XB_TOP      3328
#define XB_TOPGEN   3392
#define XCD_BAR_WORDS 3456
#define XB_SPIN_CAP (1u << 18)
__device__ __forceinline__ unsigned xb_ld(unsigned* p)              { return __hip_atomic_load(p, __ATOMIC_RELAXED, __HIP_MEMORY_SCOPE_AGENT); }
__device__ __forceinline__ unsigned xb_add(unsigned* p, unsigned v) { return __hip_atomic_fetch_add(p, v, __ATOMIC_RELAXED, __HIP_MEMORY_SCOPE_AGENT); }
__device__ __forceinline__ unsigned xb_xcc_id() { return (unsigned)__builtin_amdgcn_s_getreg((3 << 11) | 20) & 0xFu; }
#define XB_SPIN(cond, bar) do { unsigned _sp = 0; while (cond) { __builtin_amdgcn_s_sleep(1); \
    if ((++_sp & 255u) == 0u) { if (xb_ld(&(bar)[XB_TMO])) break; if (_sp > XB_SPIN_CAP) { atomicAdd(&(bar)[XB_TMO], 1u); break; } } } } while (0)
struct XcdBarrier { unsigned* bar; unsigned x; volatile LAS unsigned* st; };
__device__ __forceinline__ XcdBarrier xcd_barrier_post(unsigned* bar, volatile LAS unsigned* st) {
    XcdBarrier b; b.bar = bar; b.x = xb_xcc_id(); b.st = st;
    if (threadIdx.x == 0) (void)xb_add(&bar[XB_XCNT(b.x)], 1u);
    return b;
}
__device__ __forceinline__ void xcd_barrier_complete(unsigned* bar, unsigned x, unsigned& nloc, unsigned& nx) {
    const unsigned G = gridDim.x * gridDim.y * gridDim.z;
    unsigned sum, cnt, mine, sp = 0u;
    for (;;) {
        sum = 0u; cnt = 0u; mine = 0u;
#pragma unroll
        for (unsigned j = 0; j < 16; ++j) { const unsigned c = xb_ld(&bar[XB_XCNT(j)]); sum += c; cnt += (c > 0u) ? 1u : 0u; }
        mine = xb_ld(&bar[XB_XCNT(x)]);
        if (sum == G) break;
        __builtin_amdgcn_s_sleep(1);
        if ((++sp & 255u) == 0u) { if (xb_ld(&bar[XB_TMO])) break; if (sp > XB_SPIN_CAP) { atomicAdd(&bar[XB_TMO], 1u); break; } }
    }
    nloc = mine > 0u ? mine : 1u; nx = cnt > 0u ? cnt : 1u;
}
__device__ __forceinline__ void xcd_barrier(const XcdBarrier& b) {
    asm volatile("s_waitcnt vmcnt(0)" ::: "memory");
    __syncthreads();
    if (threadIdx.x == 0) {
        unsigned* bar = b.bar;
        __builtin_amdgcn_s_waitcnt(0);
        unsigned nloc = b.st[0], nx = b.st[1];
        if (nloc == 0u) { xcd_barrier_complete(bar, b.x, nloc, nx); b.st[0] = nloc; b.st[1] = nx; }
        const unsigned old = xb_add(&bar[XB_XSUB(b.x)], 1u);
        const unsigned gen = old / nloc;
        if (old + 1u == (gen + 1u) * nloc) {
            __builtin_amdgcn_fence(__ATOMIC_RELEASE, "agent");
            asm volatile("s_waitcnt vmcnt(0)" ::: "memory");
            const unsigned og = xb_add(&bar[XB_TOP], 1u);
            const unsigned tgt = (og / nx + 1u) * nx;
            if (og + 1u != tgt) XB_SPIN(xb_ld(&bar[XB_TOP]) < tgt, bar);
            __builtin_amdgcn_fence(__ATOMIC_ACQUIRE, "agent");
            xb_add(&bar[XB_XGEN(b.x)], 1u);
            asm volatile("s_waitcnt vmcnt(0)" ::: "memory");
        } else {
            XB_SPIN(xb_ld(&bar[XB_XGEN(b.x)]) == gen, bar);
            __builtin_amdgcn_fence(__ATOMIC_ACQUIRE, "agent");
            asm volatile("s_waitcnt vmcnt(0)" ::: "memory");
        }
    }
    __syncthreads();
}

struct Args { const float* in[27]; float* out; unsigned char* ws; int ph_lo, ph_hi; };
static_assert(sizeof(Args) == 27 * 8 + 8 + 8 + 8, "Args has no padding");
enum { I_X = 0, I_ATTN_NORM, I_FFN_NORM, I_FINAL_NORM, I_W_IN, I_W_OUT, I_S5_LRE, I_S5_LIM, I_S5_LOGDT, I_S5_BRE, I_S5_BIM, I_S5_CRE, I_S5_CIM, I_S5_D, I_S5_GLU, I_S5_ONORM,
       I_CONV_W, I_CONV_ONORM, I_HG_LB, I_HG_ONORM, I_FFN_W1, I_FFN_W3, I_FFN_W2, I_MOE_ROUTER, I_MOE_W1, I_MOE_W3, I_MOE_W2 };

struct Ctx {
    LAS unsigned char* lds; int tid, lane, wave, G, bid;
    const float* const* in; float* out; unsigned char* ws;
};

struct P0Item { const float* W; bf16_t* WT; const float* gain; int K, N, map, item; float f8s; };
__device__ __forceinline__ void p0_resolve(const float* const* in, unsigned char* ws, int it, P0Item& d) {
    constexpr int IT_IN = 16 * 96, IT_OUT = 16 * 32, IT_GLU = 4 * 8, IT_FF = 16 * 112;
    constexpr int S0 = 4 * IT_IN, S1 = S0 + 4 * IT_OUT, S2 = S1 + 4 * IT_GLU, S3 = S2 + 2 * IT_FF, S4 = S3 + 2 * IT_FF, S5 = S4 + 2 * IT_FF, S6 = S5 + 16 * IT_FF, S7 = S6 + 16 * IT_FF;
    d.gain = nullptr; d.map = 0; d.f8s = 0.f;
    if (it < S0) { const int l = it / IT_IN; d.item = it % IT_IN; d.W = in[I_W_IN] + (size_t)l * D * DIN; d.K = D; d.N = DIN; d.WT = (bf16_t*)(ws + WS_WIN) + (size_t)l * DIN * D; d.gain = in[I_ATTN_NORM] + l * D; d.f8s = ((F8_IN >> l) & 1) ? 32.f : 0.f; }
    else if (it < S1) { const int q = it - S0, l = q / IT_OUT; d.item = q % IT_OUT; d.W = in[I_W_OUT] + (size_t)l * D * D; d.K = D; d.N = D; d.WT = (bf16_t*)(ws + WS_WOUT) + (size_t)l * D * D; }
    else if (it < S2) { const int q = it - S1, l = q / IT_GLU; d.item = q % IT_GLU; d.W = in[I_S5_GLU] + (size_t)l * 256 * 256; d.K = 256; d.N = 256; d.WT = (bf16_t*)(ws + WS_GLU) + (size_t)l * 256 * 256; }
    else if (it < S3) { const int q = it - S2, j = q / IT_FF; d.item = q % IT_FF; d.W = in[I_FFN_W1] + (size_t)j * D * DFF; d.K = D; d.N = DFF; d.WT = (bf16_t*)(ws + WS_W13 + (size_t)j * 2 * DFF * D * 2); d.map = 1; d.gain = in[I_FFN_NORM] + (2 * j) * D; d.f8s = ((F8_FFN >> (2 * j)) & 1) ? 32.f : 0.f; }
    else if (it < S4) { const int q = it - S3, j = q / IT_FF; d.item = q % IT_FF; d.W = in[I_FFN_W3] + (size_t)j * D * DFF; d.K = D; d.N = DFF; d.WT = (bf16_t*)(ws + WS_W13 + (size_t)j * 2 * DFF * D * 2); d.map = 2; d.gain = in[I_FFN_NORM] + (2 * j) * D; d.f8s = ((F8_FFN >> (2 * j)) & 1) ? 32.f : 0.f; }
    else if (it < S5) { const int q = it - S4, j = q / IT_FF; d.item = q % IT_FF; d.W = in[I_FFN_W2] + (size_t)j * DFF * D; d.K = DFF; d.N = D; d.WT = (bf16_t*)(ws + WS_W2 + (size_t)j * D * DFF * 2); d.f8s = ((F8_FFN >> (2 * j)) & 1) ? 64.f : 0.f; }
    else if (it < S6) { const int q = it - S5, je = q / IT_FF, j = je >> 3; d.item = q % IT_FF; d.W = in[I_MOE_W1] + (size_t)je * D * DFF; d.K = D; d.N = DFF; d.WT = (bf16_t*)(ws + WS_MW13 + (size_t)je * 2 * DFF * D); d.map = 1; d.gain = in[I_FFN_NORM] + (2 * j + 1) * D; d.f8s = 32.f; }
    else if (it < S7) { const int q = it - S6, je = q / IT_FF, j = je >> 3; d.item = q % IT_FF; d.W = in[I_MOE_W3] + (size_t)je * D * DFF; d.K = D; d.N = DFF; d.WT = (bf16_t*)(ws + WS_MW13 + (size_t)je * 2 * DFF * D); d.map = 2; d.gain = in[I_FFN_NORM] + (2 * j + 1) * D; d.f8s = 32.f; }
    else { const int q = it - S7, je = q / IT_FF; d.item = q % IT_FF; d.W = in[I_MOE_W2] + (size_t)je * DFF * D; d.K = DFF; d.N = D; d.WT = (bf16_t*)(ws + WS_MW2 + (size_t)je * D * DFF); d.f8s = 64.f; }
}
__device__ __forceinline__ void p0_load(const P0Item& d, float (&v)[32], int lane) {
    const int nblk = d.N / 32, kb = d.item / nblk, nb = d.item % nblk, k0 = 64 * kb, n0 = 32 * nb;
    const float* p = d.W + (size_t)(k0 + (lane >> 5)) * d.N + n0 + (lane & 31);
#pragma unroll
    for (int i = 0; i < 32; ++i) v[i] = p[(size_t)(2 * i) * d.N];
}
__device__ __forceinline__ void p0_store(const P0Item& d, const float (&v)[32], LAS float* scr, int lane) {
    const int nblk = d.N / 32, kb = d.item / nblk, nb = d.item % nblk, k0 = 64 * kb, n0 = 32 * nb;
    const float sc = (d.f8s != 0.f) ? d.f8s : 1.0f;
    if (d.gain) {
#pragma unroll
        for (int i = 0; i < 32; ++i) scr[(2 * i + (lane >> 5)) * 33 + (lane & 31)] = v[i] * (d.gain[k0 + 2 * i + (lane >> 5)] * sc);
    } else {
#pragma unroll
        for (int i = 0; i < 32; ++i) scr[(2 * i + (lane >> 5)) * 33 + (lane & 31)] = v[i] * sc;
    }
    asm volatile("s_waitcnt lgkmcnt(0)" ::: "memory");
    if (d.f8s != 0.f) {
        const int c = lane & 3;
#pragma unroll
        for (int j = 0; j < 2; ++j) { const int n = n0 + (lane >> 2) + 16 * j; const LAS float* s = scr + (16 * c) * 33 + (lane >> 2) + 16 * j;
            const int drow = (d.map == 0) ? n : ((n >> 7) * 256 + (n & 127) + (d.map == 2 ? 128 : 0));
            u32x4 o; o.x = pk4_f8(s[0 * 33], s[1 * 33], s[2 * 33], s[3 * 33]); o.y = pk4_f8(s[4 * 33], s[5 * 33], s[6 * 33], s[7 * 33]);
            o.z = pk4_f8(s[8 * 33], s[9 * 33], s[10 * 33], s[11 * 33]); o.w = pk4_f8(s[12 * 33], s[13 * 33], s[14 * 33], s[15 * 33]);
            *(u32x4*)((unsigned char*)d.WT + (size_t)drow * d.K + k0 + 16 * c) = o; }
        asm volatile("s_waitcnt lgkmcnt(0)" ::: "memory");
        return;
    }
    const int c = lane & 7;
#pragma unroll
    for (int j = 0; j < 4; ++j) { const int n = n0 + (lane >> 3) + 8 * j; const LAS float* s = scr + (8 * c) * 33 + (lane >> 3) + 8 * j;
        const int drow = (d.map == 0) ? n : ((n >> 7) * 256 + (n & 127) + (d.map == 2 ? 128 : 0));
        u32x4 o; o.x = pg8::cvt_pk_bf16(s[0 * 33], s[1 * 33]); o.y = pg8::cvt_pk_bf16(s[2 * 33], s[3 * 33]); o.z = pg8::cvt_pk_bf16(s[4 * 33], s[5 * 33]); o.w = pg8::cvt_pk_bf16(s[6 * 33], s[7 * 33]);
        *(u32x4*)(d.WT + (size_t)drow * d.K + k0 + 8 * c) = o; }
    asm volatile("s_waitcnt lgkmcnt(0)" ::: "memory");
}
__device__ __forceinline__ void p0_prologue(Ctx& F) {
    LAS float* scr = (LAS float*)(F.lds + F.wave * 16384);
    const int gw = F.bid * 8 + F.wave, NGW = F.G * 8;
    const float* const* in = F.in; unsigned char* ws = F.ws;
    constexpr int IT_IN = 16 * 96, IT_OUT = 16 * 32, IT_GLU = 4 * 8, IT_FF = 16 * 112;
    constexpr int S8 = 4 * IT_IN + 4 * IT_OUT + 4 * IT_GLU + 6 * IT_FF + 48 * IT_FF;
    {
        P0Item d0, d1; float v0[32], v1[32];
        int it = gw;
        if (it < S8) { p0_resolve(in, ws, it, d0); p0_load(d0, v0, F.lane); }
        for (; it < S8; it += 2 * NGW) {
            const int it1 = it + NGW, it2 = it + 2 * NGW;
            if (it1 < S8) { p0_resolve(in, ws, it1, d1); p0_load(d1, v1, F.lane); }
            p0_store(d0, v0, scr, F.lane);
            if (it1 < S8) {
                if (it2 < S8) { p0_resolve(in, ws, it2, d0); p0_load(d0, v0, F.lane); }
                p0_store(d1, v1, scr, F.lane);
            }
        }
    }
    bf16_t* hb = (bf16_t*)(ws + WS_HB); float* ssq = (float*)(ws + WS_SSQ);
    for (int mb = gw * 4; mb < T; mb += NGW * 4) {
        f32x4 v[4][4]; float sq[4];
#pragma unroll
        for (int k = 0; k < 4; ++k)
#pragma unroll
            for (int j = 0; j < 4; ++j) v[k][j] = *((const f32x4*)(in[I_X] + (size_t)(mb + k) * D) + F.lane + 64 * j);
#pragma unroll
        for (int k = 0; k < 4; ++k) { sq[k] = 0.f; u32x2* o8 = (u32x2*)(hb + (size_t)(mb + k) * D) + F.lane;
#pragma unroll
            for (int j = 0; j < 4; ++j) { const f32x4 x = v[k][j]; sq[k] += (x.x * x.x + x.y * x.y) + (x.z * x.z + x.w * x.w); u32x2 w; w.x = pk2(x.x, x.y); w.y = pk2(x.z, x.w); o8[64 * j] = w;
                if (F8_IN & 1) *((unsigned*)(ws + WS_HB8 + (size_t)(mb + k) * D) + F.lane + 64 * j) = pk4_f8(x.x, x.y, x.z, x.w); } }
#pragma unroll
        for (int o = 1; o < 64; o <<= 1) {
#pragma unroll
            for (int k = 0; k < 4; ++k) sq[k] += shx(sq[k], o, F.lane); }
#pragma unroll
        for (int k = 0; k < 4; ++k) if (F.lane < 16) ssq[(size_t)(mb + k) * 16 + F.lane] = (F.lane == 0) ? sq[k] : 0.f;
    }
    float* tab = (float*)(ws + WS_TAB);
    const int gt = F.bid * 512 + F.tid, NGT = F.G * 512;
    for (int i = gt; i < 512; i += NGT) {
        const float* lb = in[I_HG_LB]; const float a0 = lb[i], a1 = lb[512 + i], a2 = lb[1024 + i], a3 = lb[1536 + i];
        const float mx = fmaxf(fmaxf(a0, a1), fmaxf(a2, a3)); const float e0 = expf(a0 - mx), e1 = expf(a1 - mx), e2 = expf(a2 - mx), e3 = expf(a3 - mx);
        const float inv = 1.f / (((e0 + e1) + e2) + e3); const float s1 = e1 * inv, s2 = e2 * inv, s3 = e3 * inv;
        const float hi = 1.0f - 1e-6f;
        tab[TB_LBC + i] = 0.f; tab[TB_LBC + 512 + i] = fminf(fmaxf(s1, 0.f), hi); tab[TB_LBC + 1024 + i] = fminf(fmaxf(s1 + s2, 0.f), hi); tab[TB_LBC + 1536 + i] = fminf(fmaxf((s1 + s2) + s3, 0.f), hi);
    }
    for (int i = gt; i < 4 * 16 * 64; i += NGT) {
        const int lg = i >> 6;
        const float lre = in[I_S5_LRE][i], lim = in[I_S5_LIM][i], dt = expf(in[I_S5_LOGDT][lg]);
        const float er = expf(lre * dt), lbr = er * cosf(lim * dt), lbi = er * sinf(lim * dt);
        tab[TB_LAMB + 2 * i] = lbr; tab[TB_LAMB + 2 * i + 1] = lbi;
        const float den = 1.f / (lre * lre + lim * lim), nr = lbr - 1.f, ni = lbi;
        const float cr = (nr * lre + ni * lim) * den, ci = (ni * lre - nr * lim) * den;
        bf16_t* bbi = (bf16_t*)(ws + WS_BB); bf16_t* cmi = (bf16_t*)(ws + WS_CM); const int p = i & 63;
        for (int c = 0; c < 16; ++c) { const float br = in[I_S5_BRE][(size_t)i * 16 + c], bi = in[I_S5_BIM][(size_t)i * 16 + c];
            const float vr = cr * br - ci * bi, vi = cr * bi + ci * br;
            tab[TB_BBAR + ((size_t)i * 16 + c) * 2] = vr; tab[TB_BBAR + ((size_t)i * 16 + c) * 2 + 1] = vi;
            bbi[((size_t)lg * 128 + 2 * p) * 16 + c] = (bf16_t)f2bf(vr); bbi[((size_t)lg * 128 + 2 * p + 1) * 16 + c] = (bf16_t)f2bf(vi);
            cmi[((size_t)lg * 16 + c) * 128 + 2 * p] = (bf16_t)f2bf(in[I_S5_CRE][((size_t)lg * 16 + c) * 64 + p]);
            cmi[((size_t)lg * 16 + c) * 128 + 2 * p + 1] = (bf16_t)f2bf(-in[I_S5_CIM][((size_t)lg * 16 + c) * 64 + p]); }
    }
    for (int i = gt; i < 4 * 16 * 64 * 64; i += NGT) {
        const int sidx = i & 63, lgp = i >> 6, lg = lgp >> 6, p = lgp & 63;
        const float lre = in[I_S5_LRE][lgp], lim = in[I_S5_LIM][lgp], dt = expf(in[I_S5_LOGDT][lg]);
        const float er = expf(lre * dt), lbr = er * cosf(lim * dt), lbi = er * sinf(lim * dt);
        const float den = 1.f / (lre * lre + lim * lim), nr = lbr - 1.f, ni = lbi;
        const float cr = (nr * lre + ni * lim) * den, ci = (ni * lre - nr * lim) * den;
        const float tau = (float)(63 - sidx), pe = expf(tau * lre * dt), pr = pe * cosf(tau * lim * dt), pi = pe * sinf(tau * lim * dt);
        const float wr = pr * cr - pi * ci, wi = pr * ci + pi * cr;
        unsigned ore[8], oim[8];
#pragma unroll
        for (int c2 = 0; c2 < 8; ++c2) { const float b0r = in[I_S5_BRE][(size_t)lgp * 16 + 2 * c2], b0i = in[I_S5_BIM][(size_t)lgp * 16 + 2 * c2], b1r = in[I_S5_BRE][(size_t)lgp * 16 + 2 * c2 + 1], b1i = in[I_S5_BIM][(size_t)lgp * 16 + 2 * c2 + 1];
            ore[c2] = pk2(wr * b0r - wi * b0i, wr * b1r - wi * b1i); oim[c2] = pk2(wr * b0i + wi * b0r, wr * b1i + wi * b1r); }
        bf16_t* vt = (bf16_t*)(ws + WS_VT) + ((size_t)lg * 128 + 2 * p) * 1024 + sidx * 16;
        *(u32x4*)vt = (u32x4){ore[0], ore[1], ore[2], ore[3]}; *(u32x4*)(vt + 8) = (u32x4){ore[4], ore[5], ore[6], ore[7]};
        *(u32x4*)(vt + 1024) = (u32x4){oim[0], oim[1], oim[2], oim[3]}; *(u32x4*)(vt + 1024 + 8) = (u32x4){oim[4], oim[5], oim[6], oim[7]};
    }
    for (int i = gt; i < 2 * 8 * 1024; i += NGT) {
        const int j = i >> 13, e = (i >> 10) & 7, k = i & 1023;
        tab[TB_RG + i] = in[I_MOE_ROUTER][((size_t)j * D + k) * NE + e] * in[I_FFN_NORM][(2 * j + 1) * D + k];
    }
}

__device__ __forceinline__ void conv_phase(Ctx& F, int l) {
    const bf16_t* proj = (const bf16_t*)(F.ws + WS_PROJ); bf16_t* mix = (bf16_t*)(F.ws + WS_MIX);
    const float* cw = F.in[I_CONV_W] + l * 3 * CW; const float* gn = F.in[I_CONV_ONORM] + l * CW;
    const int c = 4 * F.lane;
    const f32x4 w0 = *(const f32x4*)(cw + c), w1 = *(const f32x4*)(cw + CW + c), w2 = *(const f32x4*)(cw + 2 * CW + c), g = *(const f32x4*)(gn + c);
    const int gw = F.bid * 8 + F.wave, NGW = F.G * 8;
    for (int tb = gw * 8; tb < T; tb += NGW * 8) {
        u32x2 ra[10], rb[10], rg[8];
#pragma unroll
        for (int j = 0; j < 10; ++j) { const int tt = tb - 2 + j; ra[j] = (u32x2){0u, 0u}; rb[j] = (u32x2){0u, 0u};
            if (tt >= 0) { const bf16_t* row = proj + (size_t)tt * DIN; ra[j] = *(const u32x2*)(row + PC_CC + c); rb[j] = *(const u32x2*)(row + PC_CV + c); } }
#pragma unroll
        for (int j = 0; j < 8; ++j) rg[j] = *(const u32x2*)(proj + (size_t)(tb + j) * DIN + PC_CB + c);
        f32x4 z[10];
#pragma unroll
        for (int j = 0; j < 10; ++j) z[j] = (f32x4){bflo(ra[j].x) * bflo(rb[j].x), bfhi(ra[j].x) * bfhi(rb[j].x), bflo(ra[j].y) * bflo(rb[j].y), bfhi(ra[j].y) * bfhi(rb[j].y)};
        f32x4 y[8]; float ss[8];
#pragma unroll
        for (int j = 0; j < 8; ++j) { y[j] = (z[j] * w0 + z[j + 1] * w1 + z[j + 2] * w2) * (f32x4){bflo(rg[j].x), bfhi(rg[j].x), bflo(rg[j].y), bfhi(rg[j].y)};
            ss[j] = (y[j].x * y[j].x + y[j].y * y[j].y) + (y[j].z * y[j].z + y[j].w * y[j].w); }
#pragma unroll
        for (int o = 1; o < 64; o <<= 1) {
#pragma unroll
            for (int j = 0; j < 8; ++j) ss[j] += shx(ss[j], o, F.lane); }
#pragma unroll
        for (int j = 0; j < 8; ++j) { const float rs = __builtin_amdgcn_rsqf(ss[j] * (1.f / CW) + NORM_EPS); const f32x4 v = y[j] * rs * g;
            u32x2 o; o.x = pk2(v.x, v.y); o.y = pk2(v.z, v.w); *(u32x2*)(mix + (size_t)(tb + j) * D + 256 + c) = o; }
    }
}

#if 1
__device__ __forceinline__ void ref_hg_prep(Ctx& F, int l) {
    const bf16_t* proj = (const bf16_t*)(F.ws + WS_PROJ); const float* lbc = (const float*)(F.ws + WS_TAB) + TB_LBC + l * 512;
    float* fv = (float*)(F.ws + SC_F); float* kv = (float*)(F.ws + SC_K); float* qv = (float*)(F.ws + SC_Q);
    const size_t gt = (size_t)F.bid * 512 + F.tid, NGT = (size_t)F.G * 512;
    for (size_t i = gt; i < (size_t)T * 512; i += NGT) {
        const int t = (int)(i >> 9), c = (int)(i & 511);
        const float fp = bf2f(proj[(size_t)t * DIN + PC_F + c]), q = bf2f(proj[(size_t)t * DIN + PC_Q + c]), lb = lbc[c];
        const float sg = 1.f / (1.f + expf(-fp));
        fv[i] = lb + (1.f - lb) * sg; kv[i] = (1.f - lb) * (1.f - sg); qv[i] = q / (1.f + expf(-q));
    }
}
__device__ __forceinline__ void ref_hg_scan(Ctx& F, int unit) {
    const bf16_t* proj = (const bf16_t*)(F.ws + WS_PROJ);
    const float* fv = (const float*)(F.ws + SC_F); const float* kv = (const float*)(F.ws + SC_K); const float* qv = (const float*)(F.ws + SC_Q); float* ov = (float*)(F.ws + SC_O);
    const int head = unit >> 1, v = (unit & 1) * 64 + F.lane;
    float S[128];
#pragma unroll
    for (int k = 0; k < 128; ++k) S[k] = 0.f;
    for (int t = 0; t < T; ++t) {
        const float iv = bf2f(proj[(size_t)t * DIN + PC_I + head * 128 + v]);
        const float* f = fv + (size_t)t * 512 + head * 128; const float* kk = kv + (size_t)t * 512 + head * 128; const float* q = qv + (size_t)t * 512 + head * 128;
        float acc = 0.f;
#pragma unroll
        for (int k = 0; k < 128; ++k) { S[k] = f[k] * S[k] + kk[k] * iv; acc += S[k] * q[k]; }
        ov[(size_t)t * 512 + head * 128 + v] = acc;
    }
}
__device__ __forceinline__ void ref_s5_scan(Ctx& F, int l, int g) {
    const bf16_t* proj = (const bf16_t*)(F.ws + WS_PROJ); const float* tab = (const float*)(F.ws + WS_TAB);
    float* y1 = (float*)(F.ws + SC_Y1);
    const int p = F.lane, lgp = (l * 16 + g) * 64 + p;
    const float lbr = tab[TB_LAMB + 2 * lgp], lbi = tab[TB_LAMB + 2 * lgp + 1];
    float Br[16], Bi[16], Cr[16], Ci[16];
#pragma unroll
    for (int c = 0; c < 16; ++c) { Br[c] = tab[TB_BBAR + ((size_t)lgp * 16 + c) * 2]; Bi[c] = tab[TB_BBAR + ((size_t)lgp * 16 + c) * 2 + 1];
        Cr[c] = F.in[I_S5_CRE][((size_t)(l * 16 + g) * 16 + c) * 64 + p]; Ci[c] = F.in[I_S5_CIM][((size_t)(l * 16 + g) * 16 + c) * 64 + p]; }
    const float dl = (F.lane < 16) ? F.in[I_S5_D][l * S5W + g * 16 + F.lane] : 0.f;
    float xr = 0.f, xi = 0.f;
    for (int t = 0; t < T; ++t) {
        const u32x4* up = (const u32x4*)(proj + (size_t)t * DIN + PC_U + g * 16); const u32x4 ua = up[0], ub = up[1];
        float u[16];
        u[0] = bflo(ua.x); u[1] = bfhi(ua.x); u[2] = bflo(ua.y); u[3] = bfhi(ua.y); u[4] = bflo(ua.z); u[5] = bfhi(ua.z); u[6] = bflo(ua.w); u[7] = bfhi(ua.w);
        u[8] = bflo(ub.x); u[9] = bfhi(ub.x); u[10] = bflo(ub.y); u[11] = bfhi(ub.y); u[12] = bflo(ub.z); u[13] = bfhi(ub.z); u[14] = bflo(ub.w); u[15] = bfhi(ub.w);
        float bur = 0.f, bui = 0.f;
#pragma unroll
        for (int c = 0; c < 16; ++c) { bur += Br[c] * u[c]; bui += Bi[c] * u[c]; }
        const float nxr = lbr * xr - lbi * xi + bur, nxi = lbr * xi + lbi * xr + bui; xr = nxr; xi = nxi;
        float my = 0.f, myu = 0.f;
#pragma unroll
        for (int c = 0; c < 16; ++c) { const float s = wave_sum(Cr[c] * xr - Ci[c] * xi, F.lane); if (F.lane == c) { my = s; myu = u[c]; } }
        if (F.lane < 16) y1[(size_t)t * S5W + g * 16 + F.lane] = gelu_tanh(my + dl * myu);
    }
}
__device__ __forceinline__ void ref_finalize_s5(Ctx& F, int l) {
    bf16_t* mix = (bf16_t*)(F.ws + WS_MIX);
    const float* y1 = (const float*)(F.ws + SC_Y1);
    const float* wg = F.in[I_S5_GLU] + (size_t)l * 256 * 256; const float* gs = F.in[I_S5_ONORM] + l * 256;
    const int gw = F.bid * 8 + F.wave, NGW = F.G * 8;
    for (int t = gw; t < T; t += NGW) {
        const float* yr = y1 + (size_t)t * 256; f32x4 z = (f32x4){0.f, 0.f, 0.f, 0.f};
        for (int i = 0; i < 256; ++i) { const float a = yr[i]; const f32x4 w = *(const f32x4*)(wg + (size_t)i * 256 + 4 * F.lane); z += w * a; }
        const f32x4 yv = *(const f32x4*)(yr + 4 * F.lane);
        f32x4 y2 = (f32x4){yv.x * sigmoidf_(z.x), yv.y * sigmoidf_(z.y), yv.z * sigmoidf_(z.z), yv.w * sigmoidf_(z.w)};
        const float ss = wave_sum((y2.x * y2.x + y2.y * y2.y) + (y2.z * y2.z + y2.w * y2.w), F.lane);
        const float rs = __builtin_amdgcn_rsqf(ss * (1.f / 256.f) + NORM_EPS);
        const f32x4 g = *(const f32x4*)(gs + 4 * F.lane); y2 = y2 * rs * g;
        u32x2 o; o.x = pk2(y2.x, y2.y); o.y = pk2(y2.z, y2.w); *(u32x2*)(mix + (size_t)t * D + 4 * F.lane) = o;
    }
}
__device__ __forceinline__ void ref_finalize_hg(Ctx& F, int l) {
    const bf16_t* proj = (const bf16_t*)(F.ws + WS_PROJ); bf16_t* mix = (bf16_t*)(F.ws + WS_MIX);
    const float* ov = (const float*)(F.ws + SC_O); const float* gh = F.in[I_HG_ONORM] + l * 512;
    const int gw = F.bid * 8 + F.wave, NGW = F.G * 8;
    for (int t = gw; t < T; t += NGW) {
        const int c = 8 * F.lane; const f32x4 a = *(const f32x4*)(ov + (size_t)t * 512 + c), b = *(const f32x4*)(ov + (size_t)t * 512 + c + 4);
        float ss = ((a.x * a.x + a.y * a.y) + (a.z * a.z + a.w * a.w)) + ((b.x * b.x + b.y * b.y) + (b.z * b.z + b.w * b.w));
        ss += shx(ss, 1, F.lane); ss += shx(ss, 2, F.lane); ss += shx(ss, 4, F.lane); ss += shx(ss, 8, F.lane);
        const float rs = __builtin_amdgcn_rsqf(ss * (1.f / 128.f) + NORM_EPS);
        const f32x4 g0 = *(const f32x4*)(gh + c), g1 = *(const f32x4*)(gh + c + 4);
        const u32x4 gt = *(const u32x4*)(proj + (size_t)t * DIN + PC_G + c);
        float o[8];
        o[0] = a.x * rs * g0.x * siluf_(bflo(gt.x)); o[1] = a.y * rs * g0.y * siluf_(bfhi(gt.x)); o[2] = a.z * rs * g0.z * siluf_(bflo(gt.y)); o[3] = a.w * rs * g0.w * siluf_(bfhi(gt.y));
        o[4] = b.x * rs * g1.x * siluf_(bflo(gt.z)); o[5] = b.y * rs * g1.y * siluf_(bfhi(gt.z)); o[6] = b.z * rs * g1.z * siluf_(bflo(gt.w)); o[7] = b.w * rs * g1.w * siluf_(bfhi(gt.w));
        u32x4 w; w.x = pk2(o[0], o[1]); w.y = pk2(o[2], o[3]); w.z = pk2(o[4], o[5]); w.w = pk2(o[6], o[7]);
        *(u32x4*)(mix + (size_t)t * D + 512 + c) = w;
    }
}
#endif


typedef float f32x16 __attribute__((ext_vector_type(16)));
template <class V> __device__ __forceinline__ void mfma_settle(V& v) { asm volatile("s_nop 15\n\ts_nop 7" : "+v"(v)); }
template <int KSTEPS>
__device__ __forceinline__ void mma32(f32x16& acc, const LAS unsigned char* A, int lda, const LAS unsigned char* Bt, int ldb, int lane) {
    const LAS unsigned char* pa = A + (lane & 31) * lda + (lane >> 5) * 16;
    const LAS unsigned char* pb = Bt + (lane & 31) * ldb + (lane >> 5) * 16;
    bf16x8 a[KSTEPS], b[KSTEPS];
#pragma unroll
    for (int s = 0; s < KSTEPS; ++s) { a[s] = *(const LAS bf16x8*)(pa + s * 32); b[s] = *(const LAS bf16x8*)(pb + s * 32); }
    __builtin_amdgcn_sched_barrier(0);
#pragma unroll
    for (int s = 0; s < KSTEPS; ++s) acc = __builtin_amdgcn_mfma_f32_32x32x16_bf16(a[s], b[s], acc, 0, 0, 0);
    mfma_settle(acc);
}
__device__ __forceinline__ u32x2 pack4(float a, float b, float c, float d) { u32x2 w; w.x = pg8::cvt_pk_bf16(a, b); w.y = pg8::cvt_pk_bf16(c, d); return w; }

constexpr int HS128 = 272, HS64 = 144;
constexpr int HL_QP = 0, HL_KP = HL_QP + 64 * HS128, HL_AQ = HL_KP + 64 * HS128, HL_KDT = HL_AQ + 64 * HS128, HL_VT = HL_KDT + 128 * HS64,
              HL_P = HL_VT + 128 * HS64, HL_ST = HL_P + 64 * HS64, HL_TOT = HL_ST + 128 * HS128, HL_DV = HL_TOT + 4096, HL_END = HL_DV + 512;
static_assert(HL_END <= MISC_OFF, "HGRN2 LDS map");
__device__ __forceinline__ void hg_local(Ctx& F, int l, int unit) {
    const int hd = unit & 3, sg = unit >> 2;
    const bf16_t* proj = (const bf16_t*)(F.ws + WS_PROJ);
    bf16_t* oloc = (bf16_t*)(F.ws + FS_OLOC); bf16_t* aseg = (bf16_t*)(F.ws + FS_ASEG);
    float* send = (float*)(F.ws + FS_SEND); float* dseg = (float*)(F.ws + FS_DSEG);
    LAS unsigned char* L = F.lds;
    LAS float* tot = (LAS float*)(L + HL_TOT); LAS float* dv = (LAS float*)(L + HL_DV);
    const int tid = F.tid, lane = F.lane, w = F.wave, r = lane & 31, h = lane >> 5;
    const int kp = tid & 63, oc = tid >> 6, k0 = 2 * kp;
    const float lbA = ((const float*)(F.ws + WS_TAB))[TB_LBC + l * 512 + hd * 128 + k0], lbB = ((const float*)(F.ws + WS_TAB))[TB_LBC + l * 512 + hd * 128 + k0 + 1];
    const float omA = 1.f - lbA, omB = 1.f - lbB;
    float BsegA = 0.f, BsegB = 0.f;
    f32x16 S0, S1;
#pragma unroll
    for (int i = 0; i < 16; ++i) { S0[i] = 0.f; S1[i] = 0.f; }
    { unsigned zz = 0u; asm volatile("" : "+v"(zz)); for (int i = tid; i < 128 * HS128 / 16; i += 512) ((LAS u32x4*)(L + HL_ST))[i] = (u32x4){zz, zz, zz, zz}; }
    const int kt0 = (2 * w) >> 2, vt0 = (2 * w) & 3, kt1 = (2 * w + 1) >> 2, vt1 = (2 * w + 1) & 3;
#define HG_BAR() do { asm volatile("s_waitcnt lgkmcnt(0)" ::: "memory"); __builtin_amdgcn_s_barrier(); asm volatile("" ::: "memory"); } while (0)
    unsigned rq[8], rf[8], ri[8];
    {
        const unsigned* p0 = (const unsigned*)(proj + (size_t)(sg * 256 + oc * 8) * DIN + PC_Q + hd * 128 + k0);
#pragma unroll
        for (int i = 0; i < 8; ++i) { rq[i] = p0[(size_t)i * (DIN / 2)]; rf[i] = p0[(size_t)i * (DIN / 2) + (PC_F - PC_Q) / 2]; ri[i] = p0[(size_t)i * (DIN / 2) + (PC_I - PC_Q) / 2]; }
    }
    for (int c = 0; c < 4; ++c) {
        const int tc = sg * 256 + c * 64, t0 = tc + oc * 8;
        float lfA[8], lfB[8], qsA[8], qsB[8], kkA[8], kkB[8]; unsigned ivw[8];
        {
            float ef[16], eq[16];
#pragma unroll
            for (int i = 0; i < 8; ++i) { ivw[i] = ri[i];
                ef[2 * i] = __builtin_amdgcn_exp2f(bflo(rf[i]) * -1.4426950408889634f); ef[2 * i + 1] = __builtin_amdgcn_exp2f(bfhi(rf[i]) * -1.4426950408889634f);
                eq[2 * i] = __builtin_amdgcn_exp2f(bflo(rq[i]) * -1.4426950408889634f); eq[2 * i + 1] = __builtin_amdgcn_exp2f(bfhi(rq[i]) * -1.4426950408889634f); }
#pragma unroll
            for (int i = 0; i < 16; ++i) { ef[i] = __builtin_amdgcn_rcpf(1.f + ef[i]); eq[i] = __builtin_amdgcn_rcpf(1.f + eq[i]); }
#pragma unroll
            for (int i = 0; i < 8; ++i) {
                lfA[i] = __builtin_amdgcn_logf(fmaxf(lbA, 1e-30f) + omA * ef[2 * i]) * 0.6931471805599453f; lfB[i] = __builtin_amdgcn_logf(fmaxf(lbB, 1e-30f) + omB * ef[2 * i + 1]) * 0.6931471805599453f;
                kkA[i] = omA * (1.f - ef[2 * i]); kkB[i] = omB * (1.f - ef[2 * i + 1]);
                qsA[i] = bflo(rq[i]) * eq[2 * i]; qsB[i] = bfhi(rq[i]) * eq[2 * i + 1]; }
        }
#pragma unroll
        for (int i = 1; i < 8; ++i) { lfA[i] += lfA[i - 1]; lfB[i] += lfB[i - 1]; }
        *(LAS f32x2*)(tot + oc * 128 + k0) = (f32x2){lfA[7], lfB[7]};
        HG_BAR();
        float preA = 0.f, preB = 0.f, midA = 0.f, midB = 0.f, lastA = 0.f, lastB = 0.f;
#pragma unroll
        for (int o2 = 0; o2 < 8; ++o2) { const f32x2 tv = *(const LAS f32x2*)(tot + o2 * 128 + k0);
            if (o2 < oc) { preA += tv.x; preB += tv.y; } if (o2 < 4) { midA += tv.x; midB += tv.y; } lastA += tv.x; lastB += tv.y; }
        const float EmA = __expf(midA), EmB = __expf(midB), EsA = __expf(midA + BsegA), EsB = __expf(midB + BsegB), ElA = __expf(lastA - midA), ElB = __expf(lastB - midB);
        unsigned kdA[4], kdB[4], ivA[4], ivB[4];
        float e1[16], r1[16];
#pragma unroll
        for (int i = 0; i < 8; ++i) { e1[2 * i] = __builtin_amdgcn_exp2f((preA + lfA[i] - midA) * 1.4426950408889634f); e1[2 * i + 1] = __builtin_amdgcn_exp2f((preB + lfB[i] - midB) * 1.4426950408889634f); }
#pragma unroll
        for (int i = 0; i < 16; ++i) { e1[i] = fminf(fmaxf(e1[i], 1e-30f), 1e30f); r1[i] = __builtin_amdgcn_rcpf(e1[i]); }
#pragma unroll
        for (int i = 0; i < 8; ++i) {
            const int tl = oc * 8 + i;
            const float e1A = e1[2 * i], e1B = e1[2 * i + 1], r1A = r1[2 * i], r1B = r1[2 * i + 1];
            const float qpA = qsA[i] * e1A, qpB = qsB[i] * e1B, kpA = kkA[i] * r1A, kpB = kkB[i] * r1B;
            *(LAS unsigned*)(L + HL_QP + tl * HS128 + k0 * 2) = pk2(qpA, qpB);
            *(LAS unsigned*)(L + HL_KP + tl * HS128 + k0 * 2) = pk2(kpA, kpB);
            *(LAS unsigned*)(L + HL_AQ + tl * HS128 + k0 * 2) = pk2(qpA * EmA, qpB * EmB);
            *(unsigned*)(aseg + (size_t)(t0 + i) * 512 + hd * 128 + k0) = pk2(qpA * EsA, qpB * EsB);
            const unsigned kdab = pk2(kpA * ElA, kpB * ElB), va = ivw[i] & 0xffffu, vb = ivw[i] >> 16;
            if (i & 1) { kdA[i >> 1] |= kdab << 16; kdB[i >> 1] |= kdab & 0xffff0000u; ivA[i >> 1] |= va << 16; ivB[i >> 1] |= vb << 16; }
            else { kdA[i >> 1] = kdab & 0xffffu; kdB[i >> 1] = kdab >> 16; ivA[i >> 1] = va; ivB[i >> 1] = vb; }
        }
        *(LAS u32x4*)(L + HL_KDT + k0 * HS64 + oc * 16) = (u32x4){kdA[0], kdA[1], kdA[2], kdA[3]};
        *(LAS u32x4*)(L + HL_KDT + (k0 + 1) * HS64 + oc * 16) = (u32x4){kdB[0], kdB[1], kdB[2], kdB[3]};
        *(LAS u32x4*)(L + HL_VT + k0 * HS64 + oc * 16) = (u32x4){ivA[0], ivA[1], ivA[2], ivA[3]};
        *(LAS u32x4*)(L + HL_VT + (k0 + 1) * HS64 + oc * 16) = (u32x4){ivB[0], ivB[1], ivB[2], ivB[3]};
        if (oc == 0) *(LAS f32x2*)(dv + k0) = (f32x2){__expf(lastA), __expf(lastB)};
        BsegA += lastA; BsegB += lastB;
        if (c < 3) {
            const unsigned* p0 = (const unsigned*)(proj + (size_t)(tc + 64 + oc * 8) * DIN + PC_Q + hd * 128 + k0);
#pragma unroll
            for (int i = 0; i < 8; ++i) { rq[i] = p0[(size_t)i * (DIN / 2)]; rf[i] = p0[(size_t)i * (DIN / 2) + (PC_F - PC_Q) / 2]; ri[i] = p0[(size_t)i * (DIN / 2) + (PC_I - PC_Q) / 2]; }
        }
        HG_BAR();
        if (w < 4) {
            const int a = w & 1, b = w >> 1;
            f32x16 acc;
#pragma unroll
            for (int i = 0; i < 16; ++i) acc[i] = 0.f;
            if (!(a == 1 && b == 0)) {
                mma32<8>(acc, L + HL_KP + a * 32 * HS128, HS128, L + HL_QP + b * 32 * HS128, HS128, lane);
                if (a == b) {
#pragma unroll
                    for (int i = 0; i < 16; ++i) { const int sl = (i & 3) + 8 * (i >> 2) + 4 * h; acc[i] = (sl <= r) ? acc[i] : 0.f; }
                }
            }
#pragma unroll
            for (int g = 0; g < 4; ++g) *(LAS u32x2*)(L + HL_P + (b * 32 + r) * HS64 + (a * 32 + 8 * g + 4 * h) * 2) = pack4(acc[4 * g], acc[4 * g + 1], acc[4 * g + 2], acc[4 * g + 3]);
        }
        HG_BAR();
        {
            const int vt = w & 3, tt = w >> 2;
            f32x16 acc;
#pragma unroll
            for (int i = 0; i < 16; ++i) acc[i] = 0.f;
            mma32<4>(acc, L + HL_VT + vt * 32 * HS64, HS64, L + HL_P + tt * 32 * HS64, HS64, lane);
            mma32<8>(acc, L + HL_ST + vt * 32 * HS128, HS128, L + HL_AQ + tt * 32 * HS128, HS128, lane);
            u32x2* otile = (u32x2*)oloc + ((size_t)((hd * 512 + (tc >> 5) + tt) * 16 + vt * 4)) * 64 + lane;
#pragma unroll
            for (int g = 0; g < 4; ++g) otile[g * 64] = pack4(acc[4 * g], acc[4 * g + 1], acc[4 * g + 2], acc[4 * g + 3]);
        }
#pragma unroll
        for (int i = 0; i < 16; ++i) { const int ko = (i & 3) + 8 * (i >> 2) + 4 * h; S0[i] *= dv[kt0 * 32 + ko]; S1[i] *= dv[kt1 * 32 + ko]; }
        mma32<4>(S0, L + HL_KDT + kt0 * 32 * HS64, HS64, L + HL_VT + vt0 * 32 * HS64, HS64, lane);
        mma32<4>(S1, L + HL_KDT + kt1 * 32 * HS64, HS64, L + HL_VT + vt1 * 32 * HS64, HS64, lane);
        HG_BAR();
#pragma unroll
        for (int g = 0; g < 4; ++g) {
            *(LAS u32x2*)(L + HL_ST + (vt0 * 32 + r) * HS128 + (kt0 * 32 + 8 * g + 4 * h) * 2) = pack4(S0[4 * g], S0[4 * g + 1], S0[4 * g + 2], S0[4 * g + 3]);
            *(LAS u32x2*)(L + HL_ST + (vt1 * 32 + r) * HS128 + (kt1 * 32 + 8 * g + 4 * h) * 2) = pack4(S1[4 * g], S1[4 * g + 1], S1[4 * g + 2], S1[4 * g + 3]);
        }
    }
    float* se = send + ((size_t)(sg * 4 + hd) * 128) * 128;
#pragma unroll
    for (int g = 0; g < 4; ++g) {
        *(f32x4*)(se + (size_t)(vt0 * 32 + r) * 128 + kt0 * 32 + 8 * g + 4 * h) = (f32x4){S0[4 * g], S0[4 * g + 1], S0[4 * g + 2], S0[4 * g + 3]};
        *(f32x4*)(se + (size_t)(vt1 * 32 + r) * 128 + kt1 * 32 + 8 * g + 4 * h) = (f32x4){S1[4 * g], S1[4 * g + 1], S1[4 * g + 2], S1[4 * g + 3]};
    }
    if (oc == 0) { dseg[sg * 512 + hd * 128 + k0] = __expf(BsegA); dseg[sg * 512 + hd * 128 + k0 + 1] = __expf(BsegB); }
    __syncthreads();
#undef HG_BAR
}
__device__ __forceinline__ void hg_carry(Ctx& F, int bu) {
    const float* send = (const float*)(F.ws + FS_SEND); const float* dseg = (const float*)(F.ws + FS_DSEG); bf16_t* sst = (bf16_t*)(F.ws + FS_SST);
    LAS float* gP = (LAS float*)F.lds; LAS float* gL = gP + 512;
    const int el = F.tid & 63, grp = F.tid >> 6, e = bu * 64 + el, hd = e >> 14, k = e & 127;
    float locA[8], PA[8]; float loc = 0.f, P = 1.f;
#pragma unroll
    for (int i = 0; i < 8; ++i) { const int sgi = grp * 8 + i; const float d = dseg[sgi * 512 + hd * 128 + k], x = send[(size_t)sgi * 65536 + e]; loc = d * loc + x; P *= d; locA[i] = loc; PA[i] = P; }
    gP[grp * 64 + el] = P; gL[grp * 64 + el] = loc;
    __syncthreads();
    float X = 0.f;
    for (int g2 = 0; g2 < grp; ++g2) X = gP[g2 * 64 + el] * X + gL[g2 * 64 + el];
#pragma unroll
    for (int i = 0; i < 8; ++i) { const float v = (i == 0) ? X : (PA[i - 1 < 0 ? 0 : i - 1] * X + locA[i - 1 < 0 ? 0 : i - 1]); sst[(size_t)(grp * 8 + i) * 65536 + e] = (bf16_t)f2bf(v); }
    __syncthreads();
}
constexpr int HF_ST = 0, HF_AS = 128 * HS128, HF_END = HF_AS + 256 * HS128;
static_assert(HF_END <= MISC_OFF, "HGRN2 fix-up LDS map");
__device__ __forceinline__ void hg_fix(Ctx& F, int l, int unit) {
    const int hd = unit & 3, sg = unit >> 2;
    bf16_t* mix = (bf16_t*)(F.ws + WS_MIX);
    const bf16_t* oloc = (const bf16_t*)(F.ws + FS_OLOC); const bf16_t* aseg = (const bf16_t*)(F.ws + FS_ASEG); const bf16_t* sst = (const bf16_t*)(F.ws + FS_SST);
    const float* gh = F.in[I_HG_ONORM] + l * 512 + hd * 128;
    LAS unsigned char* L = F.lds;
    const int tid = F.tid, lane = F.lane, w = F.wave, r = lane & 31, h = lane >> 5;
    f32x16 acc[4];
#pragma unroll
    for (int v = 0; v < 4; ++v)
#pragma unroll
        for (int i = 0; i < 16; ++i) acc[v][i] = 0.f;
    const int t32 = sg * 8 + w;
    const u32x2* otile = (const u32x2*)oloc + ((size_t)((hd * 512 + t32) * 16)) * 64 + lane;
    const u32x2* gtile = (const u32x2*)(F.ws + FS_GATE) + ((size_t)((hd * 512 + t32) * 16)) * 64 + lane;
    u32x2 opre[16], gpre[16];
#pragma unroll
    for (int i = 0; i < 16; ++i) { opre[i] = otile[i * 64]; gpre[i] = gtile[i * 64]; }
    if (sg > 0) {
        const bf16_t* ss = sst + ((size_t)(sg * 4 + hd) * 128) * 128;
        for (int i = tid; i < 128 * 16; i += 512) { const int row = i >> 4, ch = i & 15; *(LAS u32x4*)(L + HF_ST + row * HS128 + ch * 16) = *(const u32x4*)(ss + (size_t)row * 128 + ch * 8); }
        for (int i = tid; i < 256 * 16; i += 512) { const int row = i >> 4, ch = i & 15; *(LAS u32x4*)(L + HF_AS + row * HS128 + ch * 16) = *(const u32x4*)(aseg + (size_t)(sg * 256 + row) * 512 + hd * 128 + ch * 8); }
        __syncthreads();
#pragma unroll
        for (int v = 0; v < 4; ++v) mma32<8>(acc[v], L + HF_ST + v * 32 * HS128, HS128, L + HF_AS + w * 32 * HS128, HS128, lane);
    }
    float ssum = 0.f;
#pragma unroll
    for (int v = 0; v < 4; ++v)
#pragma unroll
        for (int g = 0; g < 4; ++g) { const u32x2 o = opre[v * 4 + g];
            acc[v][4 * g] += bflo(o.x); acc[v][4 * g + 1] += bfhi(o.x); acc[v][4 * g + 2] += bflo(o.y); acc[v][4 * g + 3] += bfhi(o.y);
            ssum += (acc[v][4 * g] * acc[v][4 * g] + acc[v][4 * g + 1] * acc[v][4 * g + 1]) + (acc[v][4 * g + 2] * acc[v][4 * g + 2] + acc[v][4 * g + 3] * acc[v][4 * g + 3]); }
    ssum += shx(ssum, 32, lane);
    const float rs = __builtin_amdgcn_rsqf(ssum * (1.f / 128.f) + NORM_EPS);
    __syncthreads();
    LAS unsigned char* ost = L + w * 32 * HS128;
#pragma unroll
    for (int v = 0; v < 4; ++v)
#pragma unroll
        for (int g = 0; g < 4; ++g) { const int vo = v * 32 + 8 * g + 4 * h; const u32x2 gt = gpre[v * 4 + g]; const f32x4 gn = *(const f32x4*)(gh + vo);
            *(LAS u32x2*)(ost + r * HS128 + vo * 2) = pack4(acc[v][4 * g] * rs * gn.x * bflo(gt.x), acc[v][4 * g + 1] * rs * gn.y * bfhi(gt.x),
                                                            acc[v][4 * g + 2] * rs * gn.z * bflo(gt.y), acc[v][4 * g + 3] * rs * gn.w * bfhi(gt.y)); }
    __syncthreads();
    {
        const int t0 = sg * 256 + w * 32;
#pragma unroll
        for (int it = 0; it < 8; ++it) { const int row = it * 4 + (lane >> 4), ch = lane & 15;
            *(u32x4*)(mix + (size_t)(t0 + row) * D + 512 + hd * 128 + ch * 8) = *(const LAS u32x4*)(ost + row * HS128 + ch * 16); }
    }
    __syncthreads();
}

constexpr int S5_XS = 272, S5_Y1S = 528;
constexpr int S5L_X = 0, S5L_Y1 = S5L_X + 8 * 32 * S5_XS, S5L_PART = S5L_Y1 + 64 * S5_Y1S, S5L_END = S5L_PART + 64 * 4 * 4;
static_assert(S5L_END <= MISC_OFF, "S5 LDS map");
template <bool FULL>
__device__ __forceinline__ void s5_pass(Ctx& F, int l, int cidx) {
    const bf16_t* proj = (const bf16_t*)(F.ws + WS_PROJ); const float* tab = (const float*)(F.ws + WS_TAB);
    float* xe = (float*)(F.ws + FS_XE); const float* xin = (const float*)(F.ws + FS_XIN);
    const bf16_t* bbi = (const bf16_t*)(F.ws + WS_BB); const bf16_t* cmi = (const bf16_t*)(F.ws + WS_CM);
    LAS unsigned char* L = F.lds;
    const int lane = F.lane, w = F.wave, r = lane & 31, h = lane >> 5;
    LAS unsigned char* X = L + S5L_X + w * 32 * S5_XS;
    const int tc = cidx * 64;
#define S5_BAR() do { asm volatile("s_waitcnt lgkmcnt(0)" ::: "memory"); __builtin_amdgcn_s_barrier(); asm volatile("" ::: "memory"); } while (0)
    for (int gi = 0; gi < 2; ++gi) {
        const int g = 2 * w + gi, lg = l * 16 + g, st = g * 64 + lane;
        const float lbr = tab[TB_LAMB + 2 * (lg * 64 + lane)], lbi = tab[TB_LAMB + 2 * (lg * 64 + lane) + 1];
        bf16x8 Bf[4];
#pragma unroll
        for (int nt = 0; nt < 4; ++nt) Bf[nt] = *(const bf16x8*)(bbi + ((size_t)lg * 128 + nt * 32 + r) * 16 + h * 8);
        bf16x8 Cf[8];
        if (FULL) {
#pragma unroll
            for (int s2 = 0; s2 < 8; ++s2) { Cf[s2] = (bf16x8){0, 0, 0, 0, 0, 0, 0, 0}; if (r < 16) Cf[s2] = *(const bf16x8*)(cmi + ((size_t)lg * 16 + r) * 128 + s2 * 16 + h * 8); }
        }
        float xr = 0.f, xi = 0.f;
        if (FULL) { xr = xin[((size_t)cidx * 1024 + st) * 2]; xi = xin[((size_t)cidx * 1024 + st) * 2 + 1]; }
        bf16x8 Af2[2];
#pragma unroll
        for (int hf = 0; hf < 2; ++hf) Af2[hf] = *(const bf16x8*)(proj + (size_t)(tc + hf * 32 + r) * DIN + PC_U + g * 16 + h * 8);
        bf16x8 Df = (bf16x8){0, 0, 0, 0, 0, 0, 0, 0};
        if (FULL) { const short db = (short)f2bf(F.in[I_S5_D][l * S5W + g * 16 + (r & 15)]);
#pragma unroll
            for (int j = 0; j < 8; ++j) Df[j] = (r < 16 && r - 8 * h == j) ? db : (short)0; }
        for (int half = 0; half < 2; ++half) {
            const bf16x8 Af = Af2[half];
            f32x16 acc4[4];
#pragma unroll
            for (int nt = 0; nt < 4; ++nt) {
#pragma unroll
                for (int i = 0; i < 16; ++i) acc4[nt][i] = 0.f;
                acc4[nt] = __builtin_amdgcn_mfma_f32_32x32x16_bf16(Bf[nt], Af, acc4[nt], 0, 0, 0);
            }
            asm volatile("s_nop 15\n\ts_nop 7" : "+v"(acc4[0]), "+v"(acc4[1]), "+v"(acc4[2]), "+v"(acc4[3]));
#pragma unroll
            for (int nt = 0; nt < 4; ++nt)
#pragma unroll
                for (int g4 = 0; g4 < 4; ++g4) *(LAS u32x2*)(X + r * S5_XS + (nt * 32 + 8 * g4 + 4 * h) * 2) = pack4(acc4[nt][4 * g4], acc4[nt][4 * g4 + 1], acc4[nt][4 * g4 + 2], acc4[nt][4 * g4 + 3]);
            S5_BAR();
            unsigned bwv[32];
#pragma unroll
            for (int i = 0; i < 32; ++i) bwv[i] = *(const LAS unsigned*)(X + i * S5_XS + lane * 4);
            __builtin_amdgcn_sched_barrier(0);
#pragma unroll
            for (int i = 0; i < 32; ++i) {
                const unsigned bw = bwv[i];
                const float nr = lbr * xr - lbi * xi + bflo(bw), ni = lbr * xi + lbi * xr + bfhi(bw); xr = nr; xi = ni;
                if (FULL) *(LAS unsigned*)(X + i * S5_XS + lane * 4) = pk2(xr, xi);
            }
            S5_BAR();
            if (FULL) {
                f32x16 ya;
#pragma unroll
                for (int i = 0; i < 16; ++i) ya[i] = 0.f;
                bf16x8 xav[8];
#pragma unroll
                for (int s2 = 0; s2 < 8; ++s2) xav[s2] = *(const LAS bf16x8*)(X + r * S5_XS + s2 * 32 + h * 16);
                __builtin_amdgcn_sched_barrier(0);
#pragma unroll
                for (int s2 = 0; s2 < 8; ++s2) ya = __builtin_amdgcn_mfma_f32_32x32x16_bf16(Cf[s2], xav[s2], ya, 0, 0, 0);
                ya = __builtin_amdgcn_mfma_f32_32x32x16_bf16(Df, Af, ya, 0, 0, 0);
                mfma_settle(ya);
#pragma unroll
                for (int g2 = 0; g2 < 2; ++g2) *(LAS u32x2*)(L + S5L_Y1 + (half * 32 + r) * S5_Y1S + (g * 16 + 8 * g2 + 4 * h) * 2) =
                    pack4(gelu_tanh(ya[4 * g2]), gelu_tanh(ya[4 * g2 + 1]), gelu_tanh(ya[4 * g2 + 2]), gelu_tanh(ya[4 * g2 + 3]));
            }
            S5_BAR();
        }
        if (!FULL) { xe[((size_t)cidx * 1024 + st) * 2] = xr; xe[((size_t)cidx * 1024 + st) * 2 + 1] = xi; }
    }
    if (FULL) {
        __syncthreads();
        const bf16_t* wgt = (const bf16_t*)(F.ws + WS_GLU) + (size_t)l * 256 * 256;
        const float* gs = F.in[I_S5_ONORM] + l * 256; bf16_t* mix = (bf16_t*)(F.ws + WS_MIX);
        LAS float* part = (LAS float*)(L + S5L_PART);
        const int r = lane & 31, h = lane >> 5, tt = w & 1, jg = w >> 1;
        f32x16 z[2];
#pragma unroll
        for (int jt = 0; jt < 2; ++jt) {
#pragma unroll
            for (int i = 0; i < 16; ++i) z[jt][i] = 0.f;
            const bf16_t* wa = wgt + (size_t)((jg * 2 + jt) * 32 + r) * 256 + h * 8;
            const LAS unsigned char* pb = L + S5L_Y1 + (tt * 32 + r) * S5_Y1S + h * 16;
#ifndef EXP_NOGLU
            bf16x8 ga[16], gb[16];
#pragma unroll
            for (int s2 = 0; s2 < 16; ++s2) { ga[s2] = *(const bf16x8*)(wa + s2 * 16); gb[s2] = *(const LAS bf16x8*)(pb + s2 * 32); }
            __builtin_amdgcn_sched_barrier(0);
#pragma unroll
            for (int s2 = 0; s2 < 16; ++s2) z[jt] = __builtin_amdgcn_mfma_f32_32x32x16_bf16(ga[s2], gb[s2], z[jt], 0, 0, 0);
#else
            for (int s2 = 0; s2 < 1; ++s2) { (void)wa; (void)pb; }
#endif
            mfma_settle(z[jt]);
        }
        float ssum = 0.f;
#pragma unroll
        for (int jt = 0; jt < 2; ++jt)
#pragma unroll
            for (int g4 = 0; g4 < 4; ++g4) { const int j0 = (jg * 2 + jt) * 32 + 8 * g4 + 4 * h; const u32x2 yv = *(const LAS u32x2*)(L + S5L_Y1 + (tt * 32 + r) * S5_Y1S + j0 * 2);
                const float y0 = bflo(yv.x) * sigmoidf_(z[jt][4 * g4]), y1v = bfhi(yv.x) * sigmoidf_(z[jt][4 * g4 + 1]), y2 = bflo(yv.y) * sigmoidf_(z[jt][4 * g4 + 2]), y3 = bfhi(yv.y) * sigmoidf_(z[jt][4 * g4 + 3]);
                z[jt][4 * g4] = y0; z[jt][4 * g4 + 1] = y1v; z[jt][4 * g4 + 2] = y2; z[jt][4 * g4 + 3] = y3; ssum += (y0 * y0 + y1v * y1v) + (y2 * y2 + y3 * y3); }
        ssum += shx(ssum, 32, lane);
        if (h == 0) part[(tt * 32 + r) * 4 + jg] = ssum;
        __syncthreads();
        const f32x4 pp = *(const LAS f32x4*)(part + (tt * 32 + r) * 4);
        const float rs = __builtin_amdgcn_rsqf(((pp.x + pp.y) + (pp.z + pp.w)) * (1.f / 256.f) + NORM_EPS);
#pragma unroll
        for (int jt = 0; jt < 2; ++jt)
#pragma unroll
            for (int g4 = 0; g4 < 4; ++g4) { const int j0 = (jg * 2 + jt) * 32 + 8 * g4 + 4 * h; const f32x4 gn = *(const f32x4*)(gs + j0);
                *(LAS u32x2*)(L + S5L_Y1 + (tt * 32 + r) * S5_Y1S + j0 * 2) = pack4(z[jt][4 * g4] * rs * gn.x, z[jt][4 * g4 + 1] * rs * gn.y, z[jt][4 * g4 + 2] * rs * gn.z, z[jt][4 * g4 + 3] * rs * gn.w); }
        __syncthreads();
#pragma unroll
        for (int it = 0; it < 4; ++it) { const int row = it * 16 + (F.tid >> 5), ch = F.tid & 31;
            *(u32x4*)(mix + (size_t)(tc + row) * D + ch * 8) = *(const LAS u32x4*)(L + S5L_Y1 + row * S5_Y1S + ch * 16); }
    }
    __syncthreads();
}
__device__ __forceinline__ void s5_endstates(Ctx& F, int l, int bu) {
    const bf16_t* proj = (const bf16_t*)(F.ws + WS_PROJ); const bf16_t* vt = (const bf16_t*)(F.ws + WS_VT); float* xe = (float*)(F.ws + FS_XE);
    const int w = F.wave, wu = bu * 2 + (w >> 2), kq = w & 3;
    const int g = wu >> 5, ct = (wu >> 2) & 7, nt = wu & 3, lane = F.lane, r = lane & 31, h = lane >> 5;
    const bf16_t* pa = proj + (size_t)((ct * 32 + r) * 64 + kq * 16) * DIN + PC_U + g * 16 + h * 8;
    const bf16_t* pb = vt + ((size_t)(l * 16 + g) * 128 + nt * 32 + r) * 1024 + kq * 256 + h * 8;
    f32x16 acc;
#pragma unroll
    for (int i = 0; i < 16; ++i) acc[i] = 0.f;
    bf16x8 av[16], bv[16];
#pragma unroll
    for (int st = 0; st < 16; ++st) { av[st] = *(const bf16x8*)(pa + (size_t)st * DIN); bv[st] = *(const bf16x8*)(pb + st * 16); }
    __builtin_amdgcn_sched_barrier(0);
#pragma unroll
    for (int st = 0; st < 16; ++st) acc = __builtin_amdgcn_mfma_f32_32x32x16_bf16(av[st], bv[st], acc, 0, 0, 0);
    mfma_settle(acc);
    LAS float* part = (LAS float*)F.lds + (w * 16) * 64 + lane;
#pragma unroll
    for (int i = 0; i < 16; ++i) part[i * 64] = acc[i];
    __syncthreads();
    if (kq == 0) {
        float* xo = xe + (size_t)(ct * 32) * 2048 + g * 128 + nt * 32 + r;
#pragma unroll
        for (int i = 0; i < 16; ++i) { const float v = (part[i * 64] + part[(16 + i) * 64]) + (part[(32 + i) * 64] + part[(48 + i) * 64]);
            xo[(size_t)((i & 3) + 8 * (i >> 2) + 4 * h) * 2048] = v; }
    }
    __syncthreads();
}
__device__ __forceinline__ void s5_carry(Ctx& F, int l, int bu) {
    const float* tab = (const float*)(F.ws + WS_TAB); const float* xe = (const float*)(F.ws + FS_XE); float* xin = (float*)(F.ws + FS_XIN);
    LAS float* gL = (LAS float*)(F.lds + 8192);
    const int sl = F.tid & 31, grp = F.tid >> 5, st = bu * 32 + sl;
    float ar = tab[TB_LAMB + 2 * (l * 1024 + st)], ai = tab[TB_LAMB + 2 * (l * 1024 + st) + 1];
#pragma unroll
    for (int i = 0; i < 6; ++i) { const float nr = ar * ar - ai * ai, ni = 2.f * ar * ai; ar = nr; ai = ni; }
    float lr[16], li[16], pr[16], pi[16]; float cr = 0.f, ci = 0.f, qr = 1.f, qi = 0.f;
#pragma unroll
    for (int i = 0; i < 16; ++i) { const int c = grp * 16 + i; const f32x2 x = *(const f32x2*)(xe + ((size_t)c * 1024 + st) * 2);
        const float nr = ar * cr - ai * ci + x.x, ni = ar * ci + ai * cr + x.y; cr = nr; ci = ni; lr[i] = cr; li[i] = ci;
        const float mr = ar * qr - ai * qi, mi = ar * qi + ai * qr; qr = mr; qi = mi; pr[i] = qr; pi[i] = qi; }
    gL[(grp * 32 + sl) * 2] = cr; gL[(grp * 32 + sl) * 2 + 1] = ci;
    __syncthreads();
    float Xr = 0.f, Xi = 0.f;
    for (int g2 = 0; g2 < grp; ++g2) { const float er = gL[(g2 * 32 + sl) * 2], ei = gL[(g2 * 32 + sl) * 2 + 1]; const float nr = qr * Xr - qi * Xi + er, ni = qr * Xi + qi * Xr + ei; Xr = nr; Xi = ni; }
#pragma unroll
    for (int i = 0; i < 16; ++i) { const int c = grp * 16 + i; float vr = Xr, vi = Xi;
        if (i > 0) { vr = pr[i - 1] * Xr - pi[i - 1] * Xi + lr[i - 1]; vi = pr[i - 1] * Xi + pi[i - 1] * Xr + li[i - 1]; }
        *(f32x2*)(xin + ((size_t)c * 1024 + st) * 2) = (f32x2){vr, vi}; }
    __syncthreads();
}

__device__ __forceinline__ void router_phase(Ctx& F, int j) {
    const float* ssq = (const float*)(F.ws + WS_SSQ); const bf16_t* hb = (const bf16_t*)(F.ws + WS_HB);
    LAS float* lgs = (LAS float*)F.lds;
    LAS float* rgL = (LAS float*)(F.lds + 65536);
    { const f32x4* src = (const f32x4*)((const float*)(F.ws + WS_TAB) + TB_RG + j * 8 * 1024);
#pragma unroll
      for (int i = 0; i < 4; ++i) { const int idx = F.tid + 512 * i, e = idx >> 8, c4 = idx & 255; *(LAS f32x4*)(rgL + e * 1028 + c4 * 4) = src[idx]; } }
    __syncthreads();
    LAS int* sel = (LAS int*)(F.lds + 32768);
    LAS float* selg = (LAS float*)(F.lds + 32768 + 512);
    int* tok_e = (int*)(F.ws + WS_MOE + MO_TOKE); int* tok_p = (int*)(F.ws + WS_MOE + MO_TOKP); float* rstd_tok = (float*)(F.ws + WS_MOE + MO_RSTD);
    int* tcnt = (int*)(F.ws + WS_MOE + MO_TCNT); int* tlist = (int*)(F.ws + WS_MOE + MO_TLIST); float* tgate = (float*)(F.ws + WS_MOE + MO_TGATE);
    for (int tile = F.bid; tile < T / 64; tile += F.G) {
        {
            const int tl = F.tid >> 3, e = F.tid & 7, t = tile * 64 + tl;
            const u32x4* hp = (const u32x4*)(hb + (size_t)t * D); const LAS float* rp = rgL + e * 1028;
            f32x2 a2 = (f32x2){0.f, 0.f}, b2 = (f32x2){0.f, 0.f};
#pragma unroll 8
            for (int k8 = 0; k8 < 128; ++k8) { const u32x4 hw = hp[k8]; const f32x4 r0 = *(const LAS f32x4*)(rp + k8 * 8), r1 = *(const LAS f32x4*)(rp + k8 * 8 + 4);
                a2 += (f32x2){bflo(hw.x), bfhi(hw.x)} * (f32x2){r0.x, r0.y}; b2 += (f32x2){bflo(hw.y), bfhi(hw.y)} * (f32x2){r0.z, r0.w};
                a2 += (f32x2){bflo(hw.z), bfhi(hw.z)} * (f32x2){r1.x, r1.y}; b2 += (f32x2){bflo(hw.w), bfhi(hw.w)} * (f32x2){r1.z, r1.w}; }
            const float a = (a2.x + a2.y) + (b2.x + b2.y);
            float ss = ssq[(size_t)t * 16 + e] + ssq[(size_t)t * 16 + 8 + e];
            ss += shx(ss, 1, F.lane); ss += shx(ss, 2, F.lane); ss += shx(ss, 4, F.lane);
            const float rs = __builtin_amdgcn_rsqf(ss * (1.f / D) + NORM_EPS);
            lgs[tl * 8 + e] = a * rs;
            if (e == 0) rstd_tok[t] = rs;
        }
        __syncthreads();
        if (F.tid < 64) {
            const int tl = F.tid; float lg[8];
#pragma unroll
            for (int e = 0; e < 8; ++e) lg[e] = lgs[tl * 8 + e];
            int i1 = 0; float v1 = lg[0];
#pragma unroll
            for (int e = 1; e < 8; ++e) if (lg[e] > v1) { v1 = lg[e]; i1 = e; }
            int i2 = -1; float v2 = -3.0e38f;
#pragma unroll
            for (int e = 0; e < 8; ++e) if (e != i1 && lg[e] > v2) { v2 = lg[e]; i2 = e; }
            const float g1 = 1.f / (1.f + expf(v2 - v1)), g2 = 1.f - g1;
            sel[tl * 2] = i1; sel[tl * 2 + 1] = i2; selg[tl * 2] = g1; selg[tl * 2 + 1] = g2;
        }
        __syncthreads();
        if (F.tid < 8) {
            const int e = F.tid; int n = 0;
            for (int q = 0; q < 128; ++q) n += (sel[q] == e) ? 1 : 0;
            tcnt[tile * 8 + e] = n;
            int pos = 0;
            for (int q = 0; q < 128; ++q) if (sel[q] == e) { const int t = tile * 64 + (q >> 1);
                tok_e[t * 2 + (q & 1)] = e; tok_p[t * 2 + (q & 1)] = pos; tlist[(tile * 8 + e) * 64 + pos] = t; tgate[(tile * 8 + e) * 64 + pos] = selg[q]; ++pos; }
        }
        __syncthreads();
    }
}
__device__ __forceinline__ void moe_tables(Ctx& F, int j, LAS int* tab) {
    const int* tcnt = (const int*)(F.ws + WS_MOE + MO_TCNT); LAS int* baseL = (LAS int*)(F.lds + BASE_OFF);
    for (int i = F.tid; i < 2048; i += 512) baseL[i] = tcnt[i];
    __syncthreads();
    {
        const int e = F.wave, l4 = F.lane * 4;
        const int c0 = baseL[(l4 + 0) * 8 + e], c1 = baseL[(l4 + 1) * 8 + e], c2 = baseL[(l4 + 2) * 8 + e], c3 = baseL[(l4 + 3) * 8 + e];
        int inc = (c0 + c1) + (c2 + c3);
#pragma unroll
        for (int d = 1; d < 64; d <<= 1) { const int up = __builtin_amdgcn_ds_bpermute(((F.lane - d) & 63) << 2, inc); if (F.lane >= d) inc += up; }
        const int ex = inc - ((c0 + c1) + (c2 + c3));
        baseL[(l4 + 0) * 8 + e] = ex; baseL[(l4 + 1) * 8 + e] = ex + c0; baseL[(l4 + 2) * 8 + e] = ex + c0 + c1; baseL[(l4 + 3) * 8 + e] = ex + c0 + c1 + c2;
        if (F.lane == 63) tab[e] = inc;
    }
    __syncthreads();
    if (F.tid == 0) { int pp = 0; for (int e = 0; e < 8; ++e) { tab[8 + e] = pp; pp += (tab[e] + 255) >> 8; } tab[16] = pp; }
    __syncthreads();
}
__device__ __forceinline__ int slot_src(const LAS int* baseL, int e, int pos) {
    int lo = 0;
#pragma unroll
    for (int st = 128; st >= 1; st >>= 1) { const int m = lo + st; if (m < 256 && baseL[m * 8 + e] <= pos) lo = m; }
    return (lo * 8 + e) * 64 + (pos - baseL[lo * 8 + e]);
}
struct TailGeom { int nwg, Lmain, R, S; };
__device__ __forceinline__ TailGeom tail_geom(int NP, int G) {
    TailGeom t; t.nwg = NP * 4; t.Lmain = (t.nwg / G) * G; t.R = t.nwg - t.Lmain;
    t.S = 1; if (t.R > 0) { if (t.R * 14 <= G) t.S = 14; else if (t.R * 7 <= G) t.S = 7; else if (t.R * 2 <= G) t.S = 2; }
    return t;
}
__device__ __forceinline__ void combine_phase(Ctx& F, int j, float* out, bool last, LAS int* tab) {
    const unsigned char* y = (const unsigned char*)(F.ws + WS_Y); bf16_t* hb = (bf16_t*)(F.ws + WS_HB); float* ssq = (float*)(F.ws + WS_SSQ);
    const bf16_t* yt = (const bf16_t*)(F.ws + WS_YT);
    LAS int* tt = tab + 64;
    const int NP = __builtin_amdgcn_readfirstlane(tab[16]); const TailGeom tg = tail_geom(NP, F.G);
    for (int i = F.tid; i < NP * 4; i += 512) tt[i] = -1;
    __syncthreads();
    if (F.tid < tg.R) { pg8::TileOrder o; o.init(NP, 4, F.G, 0); int pm, pn; if (o.mapL(tg.Lmain + F.tid, pm, pn)) tt[pm * 4 + pn] = F.tid; }
    __syncthreads();
    const int* tok_e = (const int*)(F.ws + WS_MOE + MO_TOKE); const int* tok_p = (const int*)(F.ws + WS_MOE + MO_TOKP);
    const float* fn = F.in[I_FINAL_NORM];
    const int gw = F.bid * 8 + F.wave, NGW = F.G * 8;
    const LAS int* baseL = (const LAS int*)(F.lds + BASE_OFF);
    for (int tb = gw * 4; tb < T; tb += NGW * 4) {
        size_t s1[4], s2[4];
#pragma unroll
        for (int k = 0; k < 4; ++k) { const int t = tb + k, e1 = tok_e[2 * t], e2 = tok_e[2 * t + 1], tl6 = t >> 6;
            s1[k] = (size_t)tab[8 + e1] * 256 + baseL[tl6 * 8 + e1] + tok_p[2 * t]; s2[k] = (size_t)tab[8 + e2] * 256 + baseL[tl6 * 8 + e2] + tok_p[2 * t + 1]; }
        u32x2 hw[4][4]; unsigned ya[4][4], yb[4][4]; int t1[4][4], t2[4][4];
#pragma unroll
        for (int k = 0; k < 4; ++k)
#pragma unroll
            for (int q = 0; q < 4; ++q) {
                t1[k][q] = __builtin_amdgcn_readfirstlane(tt[(int)(s1[k] >> 8) * 4 + q]); t2[k][q] = __builtin_amdgcn_readfirstlane(tt[(int)(s2[k] >> 8) * 4 + q]);
                hw[k][q] = *((const u32x2*)(hb + (size_t)(tb + k) * D) + F.lane + 64 * q);
                ya[k][q] = *((const unsigned*)(y + s1[k] * D) + F.lane + 64 * q);
                yb[k][q] = *((const unsigned*)(y + s2[k] * D) + F.lane + 64 * q); }
        f32x4 v[4][4]; float ss[4];
#pragma unroll
        for (int k = 0; k < 4; ++k) { ss[k] = 0.f;
#pragma unroll
            for (int q = 0; q < 4; ++q) {
                const f32x2 a01 = __builtin_amdgcn_cvt_pk_f32_fp8((int)ya[k][q], false), a23 = __builtin_amdgcn_cvt_pk_f32_fp8((int)ya[k][q], true),
                            b01 = __builtin_amdgcn_cvt_pk_f32_fp8((int)yb[k][q], false), b23 = __builtin_amdgcn_cvt_pk_f32_fp8((int)yb[k][q], true);
                f32x4 fa = (f32x4){a01.x, a01.y, a23.x, a23.y} * 0.0625f, fb = (f32x4){b01.x, b01.y, b23.x, b23.y} * 0.0625f;
                if (t1[k][q] >= 0) { fa = (f32x4){0.f, 0.f, 0.f, 0.f}; const int r1 = (int)(s1[k] & 255);
                    for (int sl = 0; sl < tg.S; ++sl) { const u32x2 a = *((const u32x2*)(yt + ((size_t)(t1[k][q] * tg.S + sl) * 256 + r1) * 256) + F.lane); fa += (f32x4){bflo(a.x), bfhi(a.x), bflo(a.y), bfhi(a.y)}; } }
                if (t2[k][q] >= 0) { fb = (f32x4){0.f, 0.f, 0.f, 0.f}; const int r2 = (int)(s2[k] & 255);
                    for (int sl = 0; sl < tg.S; ++sl) { const u32x2 a = *((const u32x2*)(yt + ((size_t)(t2[k][q] * tg.S + sl) * 256 + r2) * 256) + F.lane); fb += (f32x4){bflo(a.x), bfhi(a.x), bflo(a.y), bfhi(a.y)}; } }
                f32x4 x = (f32x4){bflo(hw[k][q].x), bfhi(hw[k][q].x), bflo(hw[k][q].y), bfhi(hw[k][q].y)}; x = (x + fa) + fb;
                v[k][q] = x; ss[k] += (x.x * x.x + x.y * x.y) + (x.z * x.z + x.w * x.w); } }
#pragma unroll
        for (int o = 1; o < 64; o <<= 1) {
#pragma unroll
            for (int k = 0; k < 4; ++k) ss[k] += shx(ss[k], o, F.lane); }
#pragma unroll
        for (int k = 0; k < 4; ++k) { const int t = tb + k;
            if (last) { const float rs = __builtin_amdgcn_rsqf(ss[k] * (1.f / D) + NORM_EPS); f32x4* orow = (f32x4*)(out + (size_t)t * D) + F.lane;
#pragma unroll
                for (int q = 0; q < 4; ++q) { const f32x4 g = *((const f32x4*)fn + F.lane + 64 * q); orow[64 * q] = v[k][q] * rs * g; }
            } else {
                u32x2* o8 = (u32x2*)(hb + (size_t)t * D) + F.lane;
#pragma unroll
                for (int q = 0; q < 4; ++q) { u32x2 w; w.x = pk2(v[k][q].x, v[k][q].y); w.y = pk2(v[k][q].z, v[k][q].w); o8[64 * q] = w;
                    if (F8_IN & 0x4) *((unsigned*)(F.ws + WS_HB8 + (size_t)t * D) + F.lane + 64 * q) = pk4_f8(v[k][q].x, v[k][q].y, v[k][q].z, v[k][q].w); }
                if (F.lane < 16) ssq[(size_t)t * 16 + F.lane] = (F.lane == 0) ? ss[k] : 0.f;
            } }
    }
}

constexpr int PH_PER_LAYER = 10, N_PHASES = 1 + DEPTH * PH_PER_LAYER;
__host__ __device__ constexpr bool phase_exists(int ph) {
    if (ph == 0) return true;
    const int l = (ph - 1) / PH_PER_LAYER, k = (ph - 1) % PH_PER_LAYER;
    if (k <= 6) return true;
    if (k <= 8) return (l & 1) != 0;
    return false;
}

__global__ void __launch_bounds__(512, 2) fwd(Args args) {
    extern __shared__ __attribute__((aligned(16))) unsigned char lds_raw[];
    Ctx F;
    F.lds = (LAS unsigned char*)lds_raw; F.tid = 0; F.lane = 0; F.wave = __builtin_amdgcn_readfirstlane((int)threadIdx.x >> 6);
    F.G = gridDim.x; F.bid = blockIdx.x; F.in = args.in; F.out = args.out; F.ws = args.ws;
    volatile LAS unsigned* MISC = (volatile LAS unsigned*)(F.lds + MISC_OFF);
    LAS int* mtab = (LAS int*)(F.lds + MISC_OFF + 256);
    const int lo = args.ph_lo, hi = args.ph_hi;
    const bool fused = (hi - lo) > 1;
    XcdBarrier bar; bar.bar = (unsigned*)(F.ws + WS_CTL) + CW_BAR; bar.x = 0; bar.st = nullptr;
    if (fused) {
        if (threadIdx.x < 64) MISC[threadIdx.x] = 0u;
        __syncthreads();
        bar = xcd_barrier_post((unsigned*)(F.ws + WS_CTL) + CW_BAR, MISC + 8);
    }
#define IN(k) (lo <= (k) && (k) < hi)
#define SEAM(k) do { if (fused && (k) + 1 < hi) xcd_barrier(bar); else __syncthreads(); } while (0)
#define SITE_CTX int z_ = 0, zv_; asm volatile("" : "+s"(z_)); Ctx C = F; C.ws = F.ws + z_; C.in = F.in + z_; C.out = F.out + z_; \
    C.wave = F.wave + z_; asm volatile("v_mbcnt_lo_u32_b32 %0, -1, 0\n\tv_mbcnt_hi_u32_b32 %0, -1, %0" : "=v"(zv_)); C.lane = zv_; C.tid = C.wave * 64 + C.lane; C.G = (int)gridDim.x + z_; C.bid = (int)blockIdx.x + z_; unsigned char* ws = C.ws; (void)ws
#define P_HB ((bf16_t*)(ws + WS_HB))
#define P_SSQ ((float*)(ws + WS_SSQ))
#define P_PROJ ((bf16_t*)(ws + WS_PROJ))
#define P_MIX ((bf16_t*)(ws + WS_MIX))
#define P_ACT ((bf16_t*)(ws + WS_ACT))
#define P_YB ((bf16_t*)(ws + WS_Y))
#if SITE(0)
    if (IN(0)) { SITE_CTX; p0_prologue(C); SEAM(0); }
#endif

    for (int l = 0; l < DEPTH; ++l) {
        const int base = 1 + l * PH_PER_LAYER, j = l >> 1;
#if SITE(1)
        if (IN(base + 0)) {
            SITE_CTX;
            pg8::DenseSched S; S.o.init(T / 256, DIN / 256, C.G, C.bid); S.Bt = (const char*)(ws + WS_WIN) + (size_t)l * DIN * D * 2; S.tstepB = (size_t)256 * D * 2; S.ssq = P_SSQ; S.rgsrc = nullptr;
            if ((F8_IN >> l) & 1) { S.tstepB = (size_t)256 * D;
                pg8::EpiProj E{P_PROJ, (const LAS float*)(C.lds + RSB_OFF), (bf16_t*)(ws + FS_GATE), 0.03125f};
                pg8::gemm_phase<true>(C.lds, C.tid, (const char*)(ws + WS_HB8), D, D, S, E);
            } else {
                pg8::EpiProj E{P_PROJ, (const LAS float*)(C.lds + RSB_OFF), (bf16_t*)(ws + FS_GATE), 1.0f};
                pg8::gemm_phase<false>(C.lds, C.tid, (const char*)P_HB, 2 * D, 2 * D, S, E);
            }
            SEAM(base + 0);
        }
#endif
#if SITE(2)
        if (IN(base + 1)) {
            SITE_CTX;
            for (int rr = 0; rr < 1 + XREP_CONV; ++rr) conv_phase(C, l);
#if FAST_HG
            __syncthreads();
            for (int rr = 0; rr < 1 + XREP_HGL; ++rr) for (int u = C.bid; u < 256; u += C.G) hg_local(C, l, u);
#else
            ref_hg_prep(C, l);
#endif
#if FAST_S5
            __syncthreads();
            for (int rr = 0; rr < 1 + XREP_S5A; ++rr) for (int u = C.bid; u < 256; u += C.G) s5_endstates(C, l, u);
#else
            if (C.bid < 16 && C.wave == 0) ref_s5_scan(C, l, C.bid);
#endif
            SEAM(base + 1);
        }
#endif
#if SITE(3)
        if (IN(base + 2)) {
            SITE_CTX;
#if FAST_HG
            for (int u = C.bid; u < 1024; u += C.G) hg_carry(C, u);
#else
            if (C.bid < 8 && C.wave == 0) ref_hg_scan(C, C.bid);
#endif
#if FAST_S5
            for (int u = C.G - 1 - C.bid; u < 32; u += C.G) s5_carry(C, l, u);
#endif
            SEAM(base + 2);
        }
#endif
#if SITE(4)
        if (IN(base + 3)) {
            SITE_CTX;
#if FAST_HG
            for (int rr = 0; rr < 1 + XREP_HGF; ++rr) for (int u = C.bid; u < 256; u += C.G) hg_fix(C, l, u);
#else
            ref_finalize_hg(C, l);
#endif
#if FAST_S5
            __syncthreads();
            for (int rr = 0; rr < 1 + XREP_S5C; ++rr) for (int u = C.bid; u < 256; u += C.G) s5_pass<true>(C, l, u);
#else
            ref_finalize_s5(C, l);
#endif
            SEAM(base + 3);
        }
#endif
#if SITE(5)
        if (IN(base + 4)) {
            SITE_CTX;
            pg8::DenseSched S; S.o.init(T / 256, D / 256, C.G, C.bid); S.Bt = (const char*)(ws + WS_WOUT) + (size_t)l * D * D * 2; S.tstepB = (size_t)256 * D * 2; S.ssq = nullptr; S.rgsrc = nullptr;
            pg8::EpiResid<false> E{P_HB, P_SSQ, ((l & 1) || ((F8_FFN >> l) & 1)) ? (unsigned char*)(ws + WS_HB8) : nullptr};
            pg8::gemm_phase<false>(C.lds, C.tid, (const char*)P_MIX, 2 * D, 2 * D, S, E);
            SEAM(base + 4);
        }
#endif
        if ((l & 1) == 0) {
#if SITE(6)
            if (IN(base + 5)) {
                SITE_CTX;
                pg8::DenseSched S; S.o.init(T / 256, 2 * DFF / 256, C.G, C.bid); S.Bt = (const char*)(ws + WS_W13) + (size_t)j * 2 * DFF * D * 2; S.ssq = P_SSQ; S.rgsrc = nullptr;
                if ((F8_FFN >> l) & 1) { S.tstepB = (size_t)256 * D;
                    pg8::EpiSwiglu<true> E{(unsigned char*)P_ACT, (const LAS float*)(C.lds + RSB_OFF)};
                    pg8::gemm_phase<true>(C.lds, C.tid, (const char*)(ws + WS_HB8), D, D, S, E);
                } else { S.tstepB = (size_t)256 * D * 2;
                    pg8::EpiSwiglu<false> E{(unsigned char*)P_ACT, (const LAS float*)(C.lds + RSB_OFF)};
                    pg8::gemm_phase<false>(C.lds, C.tid, (const char*)P_HB, 2 * D, 2 * D, S, E);
                }
                SEAM(base + 5);
            }
#endif
#if SITE(7)
            if (IN(base + 6)) {
                SITE_CTX;
                pg8::DenseSched S; S.o.init(T / 256, D / 256, C.G, C.bid); S.Bt = (const char*)(ws + WS_W2) + (size_t)j * D * DFF * 2; S.ssq = nullptr; S.rgsrc = nullptr;
                if ((F8_FFN >> l) & 1) { S.tstepB = (size_t)256 * DFF;
                    pg8::EpiResid<true> E{P_HB, P_SSQ, ((F8_IN >> (l + 1)) & 1) ? (unsigned char*)(ws + WS_HB8) : nullptr};
                    pg8::gemm_phase<true>(C.lds, C.tid, (const char*)P_ACT, DFF, DFF, S, E);
                } else { S.tstepB = (size_t)256 * DFF * 2;
                    pg8::EpiResid<false> E{P_HB, P_SSQ, ((F8_IN >> (l + 1)) & 1) ? (unsigned char*)(ws + WS_HB8) : nullptr};
                    pg8::gemm_phase<false>(C.lds, C.tid, (const char*)P_ACT, 2 * DFF, 2 * DFF, S, E);
                }
                SEAM(base + 6);
            }
#endif
        } else {
#if SITE(8)
            if (IN(base + 5)) { SITE_CTX; router_phase(C, j); SEAM(base + 5); }
#endif
#if SITE(9)
            if (IN(base + 6)) {
                SITE_CTX;
                moe_tables(C, j, mtab);
                pg8::MoeSched S; S.o.init(__builtin_amdgcn_readfirstlane(mtab[16]), 2 * DFF / 256, C.G, C.bid); S.Bt = (const char*)(ws + WS_MW13) + (size_t)j * 8 * 2 * DFF * D; S.estepB = (size_t)2 * DFF * D; S.tstepB = (size_t)256 * D;
                S.tab = mtab; S.tlist = (const int*)(ws + WS_MOE + MO_TLIST); S.gather = true; S.tgate = nullptr; S.rstd_tok = (const float*)(ws + WS_MOE + MO_RSTD); S.baseL = (const LAS int*)(C.lds + BASE_OFF); S.rsbp = (const LAS unsigned*)(C.lds + RSB_OFF);
                pg8::EpiSwigluMoe E{(unsigned char*)P_ACT, (const float*)(ws + WS_MOE + MO_RSTD), (const LAS int*)(C.lds + RSB_OFF)};
                pg8::gemm_phase<true>(C.lds, C.tid, (const char*)(ws + WS_HB8), D, D, S, E);
                SEAM(base + 6);
            }
#endif
#if SITE(10)
            if (IN(base + 7)) {
                SITE_CTX;
                if (!IN(base + 6)) moe_tables(C, j, mtab);
                const int NP = __builtin_amdgcn_readfirstlane(mtab[16]); const TailGeom tg = tail_geom(NP, C.G);
                {
                pg8::MoeSched S; S.o.init(NP, D / 256, C.G, C.bid); S.o.lim = tg.Lmain; S.Bt = (const char*)(ws + WS_MW2) + (size_t)j * 8 * D * DFF; S.estepB = (size_t)D * DFF; S.tstepB = (size_t)256 * DFF;
                S.tab = mtab; S.tlist = nullptr; S.gather = false; S.rstd_tok = nullptr; S.tgate = (const float*)(ws + WS_MOE + MO_TGATE); S.baseL = (const LAS int*)(C.lds + BASE_OFF); S.rsbp = (const LAS unsigned*)(C.lds + RSB_OFF);
                pg8::EpiMoeOut E{(unsigned char*)P_YB, (const LAS float*)(C.lds + RSB_OFF)};
                pg8::gemm_phase<true>(C.lds, C.tid, (const char*)P_ACT, DFF, DFF, S, E);
                }
                if (tg.R > 0) {
                pg8::MoeTailSched S; S.o.init(NP, D / 256, C.G, C.bid); S.Bt = (const char*)(ws + WS_MW2) + (size_t)j * 8 * D * DFF; S.estepB = (size_t)D * DFF; S.tstepB = (size_t)256 * DFF;
                S.tab = mtab; S.tgate = (const float*)(ws + WS_MOE + MO_TGATE); S.baseL = (const LAS int*)(C.lds + BASE_OFF); S.Lmain = tg.Lmain; S.R = tg.R; S.S = tg.S; S.Kslice = DFF / tg.S;
                pg8::EpiMoeTail E{(bf16_t*)(ws + WS_YT) + (size_t)C.bid * 65536, (const LAS float*)(C.lds + RSB_OFF)};
                int tid2 = C.tid; asm volatile("" : "+v"(tid2));
                pg8::gemm_phase<true>(C.lds, tid2, (const char*)P_ACT, DFF / tg.S, DFF, S, E);
                }
                SEAM(base + 7);
            }
#endif
#if SITE(11)
            if (IN(base + 8)) {
                SITE_CTX;
                if (!IN(base + 6)) moe_tables(C, j, mtab);
                combine_phase(C, j, C.out, l == DEPTH - 1, mtab);
                SEAM(base + 8);
            }
#endif
        }
    }
#undef IN
#undef SEAM
}

extern "C" void kernel_launch(void* const* d_in, const int* in_sizes, int n_in, void* d_out, int out_size, void* d_ws, size_t ws_size, hipStream_t stream) {
    static int grid = 0;
    if (grid == 0) {
        if (n_in != 27 || in_sizes[0] != T * D || out_size != T * D || ws_size < WS_END) { fprintf(stderr, "kernel_launch: unexpected problem shape / workspace (%d inputs, ws %zu)\n", n_in, ws_size); grid = -1; return; }
        int dev = 0, cus = 0, per_cu = 0;
        if (hipGetDevice(&dev) != hipSuccess || hipDeviceGetAttribute(&cus, hipDeviceAttributeMultiprocessorCount, dev) != hipSuccess) { grid = -1; return; }
        if (hipFuncSetAttribute((const void*)fwd, hipFuncAttributeMaxDynamicSharedMemorySize, LDS_BYTES) != hipSuccess) { fprintf(stderr, "kernel_launch: hipFuncSetAttribute failed\n"); grid = -1; return; }
        if (hipOccupancyMaxActiveBlocksPerMultiprocessor(&per_cu, (const void*)fwd, 512, LDS_BYTES) != hipSuccess || per_cu < 1) fprintf(stderr, "kernel_launch: occupancy query reports %d\n", per_cu);
        (void)hipGetLastError();
        grid = cus;
    }
    if (grid < 0) return;
    if (hipMemsetAsync((char*)d_ws + WS_CTL + CW_BAR * 4, 0, XCD_BAR_WORDS * 4, stream) != hipSuccess) return;
    Args a{};
    for (int i = 0; i < 27; ++i) a.in[i] = (const float*)d_in[i];
    a.out = (float*)d_out; a.ws = (unsigned char*)d_ws;
#if MK_FUSED
    a.ph_lo = 0; a.ph_hi = N_PHASES;
    hipLaunchKernelGGL(fwd, dim3(grid), dim3(512), LDS_BYTES, stream, a);
#else
#ifndef MAXPH
#define MAXPH N_PHASES
#endif
    for (int ph = 0; ph < MAXPH; ++ph) {
        if (!phase_exists(ph)) continue;
        a.ph_lo = ph; a.ph_hi = ph + 1;
        hipLaunchKernelGGL(fwd, dim3(grid), dim3(512), LDS_BYTES, stream, a);
#ifdef REP_PH
        if (ph == REP_PH) for (int rr = 0; rr < REP_N; ++rr) hipLaunchKernelGGL(fwd, dim3(grid), dim3(512), LDS_BYTES, stream, a);
#endif
    }
#endif
}
```
